# Optimizing an MI355X kernel written in HIP

```python
import jax, jax.numpy as jnp
from jax import lax
import numpy as np

D_MODEL = 1024
BATCH = 4
SEQ = 8192
DEPTH = 4

PLE_DIM = 256
N_A_LAYERS = DEPTH // 2
N_B_LAYERS = DEPTH - N_A_LAYERS
POOL_WINDOWS = (2, 4, 8, 16)
POOL_GROUP_DIM = D_MODEL // len(POOL_WINDOWS)
N_HEADS = 16
HEAD_DIM = 64
N_KV_GROUPS = 4
HEADS_PER_GROUP = N_HEADS // N_KV_GROUPS
KV_WIDTH = N_KV_GROUPS * HEAD_DIM
N_BRANCH = 3
ROPE_DIMS = HEAD_DIM // 4
ROPE_THETA = 500000.0
CMP_BLOCK = 32
CMP_STRIDE = 16
CMP_HIDDEN = 256
SEL_BLOCK = 64
N_SELECT = 16
WINDOW = 512
Q_BLOCK = 64
FORCE_BONUS = 1e4
N_EXPERT_GROUPS = 4
EXPERTS_PER_GROUP = 8
N_EXPERTS = N_EXPERT_GROUPS * EXPERTS_PER_GROUP
TOP_K_IN_GROUP = 2
D_FF_EXPERT = 512
MOE_CHUNK = 512
RMS_EPS = 1e-6

kernel_name = 'yoco_pool_nsa_hmoe_trunk'


def _rmsnorm(x, g):
    xf = x.astype(jnp.float32)
    y = xf * lax.rsqrt(jnp.mean(xf * xf, axis=-1, keepdims=True) + RMS_EPS)
    return (y * g.astype(jnp.float32)).astype(x.dtype)


def _masked_softmax(s, mask):
    s = jnp.where(mask, s.astype(jnp.float32), -jnp.inf)
    m = jnp.max(s, axis=-1, keepdims=True)
    m = jnp.where(jnp.isfinite(m), m, 0.0)
    e = jnp.exp(s - m)
    return e / jnp.maximum(jnp.sum(e, axis=-1, keepdims=True), 1e-30)


def _rope(x, pos):
    half = ROPE_DIMS // 2
    inv = jnp.float32(ROPE_THETA) ** (-jnp.arange(half, dtype=jnp.float32) * 2.0 / ROPE_DIMS)
    ang = pos.astype(jnp.float32)[:, None] * inv[None, :]
    cos, sin = jnp.cos(ang), jnp.sin(ang)
    xf = x.astype(jnp.float32)
    x1 = xf[..., :half]
    x2 = xf[..., half:ROPE_DIMS]
    out = jnp.concatenate([x1 * cos - x2 * sin, x2 * cos + x1 * sin, xf[..., ROPE_DIMS:]], axis=-1)
    return out.astype(x.dtype)


def _pool_mixer(xn, w_grp, b, scale):
    S = xn.shape[1]
    t = jnp.arange(S)
    outs = []
    for gi, w in enumerate(POOL_WINDOWS):
        xg = xn[..., gi * POOL_GROUP_DIM:(gi + 1) * POOL_GROUP_DIM].astype(jnp.float32)
        cs = jnp.cumsum(xg, axis=1)
        cs_prev = jnp.pad(cs, ((0, 0), (w, 0), (0, 0)))[:, :S]
        cnt = jnp.minimum(t + 1, w).astype(jnp.float32)[None, :, None]
        pooled = (cs - cs_prev) / cnt - xg
        outs.append(pooled.astype(xn.dtype) @ w_grp[gi])
    y = jnp.concatenate(outs, axis=-1)
    return (y + b) * scale


def _compress(k, pos_emb, w1, b1, w2, b2):
    S = k.shape[2]
    n_cmp = (S - CMP_BLOCK) // CMP_STRIDE + 1
    idx = jnp.arange(n_cmp)[:, None] * CMP_STRIDE + jnp.arange(CMP_BLOCK)[None, :]
    blk = k[:, :, idx] + pos_emb
    hid = jax.nn.gelu(jnp.einsum('bgnld,ldh->bgnh', blk, w1) + b1)
    return hid @ w2 + b2


def _shared_kv(h, kv_norm, w_kv, cmp_k_pos, cmp_k_w1, cmp_k_b1, cmp_k_w2, cmp_k_b2,
               cmp_v_pos, cmp_v_w1, cmp_v_b1, cmp_v_w2, cmp_v_b2):
    B, S, _ = h.shape
    hn = _rmsnorm(h, kv_norm)
    kv = (hn @ w_kv).reshape(B, S, 2 * N_BRANCH, N_KV_GROUPS, HEAD_DIM).transpose(2, 0, 3, 1, 4)
    k_c, v_c, k_s, v_s, k_w, v_w = kv[0], kv[1], kv[2], kv[3], kv[4], kv[5]
    pos = jnp.arange(S)
    kc = _compress(k_c, cmp_k_pos, cmp_k_w1, cmp_k_b1, cmp_k_w2, cmp_k_b2)
    n_cmp = kc.shape[2]
    kc = _rope(kc, jnp.arange(n_cmp) * CMP_STRIDE + CMP_BLOCK - 1)
    vc = _compress(v_c, cmp_v_pos, cmp_v_w1, cmp_v_b1, cmp_v_w2, cmp_v_b2)
    n_blk = S // SEL_BLOCK
    ks_blk = _rope(k_s, pos).reshape(B, N_KV_GROUPS, n_blk, SEL_BLOCK, HEAD_DIM)
    vs_blk = v_s.reshape(B, N_KV_GROUPS, n_blk, SEL_BLOCK, HEAD_DIM)
    pad = ((0, 0), (0, 0), (WINDOW, 0), (0, 0))
    kw_pad = jnp.pad(_rope(k_w, pos), pad)
    vw_pad = jnp.pad(v_w, pad)
    return kc, vc, ks_blk, vs_blk, kw_pad, vw_pad


def _gather_blocks(blocks, idx):
    return jax.vmap(jax.vmap(lambda kb, ix: kb[ix]))(blocks, idx)


def _nsa_mixer(xn, w_qg, b_gate, w_o, kc, vc, ks_blk, vs_blk, kw_pad, vw_pad):
    B, S, _ = xn.shape
    G, R, dh = N_KV_GROUPS, HEADS_PER_GROUP, HEAD_DIM
    HD = N_HEADS * HEAD_DIM
    qg = xn @ w_qg
    q = qg[..., :HD].reshape(B, S, N_HEADS, dh).transpose(0, 2, 1, 3)
    q = (_rope(q, jnp.arange(S)) * (dh ** -0.5)).reshape(B, G, R, S, dh)
    gates = jax.nn.sigmoid((qg[..., HD:] + b_gate).astype(jnp.float32))
    gates = gates.reshape(B, S, G, R, N_BRANCH).transpose(0, 2, 3, 1, 4)
    n_cmp = kc.shape[2]
    n_blk = ks_blk.shape[2]
    n_sel = min(N_SELECT, n_blk)
    cmp_start = jnp.arange(n_cmp) * CMP_STRIDE
    cmp_end = cmp_start + CMP_BLOCK - 1
    blk_id = jnp.arange(n_blk)
    sel_start = blk_id * SEL_BLOCK
    cmp_to_sel = ((cmp_start[:, None] < sel_start[None, :] + SEL_BLOCK)
                  & (cmp_start[:, None] + CMP_BLOCK > sel_start[None, :])).astype(jnp.float32)

    def block(qb):
        start = qb * Q_BLOCK
        t = start + jnp.arange(Q_BLOCK)
        q_b = lax.dynamic_slice_in_dim(q, start, Q_BLOCK, axis=3)
        g_b = lax.dynamic_slice_in_dim(gates, start, Q_BLOCK, axis=3)
        s_c = jnp.einsum('bgrqd,bgnd->bgrqn', q_b, kc)
        p_c = _masked_softmax(s_c, cmp_end[None, :] <= t[:, None])
        o_c = jnp.einsum('bgrqn,bgnd->bgrqd', p_c.astype(vc.dtype), vc)
        imp = jnp.einsum('bgrqn,nj->bgqj', p_c, cmp_to_sel)
        cur = t // SEL_BLOCK
        valid = sel_start[None, :] <= t[:, None]
        forced = (blk_id[None, :] == 0) | (blk_id[None, :] == cur[:, None]) | (blk_id[None, :] == cur[:, None] - 1)
        score = jnp.where(valid, imp + jnp.where(forced, FORCE_BONUS, 0.0), -jnp.inf)
        _, sel = lax.top_k(score, n_sel)
        k_sel = _gather_blocks(ks_blk, sel)
        v_sel = _gather_blocks(vs_blk, sel)
        kpos = sel[..., None] * SEL_BLOCK + jnp.arange(SEL_BLOCK)
        m_s = (kpos <= t[None, None, :, None, None]).reshape(B, G, 1, Q_BLOCK, n_sel * SEL_BLOCK)
        s_s = jnp.einsum('bgrqd,bgqkld->bgrqkl', q_b, k_sel).reshape(B, G, R, Q_BLOCK, n_sel * SEL_BLOCK)
        p_s = _masked_softmax(s_s, m_s).reshape(B, G, R, Q_BLOCK, n_sel, SEL_BLOCK)
        o_s = jnp.einsum('bgrqkl,bgqkld->bgrqd', p_s.astype(v_sel.dtype), v_sel)
        k_w = lax.dynamic_slice_in_dim(kw_pad, start, Q_BLOCK + WINDOW, axis=2)
        v_w = lax.dynamic_slice_in_dim(vw_pad, start, Q_BLOCK + WINDOW, axis=2)
        wpos = start - WINDOW + jnp.arange(Q_BLOCK + WINDOW)
        m_w = (wpos[None, :] <= t[:, None]) & (wpos[None, :] > t[:, None] - WINDOW) & (wpos[None, :] >= 0)
        s_w = jnp.einsum('bgrqd,bgkd->bgrqk', q_b, k_w)
        p_w = _masked_softmax(s_w, m_w)
        o_w = jnp.einsum('bgrqk,bgkd->bgrqd', p_w.astype(v_w.dtype), v_w)
        o = g_b[..., 0:1] * o_c + g_b[..., 1:2] * o_s + g_b[..., 2:3] * o_w
        return o.astype(xn.dtype)

    out = lax.map(block, jnp.arange(S // Q_BLOCK))
    out = out.transpose(1, 0, 4, 2, 3, 5).reshape(B, S, HD)
    return out @ w_o


def _hier_moe(xn, rg_w, rg_b, re_w, re_b, w1, w3, w2):
    B, S, D = xn.shape
    T = B * S
    xt = xn.reshape(T, D)
    g_logits = (xt @ rg_w + rg_b).astype(jnp.float32)
    grp = jnp.argmax(g_logits, axis=-1).astype(jnp.int32)
    g_prob = jnp.take_along_axis(jax.nn.softmax(g_logits, axis=-1), grp[:, None], axis=1)[:, 0]
    e_logits = (xt @ re_w + re_b).astype(jnp.float32).reshape(T, N_EXPERT_GROUPS, EXPERTS_PER_GROUP)
    e_logits = jnp.take_along_axis(e_logits, grp[:, None, None], axis=1)[:, 0]
    top_val, top_idx = lax.top_k(e_logits, TOP_K_IN_GROUP)
    weights = g_prob[:, None] * jax.nn.softmax(top_val, axis=-1)
    experts = grp[:, None] * EXPERTS_PER_GROUP + top_idx.astype(jnp.int32)
    A = T * TOP_K_IN_GROUP
    e_flat = experts.reshape(A)
    w_flat = weights.reshape(A)
    tok_flat = jnp.repeat(jnp.arange(T, dtype=jnp.int32), TOP_K_IN_GROUP)
    order = jnp.argsort(e_flat)
    e_s, w_s, tok_s = e_flat[order], w_flat[order], tok_flat[order]
    counts = jnp.bincount(e_flat, length=N_EXPERTS)
    starts = jnp.cumsum(counts) - counts
    pcounts = (counts + MOE_CHUNK - 1) // MOE_CHUNK * MOE_CHUNK
    pends = jnp.cumsum(pcounts)
    pstarts = pends - pcounts
    dest = pstarts[e_s] + jnp.arange(A, dtype=jnp.int32) - starts[e_s]
    n_chunks = -(-A // MOE_CHUNK) + N_EXPERTS
    P = n_chunks * MOE_CHUNK
    buf_tok = jnp.zeros((P,), jnp.int32).at[dest].set(tok_s)
    buf_w = jnp.zeros((P,), jnp.float32).at[dest].set(w_s)
    chunk_e = jnp.clip(jnp.searchsorted(pends, jnp.arange(n_chunks, dtype=jnp.int32) * MOE_CHUNK, side='right'),
                       0, N_EXPERTS - 1)

    def run(args):
        tok_c, w_c, e = args
        xc = xt[tok_c]
        hc = jax.nn.silu(xc @ w1[e]) * (xc @ w3[e])
        return ((hc @ w2[e]) * w_c[:, None]).astype(xt.dtype)

    out = lax.map(run, (buf_tok.reshape(n_chunks, MOE_CHUNK), buf_w.reshape(n_chunks, MOE_CHUNK), chunk_e))
    y = jnp.zeros((T, D), xt.dtype).at[buf_tok].add(out.reshape(P, D))
    return y.reshape(B, S, D)


def setup_inputs(seed: int = 0) -> dict:
    key = jax.random.key(seed)
    ks = iter(jax.random.split(key, 40))
    f32 = jnp.float32

    def nrm(shape, scale):
        return scale * jax.random.normal(next(ks), shape, f32)

    D, HD = D_MODEL, N_HEADS * HEAD_DIM
    return {
        'x': nrm((BATCH, SEQ, D), 1.0),
        'p': nrm((DEPTH, BATCH, SEQ, PLE_DIM), 1.0),
        'norm_mix': 1.0 + nrm((DEPTH, D), 0.05),
        'norm_ffn': 1.0 + nrm((DEPTH, D), 0.05),
        'norm_ple': 1.0 + nrm((DEPTH, D), 0.05),
        'pool_w': nrm((N_A_LAYERS, len(POOL_WINDOWS), POOL_GROUP_DIM, POOL_GROUP_DIM), POOL_GROUP_DIM ** -0.5),
        'pool_b': nrm((N_A_LAYERS, D), 0.02),
        'pool_scale': 1.0 + nrm((N_A_LAYERS, D), 0.1),
        'kv_norm': 1.0 + nrm((D,), 0.05),
        'w_kv': nrm((D, 2 * N_BRANCH * KV_WIDTH), D ** -0.5),
        'cmp_k_pos': nrm((CMP_BLOCK, HEAD_DIM), 0.1),
        'cmp_k_w1': nrm((CMP_BLOCK, HEAD_DIM, CMP_HIDDEN), (CMP_BLOCK * HEAD_DIM) ** -0.5),
        'cmp_k_b1': nrm((CMP_HIDDEN,), 0.02),
        'cmp_k_w2': nrm((CMP_HIDDEN, HEAD_DIM), CMP_HIDDEN ** -0.5),
        'cmp_k_b2': nrm((HEAD_DIM,), 0.02),
        'cmp_v_pos': nrm((CMP_BLOCK, HEAD_DIM), 0.1),
        'cmp_v_w1': nrm((CMP_BLOCK, HEAD_DIM, CMP_HIDDEN), (CMP_BLOCK * HEAD_DIM) ** -0.5),
        'cmp_v_b1': nrm((CMP_HIDDEN,), 0.02),
        'cmp_v_w2': nrm((CMP_HIDDEN, HEAD_DIM), CMP_HIDDEN ** -0.5),
        'cmp_v_b2': nrm((HEAD_DIM,), 0.02),
        'w_qg': nrm((N_B_LAYERS, D, HD + N_HEADS * N_BRANCH), D ** -0.5),
        'b_gate': nrm((N_B_LAYERS, N_HEADS * N_BRANCH), 0.1),
        'w_o': nrm((N_B_LAYERS, HD, D), HD ** -0.5),
        'router_g_w': nrm((DEPTH, D, N_EXPERT_GROUPS), D ** -0.5),
        'router_g_b': nrm((DEPTH, N_EXPERT_GROUPS), 0.01),
        'router_e_w': nrm((DEPTH, D, N_EXPERTS), D ** -0.5),
        'router_e_b': nrm((DEPTH, N_EXPERTS), 0.01),
        'moe_w1': nrm((DEPTH, N_EXPERTS, D, D_FF_EXPERT), D ** -0.5),
        'moe_w3': nrm((DEPTH, N_EXPERTS, D, D_FF_EXPERT), D ** -0.5),
        'moe_w2': nrm((DEPTH, N_EXPERTS, D_FF_EXPERT, D), D_FF_EXPERT ** -0.5),
        'ple_proj': nrm((DEPTH, PLE_DIM, D), PLE_DIM ** -0.5),
        'ple_gate_w': nrm((DEPTH, D, D), D ** -0.5),
        'ple_gate_b': nrm((DEPTH, D), 0.02),
        'final_norm': 1.0 + nrm((D,), 0.05),
    }


def reference(x, p, norm_mix, norm_ffn, norm_ple, pool_w, pool_b, pool_scale, kv_norm, w_kv,
              cmp_k_pos, cmp_k_w1, cmp_k_b1, cmp_k_w2, cmp_k_b2,
              cmp_v_pos, cmp_v_w1, cmp_v_b1, cmp_v_w2, cmp_v_b2,
              w_qg, b_gate, w_o, router_g_w, router_g_b, router_e_w, router_e_b,
              moe_w1, moe_w3, moe_w2, ple_proj, ple_gate_w, ple_gate_b, final_norm):
    h = x
    shared = None
    for i in range(DEPTH):
        if i == N_A_LAYERS:
            shared = _shared_kv(h, kv_norm, w_kv, cmp_k_pos, cmp_k_w1, cmp_k_b1, cmp_k_w2, cmp_k_b2,
                                cmp_v_pos, cmp_v_w1, cmp_v_b1, cmp_v_w2, cmp_v_b2)
        xn = _rmsnorm(h, norm_mix[i])
        if i < N_A_LAYERS:
            h = h + _pool_mixer(xn, pool_w[i], pool_b[i], pool_scale[i])
        else:
            j = i - N_A_LAYERS
            h = h + _nsa_mixer(xn, w_qg[j], b_gate[j], w_o[j], *shared)
        h = h + _hier_moe(_rmsnorm(h, norm_ffn[i]), router_g_w[i], router_g_b[i], router_e_w[i],
                          router_e_b[i], moe_w1[i], moe_w3[i], moe_w2[i])
        gate = jax.nn.sigmoid(_rmsnorm(h, norm_ple[i]) @ ple_gate_w[i] + ple_gate_b[i])
        h = h + (p[i] @ ple_proj[i]) * gate
    return _rmsnorm(h, final_norm)
```

```cpp
#define MK_LAUNCHES 0
#include <hip/hip_runtime.h>
#include <stdint.h>
#include <stddef.h>
#include <stdio.h>

#define LAS __attribute__((address_space(3)))
typedef unsigned short bf16_t;
typedef short bf16x8 __attribute__((ext_vector_type(8)));
typedef float f32x4 __attribute__((ext_vector_type(4)));
typedef float f32x2 __attribute__((ext_vector_type(2)));
typedef float f32x16 __attribute__((ext_vector_type(16)));
typedef unsigned u32x4 __attribute__((ext_vector_type(4)));
typedef unsigned u32x2 __attribute__((ext_vector_type(2)));

constexpr int T_TOK = 32768, DM = 1024, SEQ = 8192, NBATCH = 4;
constexpr int NEXP = 32, DFF = 512;
constexpr int PMAX = 65536 + 8192;
constexpr float RMS_EPS = 1e-6f;
constexpr float QSCALE = 0.125f * 1.4426950408889634f;

constexpr size_t al256(size_t x) { return (x + 255) & ~(size_t)255; }
constexpr size_t WS_ZERO   = 0;
constexpr size_t ZERO_BYTES = 65536;
constexpr size_t ZO_COUNTS = 16384;
constexpr size_t ZO_CURSOR = 16384 + 1024;
constexpr size_t WS_ROPE   = WS_ZERO + ZERO_BYTES;
constexpr size_t WS_CMPTAB = WS_ROPE + (size_t)SEQ * 16 * 4;
constexpr size_t WS_CB1    = WS_CMPTAB + 8192 * 4;
constexpr size_t WS_WPOOL  = WS_CB1 + 2 * 256 * 4;
constexpr size_t WS_WKVQ   = WS_WPOOL + (size_t)2 * 1024 * 256 * 2;
constexpr size_t WS_WQG1   = WS_WKVQ + (size_t)2816 * 1024 * 2;
constexpr size_t WS_WC1    = WS_WQG1 + (size_t)1280 * 1024 * 2;
constexpr size_t WS_WC2    = WS_WC1 + (size_t)2 * 256 * 2048 * 2;
constexpr size_t WS_WO     = WS_WC2 + (size_t)2 * 256 * 256 * 2;
constexpr size_t WS_WR     = WS_WO + (size_t)2 * 1024 * 1024 * 2;
constexpr size_t WS_WPP    = WS_WR + (size_t)4 * 256 * 1024 * 2;
constexpr size_t WS_WPG    = WS_WPP + (size_t)4 * 1024 * 256 * 2;
constexpr size_t WS_W13    = WS_WPG + (size_t)4 * 1024 * 1024 * 2;
constexpr size_t WS_W2     = WS_W13 + (size_t)128 * 1024 * 1024 * 2;
constexpr size_t WS_PB     = WS_W2 + (size_t)128 * 1024 * 512 * 2;
constexpr size_t WS_HBA    = WS_PB + (size_t)4 * T_TOK * 256 * 2;
constexpr size_t WS_HBB    = WS_HBA + (size_t)T_TOK * 1024 * 2;
constexpr size_t WS_SSQ    = WS_HBB + (size_t)T_TOK * 1024 * 2;
constexpr size_t WS_RSF    = WS_SSQ + (size_t)T_TOK * 16 * 4;
constexpr size_t WS_RSP    = WS_RSF + (size_t)T_TOK * 4;
constexpr size_t WS_TOKE   = WS_RSP + (size_t)T_TOK * 4;
constexpr size_t WS_TOKW   = WS_TOKE + (size_t)T_TOK * 8;
constexpr size_t WS_ROWTAB = WS_TOKW + (size_t)T_TOK * 8;
constexpr size_t WS_ROWOFF = WS_ROWTAB + (size_t)PMAX * 4;
constexpr size_t WS_GATES  = WS_ROWOFF + (size_t)PMAX * 4;
constexpr size_t WS_KC     = WS_GATES + (size_t)T_TOK * 48 * 4;
constexpr size_t WS_VCT    = WS_KC + (size_t)16 * 512 * 64 * 2;
constexpr size_t WS_CHID   = WS_VCT + (size_t)16 * 512 * 64 * 2;
constexpr size_t WS_KS     = WS_CHID + (size_t)2 * 8192 * 256 * 2;
constexpr size_t WS_KW     = WS_KS + (size_t)T_TOK * 256 * 2;
constexpr size_t WS_VST    = WS_KW + (size_t)T_TOK * 256 * 2;
constexpr size_t WS_VWT    = WS_VST + (size_t)T_TOK * 256 * 2;
constexpr size_t WS_ACT    = WS_VWT + (size_t)T_TOK * 256 * 2;
constexpr size_t WS_HBUF   = WS_ACT + (size_t)T_TOK * 1024 * 2;
constexpr size_t WS_SLOT   = WS_HBUF + (size_t)PMAX * 512 * 2;
constexpr size_t WS_END    = WS_SLOT + (size_t)2 * T_TOK * 1024 * 2;
constexpr size_t WS_Q      = WS_HBUF;
constexpr size_t WS_KVC    = WS_SLOT;
constexpr size_t WS_VS     = WS_KVC + (size_t)T_TOK * 512 * 2;
constexpr size_t WS_VW     = WS_VS + (size_t)T_TOK * 256 * 2;

constexpr int LDS_BYTES = 160 * 1024;
constexpr int LDS_MISC  = 128 * 1024;

struct Params {
    const float* in[34];
    float* out;
    unsigned char* ws;
    int p0, p1;
};

template <int N> struct IC { static constexpr int value = N; };
typedef const __attribute__((address_space(4))) Params* KParams;
__device__ __forceinline__ KParams kparams() { KParams q = (KParams)__builtin_amdgcn_kernarg_segment_ptr(); asm volatile("" : "+s"(q)); return q; }

__device__ __forceinline__ unsigned cvt_pk_bf16(float lo, float hi) { unsigned r; asm volatile("v_cvt_pk_bf16_f32 %0, %1, %2" : "=v"(r) : "v"(lo), "v"(hi)); return r; }
__device__ __forceinline__ bf16_t f2bf(float f) { return (bf16_t)(cvt_pk_bf16(f, 0.f) & 0xffffu); }
__device__ __forceinline__ float bf2f(unsigned b) { return __uint_as_float(b << 16); }
__device__ __forceinline__ float wave_sum(float v) {
#pragma unroll
    for (int o = 1; o < 64; o <<= 1) v += __shfl_xor(v, o);
    return v;
}
__device__ __forceinline__ float sigmoidf_(float x) { return 1.f / (1.f + __expf(-x)); }
__device__ __forceinline__ int swap23(int k) { return (k & ~12) | ((k & 4) << 1) | ((k & 8) >> 1); }

#define XB_TMO      128
#define XB_XCNT(j)  (256  + 64 * (j))
#define XB_XSUB(j)  (1280 + 64 * (j))
#define XB_XGEN(j)  (2304 + 64 * (j))
#define XB_TOP      3328
#define XB_TOPGEN   3392
#define XCD_BAR_WORDS 3456
#define XB_SPIN_CAP (1u << 18)
__device__ __forceinline__ unsigned xb_ld(unsigned* p)              { return __hip_atomic_load(p, __ATOMIC_RELAXED, __HIP_MEMORY_SCOPE_AGENT); }
__device__ __forceinline__ unsigned xb_add(unsigned* p, unsigned v) { return __hip_atomic_fetch_add(p, v, __ATOMIC_RELAXED, __HIP_MEMORY_SCOPE_AGENT); }
__device__ __forceinline__ unsigned xb_xcc_id() { return (unsigned)__builtin_amdgcn_s_getreg((3 << 11) | 20) & 0xFu; }
#define XB_SPIN(cond, bar) do { unsigned _sp = 0; while (cond) { __builtin_amdgcn_s_sleep(1); \
    if ((++_sp & 255u) == 0u) { if (xb_ld(&(bar)[XB_TMO])) break; if (_sp > XB_SPIN_CAP) { atomicAdd(&(bar)[XB_TMO], 1u); break; } } } } while (0)
struct XcdBarrier { unsigned* bar; unsigned x; volatile LAS unsigned* st; };
__device__ __forceinline__ XcdBarrier xcd_barrier_post(unsigned* bar, volatile LAS unsigned* st) {
    XcdBarrier b; b.bar = bar; b.x = xb_xcc_id(); b.st = st;
    if (threadIdx.x == 0) (void)xb_add(&bar[XB_XCNT(b.x)], 1u);
    return b;
}
__device__ __forceinline__ void xcd_barrier_complete(unsigned* bar, unsigned x, unsigned& nloc, unsigned& nx) {
    const unsigned G = gridDim.x * gridDim.y * gridDim.z;
    unsigned sum, cnt, mine, sp = 0u;
    for (;;) {
        sum = 0u; cnt = 0u; mine = 0u;
#pragma unroll
        for (unsigned j = 0; j < 16; ++j) { const unsigned c = xb_ld(&bar[XB_XCNT(j)]); sum += c; cnt += (c > 0u) ? 1u : 0u; mine = (j == x) ? c : mine; }
        if (sum == G) break;
        __builtin_amdgcn_s_sleep(1);
        if ((++sp & 255u) == 0u) { if (xb_ld(&bar[XB_TMO])) break; if (sp > XB_SPIN_CAP) { atomicAdd(&bar[XB_TMO], 1u); break; } }
    }
    nloc = mine > 0u ? mine : 1u; nx = cnt > 0u ? cnt : 1u;
}
__device__ __forceinline__ void xcd_barrier(const XcdBarrier& b) {
    asm volatile("s_waitcnt vmcnt(0)" ::: "memory");
    __syncthreads();
    if (threadIdx.x == 0) {
        unsigned* bar = b.bar;
        __builtin_amdgcn_s_waitcnt(0);
        unsigned nloc = b.st[0], nx = b.st[1];
        if (nloc == 0u) { xcd_barrier_complete(bar, b.x, nloc, nx); b.st[0] = nloc; b.st[1] = nx; }
        const unsigned old = xb_add(&bar[XB_XSUB(b.x)], 1u);
        const unsigned gen = old / nloc;
        if (old + 1u == (gen + 1u) * nloc) {
            __builtin_amdgcn_fence(__ATOMIC_RELEASE, "agent");
            asm volatile("s_waitcnt vmcnt(0)" ::: "memory");
            const unsigned og = xb_add(&bar[XB_TOP], 1u);
            const unsigned tg = og / nx;
            if (og + 1u == (tg + 1u) * nx) xb_add(&bar[XB_TOPGEN], 1u);
            else XB_SPIN(xb_ld(&bar[XB_TOPGEN]) == tg, bar);
            __builtin_amdgcn_fence(__ATOMIC_ACQUIRE, "agent");
            xb_add(&bar[XB_XGEN(b.x)], 1u);
            asm volatile("s_waitcnt vmcnt(0)" ::: "memory");
        } else {
            XB_SPIN(xb_ld(&bar[XB_XGEN(b.x)]) == gen, bar);
            __builtin_amdgcn_fence(__ATOMIC_ACQUIRE, "agent");
            asm volatile("s_waitcnt vmcnt(0)" ::: "memory");
        }
    }
    __syncthreads();
}

namespace g8 {
constexpr int BM = 256, BK = 64, HALF = 128, HTB = HALF * BK * 2, STAGE_BYTES = 8 * HTB, NXCD = 8, WGM = 8;
__host__ __device__ __forceinline__ int lds_byte(int r, int c) { const int st = (r >> 4) * 2 + (c >> 5), rr = r & 15, cc = c & 31, ob = rr * 64 + cc * 2; return st * 1024 + (ob ^ (((ob >> 9) & 1) << 5)); }
__host__ __device__ __forceinline__ void stage_rc(int b, int& R, int& C) { const int st = b / 1024, sb = b % 1024, swz = sb ^ (((sb >> 9) & 1) << 5); R = (st >> 1) * 16 + swz / 64; C = (st & 1) * 32 + (swz % 64) / 2; }
__host__ __device__ __forceinline__ int perm32(int rho) { const int n = rho >> 4, i = rho & 15; return 8 * (i >> 2) + 4 * n + (i & 3); }
struct Unit { int pm, pn; };

struct DenseSched {
    int nM, nN, nwg, G, c;
    const char* A; const char* Bt; size_t a_tile_b, a_pn_b, b_tile_b; const unsigned* tab;
    __device__ __forceinline__ void init(int nM_, int nN_) { nM = nM_; nN = nN_; nwg = nM * nN; G = gridDim.x; c = blockIdx.x; tab = nullptr; a_pn_b = 0; }
    __device__ __forceinline__ bool next(int i, Unit& u) const {
        const long L = (long)i * G + c; if (L >= nwg) return false;
        int wgid = (int)L; { const int q = nwg / NXCD, r = nwg % NXCD, xcd = wgid % NXCD, off = wgid / NXCD; wgid = (xcd < r ? xcd * (q + 1) : r * (q + 1) + (xcd - r) * q) + off; }
        const int nig = WGM * nN, gid = wgid / nig, fm = gid * WGM, gsz = (nM - fm) < WGM ? (nM - fm) : WGM;
        u.pm = fm + ((wgid % nig) % gsz); u.pn = (wgid % nig) / gsz; return true;
    }
    __device__ __forceinline__ const char* a_base(const Unit& u) const { return A + (size_t)u.pm * a_tile_b + (size_t)u.pn * a_pn_b; }
    __device__ __forceinline__ const char* b_base(const Unit& u) const { return Bt + (size_t)u.pn * b_tile_b; }
    __device__ __forceinline__ const unsigned* row_tab(const Unit& u) const { return tab + u.pm * 256; }
};
struct MoeSched {
    int nunits, NPN, G, c;
    const char* A; const char* W; size_t a_tile_b, w_e_b, b_tile_b; const unsigned* tab; const LAS unsigned char* tile_e;
    __device__ __forceinline__ bool next(int i, Unit& u) const {
        const long L = (long)i * G + c; if (L >= nunits) return false;
        u.pm = (int)L / NPN; u.pn = (int)L % NPN; return true;
    }
    __device__ __forceinline__ const char* a_base(const Unit& u) const { return A + (size_t)u.pm * a_tile_b; }
    __device__ __forceinline__ const char* b_base(const Unit& u) const { return W + (size_t)tile_e[u.pm] * w_e_b + (size_t)u.pn * b_tile_b; }
    __device__ __forceinline__ const unsigned* row_tab(const Unit& u) const { return tab + u.pm * 256; }
};

template <class Epi, class Sched, bool GATHER>
__device__ __forceinline__ void gemm_phase(LAS unsigned char* lds, const int K_, const int lda_b, const int kstepA, const Sched& S, const Epi& E) {
    int K = K_; asm volatile("" : "+s"(K));
    int tid_ = threadIdx.x; asm volatile("" : "+v"(tid_));
    const int tid = tid_, wid = __builtin_amdgcn_readfirstlane(tid >> 6), lane = tid & 63, wr = wid >> 2, wc = wid & 3, fr = lane & 15, fq = lane >> 4;
    const int nt = K / BK;
    unsigned voffB[2], va[2][2], vn[2][2];
#pragma unroll
    for (int i = 0; i < 2; ++i) { int R, C; stage_rc(tid * 16 + i * 8192, R, C); const int Rb = Epi::PERM ? ((R & ~31) + perm32(R & 31)) : R;
        voffB[i] = (unsigned)(Rb * K + C) * 2u;
        va[0][i] = (unsigned)(R * lda_b + C * 2); va[1][i] = (unsigned)((R + HALF) * lda_b + C * 2); vn[0][i] = va[0][i]; vn[1][i] = va[1][i]; }
    const size_t kstepB = (size_t)(BK * 2);
    const size_t hstepB = (size_t)HALF * K * 2;
    const unsigned ldsw = (unsigned)wid * 1024u;
    const int aoff = lds_byte(wr * 64 + fr, fq * 8), boff = lds_byte(wc * 32 + fr, fq * 8);
#define G8_SA(b, h) (((b) * 2 + (h)) * HTB)
#define G8_SB(b, h) ((4 + (b) * 2 + (h)) * HTB)
#define G8_STAGEB(bufoff, gbase) do { _Pragma("unroll") for (int _i = 0; _i < 2; ++_i) \
        __builtin_amdgcn_global_load_lds((const unsigned*)((const char*)(gbase) + voffB[_i]), (LAS unsigned*)(lds + (bufoff) + ldsw + _i * 8192), 16, 0, 0); } while (0)
#define G8_STAGEA(bufoff, gbase, VA, h) do { _Pragma("unroll") for (int _i = 0; _i < 2; ++_i) \
        __builtin_amdgcn_global_load_lds((const unsigned*)((const char*)(gbase) + (VA)[h][_i]), (LAS unsigned*)(lds + (bufoff) + ldsw + _i * 8192), 16, 0, 0); } while (0)
#define G8_LDA(dst, b, h) do { _Pragma("unroll") for (int m = 0; m < 4; ++m) _Pragma("unroll") for (int k = 0; k < 2; ++k) dst[m][k] = *(const LAS bf16x8*)(lds + G8_SA(b, h) + aoff + m * 2048 + k * 1024); } while (0)
#define G8_LDB(dst, b, h) do { _Pragma("unroll") for (int n = 0; n < 2; ++n) _Pragma("unroll") for (int k = 0; k < 2; ++k) dst[n][k] = *(const LAS bf16x8*)(lds + G8_SB(b, h) + boff + n * 2048 + k * 1024); } while (0)
#define G8_MMA(ai, bj, At, Bt) do { __builtin_amdgcn_s_setprio(1); _Pragma("unroll") for (int m = 0; m < 4; ++m) _Pragma("unroll") for (int n = 0; n < 2; ++n) _Pragma("unroll") for (int k = 0; k < 2; ++k) \
        acc[ai][bj][m][n] = __builtin_amdgcn_mfma_f32_16x16x32_bf16(Bt[n][k], At[m][k], acc[ai][bj][m][n], 0, 0, 0); __builtin_amdgcn_s_setprio(0); } while (0)
#define G8_WAIT_V(n) asm volatile("s_waitcnt vmcnt(" #n ")" ::: "memory")
#define G8_WAIT_L(n) asm volatile("s_waitcnt lgkmcnt(" #n ")" ::: "memory")
#define G8_BAR __builtin_amdgcn_s_barrier()
#define G8_SCHED __builtin_amdgcn_sched_barrier(0)
    Unit cur, nxt; int ui = 0;
    if (!S.next(0, cur)) return;
    f32x4 acc[2][2][4][2];
#pragma unroll
    for (int a = 0; a < 2; ++a)
#pragma unroll
        for (int b = 0; b < 2; ++b)
#pragma unroll
            for (int m = 0; m < 4; ++m)
#pragma unroll
                for (int n = 0; n < 2; ++n) acc[a][b][m][n] = (f32x4){0.f, 0.f, 0.f, 0.f};
    bf16x8 At[4][2], B0[2][2], B1[2][2];
    const char* cA = S.a_base(cur); const char* cB = S.b_base(cur);
    if (GATHER) { const unsigned* tb = S.row_tab(cur);
#pragma unroll
        for (int i = 0; i < 2; ++i) { int R, C; stage_rc(tid * 16 + i * 8192, R, C); va[0][i] = tb[R] + (unsigned)(C * 2); va[1][i] = tb[R + HALF] + (unsigned)(C * 2); } }
    G8_STAGEB(G8_SB(0, 0), cB); G8_STAGEA(G8_SA(0, 0), cA, va, 0); G8_STAGEB(G8_SB(0, 1), cB + hstepB); G8_STAGEA(G8_SA(0, 1), cA, va, 1);
    if (wr == 1) G8_BAR;
    G8_WAIT_V(4); G8_BAR;
    G8_STAGEB(G8_SB(1, 0), cB + kstepB); G8_STAGEA(G8_SA(1, 0), cA + kstepA, va, 0); G8_STAGEB(G8_SB(1, 1), cB + hstepB + kstepB);
    G8_WAIT_V(6); G8_BAR;
    for (;;) {
        const bool has_next = S.next(ui + 1, nxt);
        const char* nA = has_next ? S.a_base(nxt) : cA; const char* nB = has_next ? S.b_base(nxt) : cB;
        if (GATHER) {
            if (has_next) { const unsigned* tb = S.row_tab(nxt);
#pragma unroll
                for (int i = 0; i < 2; ++i) { int R, C; stage_rc(tid * 16 + i * 8192, R, C); vn[0][i] = tb[R] + (unsigned)(C * 2); vn[1][i] = tb[R + HALF] + (unsigned)(C * 2); } }
            else {
#pragma unroll
                for (int i = 0; i < 2; ++i) { vn[0][i] = va[0][i]; vn[1][i] = va[1][i]; } }
        }
        for (int t = 0; t < nt; t += 2) {
            const bool last = (t == nt - 2);
            const char* a1 = cA + (size_t)(t + 1) * kstepA;
            const char* a2 = last ? nA : cA + (size_t)(t + 2) * kstepA; const char* b2 = last ? nB : cB + (size_t)(t + 2) * kstepB;
            const char* a3 = a2 + kstepA; const char* b3 = b2 + kstepB;
            unsigned vx[2][2];
#pragma unroll
            for (int hh = 0; hh < 2; ++hh)
#pragma unroll
                for (int i = 0; i < 2; ++i) vx[hh][i] = (GATHER && last) ? vn[hh][i] : va[hh][i];
            G8_LDB(B0, 0, 0); G8_SCHED; G8_LDA(At, 0, 0); G8_STAGEA(G8_SA(1, 1), a1, va, 1);
            G8_WAIT_L(8); G8_BAR; G8_WAIT_L(0); G8_MMA(0, 0, At, B0); G8_BAR; G8_SCHED;
            G8_LDB(B1, 0, 1); G8_STAGEB(G8_SB(0, 0), b2);
            G8_BAR; G8_WAIT_L(0); G8_MMA(0, 1, At, B1); G8_BAR;
            G8_LDA(At, 0, 1); G8_STAGEA(G8_SA(0, 0), a2, vx, 0);
            G8_BAR; G8_WAIT_L(0); G8_MMA(1, 0, At, B0); G8_BAR; G8_SCHED;
            G8_STAGEB(G8_SB(0, 1), b2 + hstepB);
            G8_WAIT_V(6); G8_BAR; G8_MMA(1, 1, At, B1); G8_BAR;
            G8_LDB(B0, 1, 0); G8_SCHED; G8_LDA(At, 1, 0); G8_STAGEA(G8_SA(0, 1), a2, vx, 1);
            G8_WAIT_L(8); G8_BAR; G8_WAIT_L(0); G8_MMA(0, 0, At, B0); G8_BAR; G8_SCHED;
            G8_LDB(B1, 1, 1); G8_STAGEB(G8_SB(1, 0), b3);
            G8_BAR; G8_WAIT_L(0); G8_MMA(0, 1, At, B1); G8_BAR;
            G8_LDA(At, 1, 1); G8_STAGEA(G8_SA(1, 0), a3, vx, 0);
            G8_BAR; G8_WAIT_L(0); G8_MMA(1, 0, At, B0); G8_BAR; G8_SCHED;
            G8_STAGEB(G8_SB(1, 1), b3 + hstepB);
            G8_WAIT_V(6); G8_BAR; G8_MMA(1, 1, At, B1); G8_BAR;
        }
        E(acc, cur, wr, wc, fr, fq);
        if (!has_next) break;
#pragma unroll
        for (int a = 0; a < 2; ++a)
#pragma unroll
            for (int b = 0; b < 2; ++b)
#pragma unroll
                for (int m = 0; m < 4; ++m)
#pragma unroll
                    for (int n = 0; n < 2; ++n) acc[a][b][m][n] = (f32x4){0.f, 0.f, 0.f, 0.f};
        cur = nxt; cA = nA; cB = nB; ++ui;
        if (GATHER) {
#pragma unroll
            for (int i = 0; i < 2; ++i) { va[0][i] = vn[0][i]; va[1][i] = vn[1][i]; } }
    }
    G8_WAIT_V(0);
    if (wr == 0) G8_BAR;
    G8_BAR;
#undef G8_SA
#undef G8_SB
#undef G8_STAGEA
#undef G8_STAGEB
#undef G8_LDA
#undef G8_LDB
#undef G8_MMA
#undef G8_WAIT_V
#undef G8_WAIT_L
#undef G8_BAR
#undef G8_SCHED
}
}
using g8::Unit;

typedef f32x4 AccT[2][2][4][2];

template <int MODE> struct EpiResid {
    static constexpr bool PERM = false;
    int L;
    __device__ __forceinline__ void operator()(const AccT& acc, const Unit& u, int wr, int wc, int fr, int fq) const {
        KParams Q = kparams(); unsigned char* ws = Q->ws;
        const float* hin = (MODE == 1 && L == 0) ? Q->in[0] : Q->out; float* hout = Q->out; bf16_t* hb = (bf16_t*)(ws + WS_HBA); float* ssq = (float*)(ws + WS_SSQ);
        const float* bias = (MODE == 1) ? Q->in[6] + L * 1024 : Q->in[32] + L * 1024; const float* scale = Q->in[7] + L * 1024;
        const bf16_t* ple = (const bf16_t*)(ws + WS_ACT); const float* rstd = (const float*)(ws + WS_RSP);
        const int col0 = u.pn * 256 + wc * 32 + 4 * fq;
        f32x4 bv[2][2], sv[2][2];
#pragma unroll
        for (int bj = 0; bj < 2; ++bj)
#pragma unroll
            for (int n = 0; n < 2; ++n) {
                bv[bj][n] = (MODE != 0) ? *(const f32x4*)(bias + col0 + bj * 128 + n * 16) : (f32x4){0.f, 0.f, 0.f, 0.f};
                sv[bj][n] = (MODE == 1) ? *(const f32x4*)(scale + col0 + bj * 128 + n * 16) : (f32x4){1.f, 1.f, 1.f, 1.f}; }
#pragma unroll
        for (int ai = 0; ai < 2; ++ai)
#pragma unroll
            for (int m = 0; m < 4; ++m) {
                const int row = u.pm * 256 + ai * 128 + wr * 64 + m * 16 + fr;
                const size_t off = (size_t)row * DM + col0;
                float rs = 1.f; if (MODE == 2) rs = rstd[row];
                float ss = 0.f;
#pragma unroll
                for (int bj = 0; bj < 2; ++bj)
#pragma unroll
                    for (int n = 0; n < 2; ++n) {
                        const size_t o = off + bj * 128 + n * 16;
                        const f32x4 hv = *(const f32x4*)(hin + o);
                        f32x4 v = acc[ai][bj][m][n];
                        if (MODE == 1) v = (v + bv[bj][n]) * sv[bj][n];
                        if (MODE == 2) { const u32x2 pw = *(const u32x2*)(ple + o);
                            f32x4 pl = {bf2f(pw.x & 0xffffu), bf2f(pw.x >> 16), bf2f(pw.y & 0xffffu), bf2f(pw.y >> 16)};
                            f32x4 z = v * rs + bv[bj][n];
                            v = (f32x4){pl.x * sigmoidf_(z.x), pl.y * sigmoidf_(z.y), pl.z * sigmoidf_(z.z), pl.w * sigmoidf_(z.w)}; }
                        v = v + hv;
                        *(f32x4*)(hout + o) = v;
                        u32x2 w; w.x = cvt_pk_bf16(v.x, v.y); w.y = cvt_pk_bf16(v.z, v.w);
                        *(u32x2*)(hb + o) = w;
                        ss += v.x * v.x + v.y * v.y + v.z * v.z + v.w * v.w;
                    }
                ss += __shfl_xor(ss, 16); ss += __shfl_xor(ss, 32);
                if (fq == 0) ssq[(size_t)row * 16 + u.pn * 4 + wc] = ss;
            }
    }
};

__device__ __forceinline__ float rstd_from_parts(const float* ssq, int row) {
    const f32x4* p = (const f32x4*)(ssq + (size_t)row * 16);
    const f32x4 a = p[0], b = p[1], c = p[2], d = p[3];
    const float s = ((a.x + a.y) + (a.z + a.w)) + ((b.x + b.y) + (b.z + b.w)) + ((c.x + c.y) + (c.z + c.w)) + ((d.x + d.y) + (d.z + d.w));
    return 1.f / sqrtf(s * (1.f / DM) + RMS_EPS);
}

struct EpiRouter {
    static constexpr bool PERM = false;
    int L; LAS unsigned* hist;
    __device__ __forceinline__ void operator()(const AccT& acc, const Unit& u, int wr, int wc, int fr, int fq) const {
        if (wc != 0) return;
        KParams Q = kparams(); unsigned char* ws = Q->ws;
        const float* ssq = (const float*)(ws + WS_SSQ); const float* gb = Q->in[24] + L * 4; const float* eb = Q->in[26] + L * 32;
        int* toke = (int*)(ws + WS_TOKE); float* tokw = (float*)(ws + WS_TOKW); float* rsf = (float*)(ws + WS_RSF);
#pragma unroll
        for (int ai = 0; ai < 2; ++ai)
#pragma unroll
            for (int m = 0; m < 4; ++m) {
                const int row = u.pm * 256 + ai * 128 + wr * 64 + m * 16 + fr;
                const float rs = rstd_from_parts(ssq, row);
                float gl[4];
#pragma unroll
                for (int i = 0; i < 4; ++i) gl[i] = __shfl(acc[ai][1][m][0][i], fr) * rs + gb[i];
                int grp = 0; float gm = gl[0];
#pragma unroll
                for (int i = 1; i < 4; ++i) if (gl[i] > gm) { gm = gl[i]; grp = i; }
                float gs = 0.f;
#pragma unroll
                for (int i = 0; i < 4; ++i) gs += __expf(gl[i] - gm);
                const float gprob = 1.f / gs;
                f32x4 mine;
#pragma unroll
                for (int i = 0; i < 4; ++i) { float x0 = acc[ai][0][m][0][i], x1 = acc[ai][0][m][1][i]; asm volatile("" : "+v"(x0), "+v"(x1)); mine[i] = (grp >> 1) ? x1 : x0; }
                const int src0 = fr + 16 * (2 * (grp & 1));
                float el[8];
#pragma unroll
                for (int i = 0; i < 4; ++i) { el[i] = __shfl(mine[i], src0); el[4 + i] = __shfl(mine[i], src0 + 16); }
#pragma unroll
                for (int j = 0; j < 8; ++j) el[j] = el[j] * rs + eb[grp * 8 + j];
                int i1 = 0; float v1 = el[0];
#pragma unroll
                for (int j = 1; j < 8; ++j) if (el[j] > v1) { v1 = el[j]; i1 = j; }
                int i2 = -1; float v2 = -3.0e38f;
#pragma unroll
                for (int j = 0; j < 8; ++j) if (j != i1 && el[j] > v2) { v2 = el[j]; i2 = j; }
                const float e2 = __expf(v2 - v1), inv = 1.f / (1.f + e2);
                if (fq == 0) {
                    const int e1g = grp * 8 + i1, e2g = grp * 8 + i2;
                    *(int2*)(toke + (size_t)row * 2) = make_int2(e1g, e2g);
                    *(float2*)(tokw + (size_t)row * 2) = make_float2(gprob * inv, gprob * e2 * inv);
                    rsf[row] = rs;
                    atomicAdd((unsigned*)&hist[e1g], 1u); atomicAdd((unsigned*)&hist[e2g], 1u);
                }
            }
    }
};

struct EpiMoe1 {
    static constexpr bool PERM = true;
    int dummy;
    __device__ __forceinline__ void operator()(const AccT& acc, const Unit& u, int wr, int wc, int fr, int fq) const {
        KParams Q = kparams(); unsigned char* ws = Q->ws;
        const int* rowtab = (const int*)(ws + WS_ROWTAB); const float* rsf = (const float*)(ws + WS_RSF); bf16_t* hbuf = (bf16_t*)(ws + WS_HBUF);
        const int hc0 = u.pn * 128 + wc * 16 + 4 * fq;
#pragma unroll
        for (int ai = 0; ai < 2; ++ai)
#pragma unroll
            for (int m = 0; m < 4; ++m) {
                const int pos = u.pm * 256 + ai * 128 + wr * 64 + m * 16 + fr;
                const int a = rowtab[pos];
                if (a < 0) continue;
                const float rs = rsf[a >> 1];
#pragma unroll
                for (int bj = 0; bj < 2; ++bj) {
                    const f32x4 g = acc[ai][bj][m][0] * rs, uu = acc[ai][bj][m][1] * rs;
                    f32x4 o;
#pragma unroll
                    for (int i = 0; i < 4; ++i) o[i] = g[i] * sigmoidf_(g[i]) * uu[i];
                    u32x2 w; w.x = cvt_pk_bf16(o.x, o.y); w.y = cvt_pk_bf16(o.z, o.w);
                    *(u32x2*)(hbuf + (size_t)pos * DFF + hc0 + bj * 64) = w;
                }
            }
    }
};
struct EpiMoe2 {
    static constexpr bool PERM = true;
    int dummy;
    __device__ __forceinline__ void operator()(const AccT& acc, const Unit& u, int wr, int wc, int fr, int fq) const {
        KParams Q = kparams(); unsigned char* ws = Q->ws;
        const int* rowtab = (const int*)(ws + WS_ROWTAB); const float* tokw = (const float*)(ws + WS_TOKW); bf16_t* slot = (bf16_t*)(ws + WS_SLOT);
        const int col0 = u.pn * 256 + wc * 32 + 8 * fq;
#pragma unroll
        for (int ai = 0; ai < 2; ++ai)
#pragma unroll
            for (int m = 0; m < 4; ++m) {
                const int pos = u.pm * 256 + ai * 128 + wr * 64 + m * 16 + fr;
                const int a = rowtab[pos];
                if (a < 0) continue;
                const float w = tokw[a];
#pragma unroll
                for (int bj = 0; bj < 2; ++bj) {
                    const f32x4 v0 = acc[ai][bj][m][0] * w, v1 = acc[ai][bj][m][1] * w;
                    u32x4 o; o.x = cvt_pk_bf16(v0.x, v0.y); o.y = cvt_pk_bf16(v0.z, v0.w); o.z = cvt_pk_bf16(v1.x, v1.y); o.w = cvt_pk_bf16(v1.z, v1.w);
                    *(u32x4*)(slot + (size_t)a * DM + col0 + bj * 128) = o;
                }
            }
    }
};
struct EpiBf16 {
    static constexpr bool PERM = true;
    int dummy;
    __device__ __forceinline__ void operator()(const AccT& acc, const Unit& u, int wr, int wc, int fr, int fq) const {
        KParams Q = kparams(); bf16_t* O = (bf16_t*)(Q->ws + WS_ACT); constexpr int ldc = 1024;
        const int col0 = u.pn * 256 + wc * 32 + 8 * fq;
#pragma unroll
        for (int ai = 0; ai < 2; ++ai)
#pragma unroll
            for (int m = 0; m < 4; ++m) {
                const int row = u.pm * 256 + ai * 128 + wr * 64 + m * 16 + fr;
#pragma unroll
                for (int bj = 0; bj < 2; ++bj) {
                    const f32x4 v0 = acc[ai][bj][m][0], v1 = acc[ai][bj][m][1];
                    u32x4 o; o.x = cvt_pk_bf16(v0.x, v0.y); o.y = cvt_pk_bf16(v0.z, v0.w); o.z = cvt_pk_bf16(v1.x, v1.y); o.w = cvt_pk_bf16(v1.z, v1.w);
                    *(u32x4*)(O + (size_t)row * ldc + col0 + bj * 128) = o;
                }
            }
    }
};
struct EpiQkv {
    static constexpr bool PERM = true;
    int tile0; int J;
    __device__ __forceinline__ void operator()(const AccT& acc, const Unit& u, int wr, int wc, int fr, int fq) const {
        KParams Q = kparams(); unsigned char* ws = Q->ws;
        const float* ssq = (const float*)(ws + WS_SSQ); const float* rope = (const float*)(ws + WS_ROPE); const float* bgate = Q->in[21] + J * 48;
        bf16_t* kvc = (bf16_t*)(ws + WS_KVC); bf16_t* ks = (bf16_t*)(ws + WS_KS); bf16_t* vs = (bf16_t*)(ws + WS_VS); bf16_t* kw = (bf16_t*)(ws + WS_KW); bf16_t* vw = (bf16_t*)(ws + WS_VW);
        bf16_t* q = (bf16_t*)(ws + WS_Q); float* gates = (float*)(ws + WS_GATES);
        const int ty = u.pn + tile0;
        const int cu0 = wc * 32 + 8 * fq;
        const bool roped = (ty == 2 || ty == 4 || ty >= 6) && ty != 10;
        const bool dorope = roped && ((wc & 1) == 0);
        bf16_t* dst; int ldc; int cbase;
        if (ty < 2)       { dst = kvc; ldc = 512;  cbase = ty * 256; }
        else if (ty == 2) { dst = ks;  ldc = 256;  cbase = 0; }
        else if (ty == 3) { dst = vs;  ldc = 256;  cbase = 0; }
        else if (ty == 4) { dst = kw;  ldc = 256;  cbase = 0; }
        else if (ty == 5) { dst = vw;  ldc = 256;  cbase = 0; }
        else              { dst = q;   ldc = 1024; cbase = (ty - 6) * 256; }
#pragma unroll
        for (int ai = 0; ai < 2; ++ai)
#pragma unroll
            for (int m = 0; m < 4; ++m) {
                const int row = u.pm * 256 + ai * 128 + wr * 64 + m * 16 + fr;
                const float rs = rstd_from_parts(ssq, row);
                if (ty == 10) {
                    if (wc < 2) {
#pragma unroll
                        for (int n = 0; n < 2; ++n) {
                            const int c = cu0 + 4 * n;
                            if (c < 48) { f32x4 z = acc[ai][0][m][n] * rs + *(const f32x4*)(bgate + c);
                                f32x4 o = {sigmoidf_(z.x), sigmoidf_(z.y), sigmoidf_(z.z), sigmoidf_(z.w)};
                                *(f32x4*)(gates + (size_t)row * 48 + c) = o; }
                        }
                    }
                    continue;
                }
                f32x4 cs[2], sn[2];
                if (dorope) { const float* rp = rope + (size_t)(row & (SEQ - 1)) * 16;
                    cs[0] = *(const f32x4*)(rp); cs[1] = *(const f32x4*)(rp + 4); sn[0] = *(const f32x4*)(rp + 8); sn[1] = *(const f32x4*)(rp + 12); }
#pragma unroll
                for (int bj = 0; bj < 2; ++bj) {
                    f32x4 v[2];
#pragma unroll
                    for (int n = 0; n < 2; ++n) {
                        v[n] = acc[ai][bj][m][n] * rs;
                        if (dorope) {
                            f32x4 ot;
#pragma unroll
                            for (int i = 0; i < 4; ++i) ot[i] = __shfl_xor(v[n][i], 16);
                            if (fq == 0) v[n] = v[n] * cs[n] - ot * sn[n];
                            else if (fq == 1) v[n] = v[n] * cs[n] + ot * sn[n];
                        }
                        if (ty >= 6) v[n] = v[n] * QSCALE;
                    }
                    u32x4 o; o.x = cvt_pk_bf16(v[0].x, v[0].y); o.y = cvt_pk_bf16(v[0].z, v[0].w); o.z = cvt_pk_bf16(v[1].x, v[1].y); o.w = cvt_pk_bf16(v[1].z, v[1].w);
                    *(u32x4*)(dst + (size_t)row * ldc + cbase + cu0 + bj * 128) = o;
                }
            }
    }
};
__device__ __forceinline__ float gelu_tanh(float x) {
    const float u = 0.7978845608028654f * (x + 0.044715f * x * x * x);
    const float t = 1.f - 2.f / (1.f + __expf(2.f * u));
    return 0.5f * x * (1.f + t);
}
struct EpiCmp1 {
    static constexpr bool PERM = true;
    int dummy;
    __device__ __forceinline__ void operator()(const AccT& acc, const Unit& u, int wr, int wc, int fr, int fq) const {
        KParams Q = kparams(); unsigned char* ws = Q->ws; const float* cb1 = (const float*)(ws + WS_CB1); bf16_t* chid = (bf16_t*)(ws + WS_CHID);
        const int col0 = wc * 32 + 8 * fq;
        bf16_t* O = chid + (size_t)u.pn * 8192 * 256;
#pragma unroll
        for (int ai = 0; ai < 2; ++ai)
#pragma unroll
            for (int m = 0; m < 4; ++m) {
                const int row = u.pm * 256 + ai * 128 + wr * 64 + m * 16 + fr;
#pragma unroll
                for (int bj = 0; bj < 2; ++bj) {
                    const int c = col0 + bj * 128;
                    const f32x4 b0 = *(const f32x4*)(cb1 + u.pn * 256 + c), b1 = *(const f32x4*)(cb1 + u.pn * 256 + c + 4);
                    const f32x4 v0 = acc[ai][bj][m][0] + b0, v1 = acc[ai][bj][m][1] + b1;
                    u32x4 o; o.x = cvt_pk_bf16(gelu_tanh(v0.x), gelu_tanh(v0.y)); o.y = cvt_pk_bf16(gelu_tanh(v0.z), gelu_tanh(v0.w));
                    o.z = cvt_pk_bf16(gelu_tanh(v1.x), gelu_tanh(v1.y)); o.w = cvt_pk_bf16(gelu_tanh(v1.z), gelu_tanh(v1.w));
                    *(u32x4*)(O + (size_t)row * 256 + c) = o;
                }
            }
    }
};
struct EpiCmp2 {
    static constexpr bool PERM = true;
    int dummy;
    __device__ __forceinline__ void operator()(const AccT& acc, const Unit& u, int wr, int wc, int fr, int fq) const {
        if (wc >= 2) return;
        KParams Q = kparams(); unsigned char* ws = Q->ws; const float* b2k = Q->in[14]; const float* b2v = Q->in[19]; const float* rope = (const float*)(ws + WS_ROPE);
        bf16_t* kc = (bf16_t*)(ws + WS_KC); bf16_t* vct = (bf16_t*)(ws + WS_VCT);
        const int c0 = wc * 32 + 8 * fq;
        const float* b2 = u.pn ? b2v : b2k;
        const f32x4 bb0 = *(const f32x4*)(b2 + c0), bb1 = *(const f32x4*)(b2 + c0 + 4);
#pragma unroll
        for (int ai = 0; ai < 2; ++ai)
#pragma unroll
            for (int m = 0; m < 4; ++m) {
                const int row = u.pm * 256 + ai * 128 + wr * 64 + m * 16 + fr;
                const int bg = row >> 9, n = row & 511;
                f32x4 v[2]; v[0] = acc[ai][0][m][0] + bb0; v[1] = acc[ai][0][m][1] + bb1;
                if (u.pn == 0) {
                    if (wc == 0) {
                        const int pos = (16 * n + 31) & (SEQ - 1);
                        const float* rp = rope + (size_t)pos * 16;
#pragma unroll
                        for (int nn = 0; nn < 2; ++nn) {
                            const f32x4 cs = *(const f32x4*)(rp + 4 * nn), sn = *(const f32x4*)(rp + 8 + 4 * nn);
                            f32x4 ot;
#pragma unroll
                            for (int i = 0; i < 4; ++i) ot[i] = __shfl_xor(v[nn][i], 16);
                            if (fq == 0) v[nn] = v[nn] * cs - ot * sn; else if (fq == 1) v[nn] = v[nn] * cs + ot * sn;
                        }
                    }
                    if (n == 511) { v[0] = (f32x4){0.f, 0.f, 0.f, 0.f}; v[1] = v[0]; }
                    u32x4 o; o.x = cvt_pk_bf16(v[0].x, v[0].y); o.y = cvt_pk_bf16(v[0].z, v[0].w); o.z = cvt_pk_bf16(v[1].x, v[1].y); o.w = cvt_pk_bf16(v[1].z, v[1].w);
                    *(u32x4*)(kc + ((size_t)bg * 512 + n) * 64 + c0) = o;
                } else {
                    const int np = swap23(n);
#pragma unroll
                    for (int nn = 0; nn < 2; ++nn)
#pragma unroll
                        for (int i = 0; i < 4; ++i) vct[((size_t)bg * 64 + c0 + 4 * nn + i) * 512 + np] = (n == 511) ? (bf16_t)0 : f2bf(v[nn][i]);
                }
            }
    }
};
template <class F>
__device__ __forceinline__ void cvt_family(LAS float* scr, bf16_t* dst, int nbatch, int Nd, int K, const F& f) {
    const int tilesN = Nd / 64, tilesK = K / 64, per = tilesN * tilesK, items = nbatch * per;
    int tid_ = threadIdx.x; asm volatile("" : "+v"(tid_));
    const int tid = tid_;
    for (int it = blockIdx.x; it < items; it += gridDim.x) {
        const int b = it / per, r = it % per, n0 = (r / tilesK) * 64, k0 = (r % tilesK) * 64;
#pragma unroll
        for (int i = 0; i < 8; ++i) { const int kk = (tid >> 6) + 8 * i, nn = tid & 63; scr[kk * 65 + nn] = f(b, k0 + kk, n0 + nn); }
        __syncthreads();
        { const int nn = tid >> 3, kc = tid & 7; const LAS float* s = scr + (8 * kc) * 65 + nn;
          u32x4 o; o.x = cvt_pk_bf16(s[0], s[65]); o.y = cvt_pk_bf16(s[2 * 65], s[3 * 65]); o.z = cvt_pk_bf16(s[4 * 65], s[5 * 65]); o.w = cvt_pk_bf16(s[6 * 65], s[7 * 65]);
          *(u32x4*)(dst + ((size_t)b * Nd + n0 + nn) * K + k0 + 8 * kc) = o; }
        __syncthreads();
    }
}

__device__ __forceinline__ void prologue_phase(LAS unsigned char* lds, const Params& p) {
    LAS float* scr = (LAS float*)lds;
    unsigned char* ws = p.ws;
    const int tid = threadIdx.x;
    const size_t gtid = (size_t)blockIdx.x * 512 + tid, gsz = (size_t)gridDim.x * 512;
    { float* rope = (float*)(ws + WS_ROPE);
      for (size_t i = gtid; i < (size_t)SEQ * 8; i += gsz) { const int pos = (int)(i >> 3), f = (int)(i & 7);
          const float inv = (float)pow(500000.0, -(double)f / 8.0); const float ang = (float)pos * inv;
          rope[pos * 16 + f] = (float)cos((double)ang); rope[pos * 16 + 8 + f] = (float)sin((double)ang); } }
    { unsigned* tab = (unsigned*)(ws + WS_CMPTAB);
      for (size_t i = gtid; i < 8192; i += gsz) { const int bg = (int)(i >> 9), n = (int)(i & 511), b = bg >> 2, g = bg & 3, nc = n > 510 ? 510 : n;
          tab[i] = (unsigned)((((size_t)b * SEQ + 16 * nc) * 512 + g * 64) * 2); } }
    if (blockIdx.x == 0) { float* cb1 = (float*)(ws + WS_CB1); const int which = tid >> 8, hh = tid & 255;
        const float* pos = which ? p.in[15] : p.in[10]; const float* w1 = which ? p.in[16] : p.in[11]; const float* b1 = which ? p.in[17] : p.in[12];
        float s = b1[hh]; for (int k = 0; k < 2048; ++k) s += pos[k] * w1[(size_t)k * 256 + hh];
        cb1[which * 256 + hh] = s; }
    { const f32x4* src = (const f32x4*)p.in[1]; u32x2* dst = (u32x2*)(ws + WS_PB);
      for (size_t i = gtid; i < (size_t)4 * T_TOK * 256 / 4; i += gsz) { const f32x4 v = src[i]; u32x2 o; o.x = cvt_pk_bf16(v.x, v.y); o.y = cvt_pk_bf16(v.z, v.w); dst[i] = o; } }
    { const float* pw = p.in[5];
      cvt_family(scr, (bf16_t*)(ws + WS_WPOOL), 2, 1024, 256, [=](int b, int k, int nd) { return pw[(((size_t)b * 4 + (nd >> 8)) * 256 + k) * 256 + (nd & 255)]; }); }
    { const float* wkv = p.in[9]; const float* kvn = p.in[8]; const float* wqg = p.in[20]; const float* nm = p.in[2] + 2 * 1024;
      cvt_family(scr, (bf16_t*)(ws + WS_WKVQ), 1, 2816, 1024, [=](int b, int k, int nd) {
          if (nd < 1536) return wkv[(size_t)k * 1536 + nd] * kvn[k];
          if (nd < 1536 + 1072) return wqg[(size_t)k * 1072 + (nd - 1536)] * nm[k];
          return 0.f; }); }
    { const float* wqg = p.in[20] + (size_t)1024 * 1072; const float* nm = p.in[2] + 3 * 1024;
      cvt_family(scr, (bf16_t*)(ws + WS_WQG1), 1, 1280, 1024, [=](int b, int k, int nd) { return nd < 1072 ? wqg[(size_t)k * 1072 + nd] * nm[k] : 0.f; }); }
    { const float* wk = p.in[11]; const float* wv = p.in[16];
      cvt_family(scr, (bf16_t*)(ws + WS_WC1), 2, 256, 2048, [=](int b, int k, int nd) { return (b ? wv : wk)[(size_t)k * 256 + nd]; }); }
    { const float* wk = p.in[13]; const float* wv = p.in[18];
      cvt_family(scr, (bf16_t*)(ws + WS_WC2), 2, 256, 256, [=](int b, int k, int nd) { return nd < 64 ? (b ? wv : wk)[(size_t)k * 64 + nd] : 0.f; }); }
    { const float* wo = p.in[22];
      cvt_family(scr, (bf16_t*)(ws + WS_WO), 2, 1024, 1024, [=](int b, int k, int nd) { return wo[((size_t)b * 1024 + k) * 1024 + nd]; }); }
    { const float* rg = p.in[23]; const float* re = p.in[25]; const float* nf = p.in[3];
      cvt_family(scr, (bf16_t*)(ws + WS_WR), 4, 256, 1024, [=](int b, int k, int nd) {
          if (nd < 32) return re[((size_t)b * 1024 + k) * 32 + nd] * nf[b * 1024 + k];
          if (nd >= 128 && nd < 132) return rg[((size_t)b * 1024 + k) * 4 + (nd - 128)] * nf[b * 1024 + k];
          return 0.f; }); }
    { const float* pp = p.in[30];
      cvt_family(scr, (bf16_t*)(ws + WS_WPP), 4, 1024, 256, [=](int b, int k, int nd) { return pp[((size_t)b * 256 + k) * 1024 + nd]; }); }
    { const float* pg = p.in[31]; const float* np = p.in[4];
      cvt_family(scr, (bf16_t*)(ws + WS_WPG), 4, 1024, 1024, [=](int b, int k, int nd) { return pg[((size_t)b * 1024 + k) * 1024 + nd] * np[b * 1024 + k]; }); }
    { const float* w1 = p.in[27]; const float* w3 = p.in[28]; const float* nf = p.in[3];
      cvt_family(scr, (bf16_t*)(ws + WS_W13), 128, 1024, 1024, [=](int b, int k, int nd) {
          const int c8 = nd >> 3, i = nd & 7; const long dlt = (const char*)w3 - (const char*)w1; const float* w = (const float*)((const char*)w1 + ((i < 4) ? 0l : dlt));
          return w[((size_t)b * 1024 + k) * 512 + 4 * c8 + (i & 3)] * nf[(b >> 5) * 1024 + k]; }); }
    { const float* w2 = p.in[29];
      cvt_family(scr, (bf16_t*)(ws + WS_W2), 128, 1024, 512, [=](int b, int k, int nd) { return w2[((size_t)b * 512 + k) * 1024 + nd]; }); }
}

template <int W>
__device__ __forceinline__ void stencil_rows(const float* h, const LAS float* rs, const float gx, const float gy, bf16_t* pooled, int r0, int s0, int c0) {
    f32x2 buf[16];
#pragma unroll
    for (int j = 0; j < 16; ++j) buf[j] = (f32x2){0.f, 0.f};
    for (int ch = 0; ch < 9; ++ch) {
        f32x2 ld[16];
#pragma unroll
        for (int j = 0; j < 16; ++j) { const int rr = ch * 16 + j; const bool ok = (ch > 0) || (s0 > 0);
            ld[j] = ok ? *(const f32x2*)(h + (size_t)(r0 - 16 + rr) * DM + c0) : (f32x2){0.f, 0.f}; }
#pragma unroll
        for (int j = 0; j < 16; ++j) { const int rr = ch * 16 + j; const float r = rs[rr];
            f32x2 xn; xn.x = ld[j].x * r * gx; xn.y = ld[j].y * r * gy;
            buf[j] = xn;
            if (ch > 0) {
                f32x2 s = xn;
#pragma unroll
                for (int i = 1; i < W; ++i) s = s + buf[(j - i) & 15];
                const int sp = s0 + rr - 16;
                const int cnt = (sp + 1 < W) ? (sp + 1) : W;
                const float ic = 1.f / (float)cnt;
                const float ox = s.x * ic - xn.x, oy = s.y * ic - xn.y;
                *(unsigned*)(pooled + (size_t)(r0 - 16 + rr) * DM + c0) = cvt_pk_bf16(ox, oy);
            }
        }
    }
}
__device__ __forceinline__ void stencil_phase(LAS unsigned char* lds, const float* h, const float* gain, bf16_t* pooled) {
    LAS float* rs = (LAS float*)lds;
    int tid_ = threadIdx.x; asm volatile("" : "+v"(tid_));
    const int tid = tid_, w = tid >> 6, lane = tid & 63;
    for (int it = blockIdx.x; it < T_TOK / 128; it += gridDim.x) {
        const int r0 = it * 128, s0 = r0 & (SEQ - 1);
        for (int rr = w; rr < 144; rr += 8) {
            const int row = r0 - 16 + rr; float v = 0.f;
            if (rr >= 16 || s0 > 0) { const f32x4* xr = (const f32x4*)(h + (size_t)row * DM) + lane; float s = 0.f;
#pragma unroll
                for (int j = 0; j < 4; ++j) { const f32x4 x = xr[64 * j]; s += x.x * x.x + x.y * x.y + x.z * x.z + x.w * x.w; }
                s = wave_sum(s); v = 1.f / sqrtf(s * (1.f / DM) + RMS_EPS); }
            if (lane == 0) rs[rr] = v;
        }
        __syncthreads();
        const int c0 = 2 * tid, gi = tid >> 7; const float gx = gain[c0], gy = gain[c0 + 1];
        if (gi == 0) stencil_rows<2>(h, rs, gx, gy, pooled, r0, s0, c0);
        else if (gi == 1) stencil_rows<4>(h, rs, gx, gy, pooled, r0, s0, c0);
        else if (gi == 2) stencil_rows<8>(h, rs, gx, gy, pooled, r0, s0, c0);
        else stencil_rows<16>(h, rs, gx, gy, pooled, r0, s0, c0);
        __syncthreads();
    }
}

__device__ __forceinline__ int moe_tables(LAS unsigned char* lds, const unsigned* counts) {
    LAS unsigned* pstart = (LAS unsigned*)(lds + LDS_MISC);
    LAS unsigned char* tile_e = lds + LDS_MISC + 256;
    __syncthreads();
    if (threadIdx.x == 0) { unsigned acc = 0;
        for (int e = 0; e < NEXP; ++e) { pstart[e] = acc; const unsigned nt = (counts[e] + 255u) >> 8; for (unsigned t = 0; t < nt; ++t) tile_e[(acc >> 8) + t] = (unsigned char)e; acc += nt << 8; }
        pstart[NEXP] = acc; }
    __syncthreads();
    return (int)(pstart[NEXP] >> 8);
}
__device__ __forceinline__ void scatter_phase(LAS unsigned char* lds, const unsigned* counts, unsigned* cursor, const int* toke, int* rowtab, unsigned* rowoff) {
    moe_tables(lds, counts);
    LAS unsigned* pstart = (LAS unsigned*)(lds + LDS_MISC);
    LAS unsigned* cl = (LAS unsigned*)(lds + LDS_MISC + 1024);
    const int tid = threadIdx.x;
    for (int it = blockIdx.x; it < 2 * T_TOK / 256; it += gridDim.x) {
        if (tid < 64) cl[tid] = 0;
        __syncthreads();
        int a = -1, e = 0; unsigned rank = 0;
        if (tid < 256) { a = it * 256 + tid; e = toke[a]; rank = __hip_atomic_fetch_add(&cl[e], 1u, __ATOMIC_RELAXED, __HIP_MEMORY_SCOPE_WORKGROUP); }
        __syncthreads();
        if (tid < 32) { const unsigned n = cl[tid]; cl[32 + tid] = n ? __hip_atomic_fetch_add(cursor + tid, n, __ATOMIC_RELAXED, __HIP_MEMORY_SCOPE_AGENT) : 0u; }
        __syncthreads();
        if (tid < 256) { const unsigned pos = pstart[e] + cl[32 + e] + rank; rowtab[pos] = a; rowoff[pos] = (unsigned)(a >> 1) * 2048u; }
        __syncthreads();
    }
    if (blockIdx.x < NEXP) { const int e = blockIdx.x; const unsigned lo = pstart[e] + counts[e], hi = pstart[e + 1];
        for (unsigned pos = lo + tid; pos < hi; pos += 512) { rowtab[pos] = -1; rowoff[pos] = 0u; } }
}

__device__ __forceinline__ void e1_phase(float* h, const bf16_t* slot, bf16_t* hb, float* rsp) {
    int tid_ = threadIdx.x; asm volatile("" : "+v"(tid_));
    const int w = tid_ >> 6, lane = tid_ & 63;
    for (int row = blockIdx.x * 8 + w; row < T_TOK; row += gridDim.x * 8) {
        f32x4* hr = (f32x4*)(h + (size_t)row * DM) + lane;
        const u32x2* s0 = (const u32x2*)(slot + (size_t)(2 * row) * DM) + lane; const u32x2* s1 = (const u32x2*)(slot + (size_t)(2 * row + 1) * DM) + lane;
        u32x2* ob = (u32x2*)(hb + (size_t)row * DM) + lane;
        float ss = 0.f;
#pragma unroll
        for (int j = 0; j < 4; ++j) { f32x4 v = hr[64 * j]; const u32x2 a = s0[64 * j], b = s1[64 * j];
            v.x += bf2f(a.x & 0xffffu) + bf2f(b.x & 0xffffu); v.y += bf2f(a.x >> 16) + bf2f(b.x >> 16);
            v.z += bf2f(a.y & 0xffffu) + bf2f(b.y & 0xffffu); v.w += bf2f(a.y >> 16) + bf2f(b.y >> 16);
            hr[64 * j] = v; u32x2 o; o.x = cvt_pk_bf16(v.x, v.y); o.y = cvt_pk_bf16(v.z, v.w); ob[64 * j] = o;
            ss += v.x * v.x + v.y * v.y + v.z * v.z + v.w * v.w; }
        ss = wave_sum(ss);
        if (lane == 0) rsp[row] = 1.f / sqrtf(ss * (1.f / DM) + RMS_EPS);
    }
}
__device__ __forceinline__ void final_phase(float* h, const float* gain) {
    int tid_ = threadIdx.x; asm volatile("" : "+v"(tid_));
    const int w = tid_ >> 6, lane = tid_ & 63;
    for (int row = blockIdx.x * 8 + w; row < T_TOK; row += gridDim.x * 8) {
        f32x4* hr = (f32x4*)(h + (size_t)row * DM) + lane; const f32x4* gr = (const f32x4*)gain + lane;
        f32x4 v[4]; float ss = 0.f;
#pragma unroll
        for (int j = 0; j < 4; ++j) { v[j] = hr[64 * j]; ss += v[j].x * v[j].x + v[j].y * v[j].y + v[j].z * v[j].z + v[j].w * v[j].w; }
        ss = wave_sum(ss); const float r = 1.f / sqrtf(ss * (1.f / DM) + RMS_EPS);
#pragma unroll
        for (int j = 0; j < 4; ++j) hr[64 * j] = v[j] * r * gr[64 * j];
    }
}
__device__ __forceinline__ void vtrans_phase(LAS unsigned char* lds, const bf16_t* vs, const bf16_t* vw, bf16_t* vst, bf16_t* vwt) {
    LAS bf16_t* tl = (LAS bf16_t*)lds;
    int tid_ = threadIdx.x; asm volatile("" : "+v"(tid_));
    const int tid = tid_;
    for (int it = blockIdx.x; it < 2 * 16 * 128; it += gridDim.x) {
        const int which = it >> 11, r = it & 2047, bg = r >> 7, kt = r & 127, b = bg >> 2, g = bg & 3;
        const bf16_t* src = which ? vw : vs; bf16_t* dst = which ? vwt : vst;
        { const int key = tid >> 3, ch = tid & 7;
          const u32x4 v = *(const u32x4*)(src + ((size_t)b * SEQ + kt * 64 + key) * 256 + g * 64 + ch * 8);
          const int kp = swap23(key);
          const unsigned wv[4] = {v.x, v.y, v.z, v.w};
#pragma unroll
          for (int i = 0; i < 4; ++i) { tl[(ch * 8 + 2 * i) * 72 + kp] = (bf16_t)(wv[i] & 0xffffu); tl[(ch * 8 + 2 * i + 1) * 72 + kp] = (bf16_t)(wv[i] >> 16); } }
        __syncthreads();
        { const int d = tid >> 3, ch = tid & 7;
          const u32x4 v = *(const LAS u32x4*)(tl + d * 72 + ch * 8);
          *(u32x4*)(dst + ((size_t)bg * 64 + d) * SEQ + kt * 64 + ch * 8) = v; }
        __syncthreads();
    }
}

struct AttnArgs { const bf16_t* q; const float* gates; const bf16_t* kc; const bf16_t* vct; const bf16_t* ks; const bf16_t* vst; const bf16_t* kw; const bf16_t* vwt; bf16_t* out; };
#define ATT_MFMA(a, b, c) __builtin_amdgcn_mfma_f32_32x32x16_bf16(a, b, c, 0, 0, 0)
constexpr int ATP = 144;
constexpr int ATILE = 64 * ATP;
__device__ __forceinline__ void attn_phase(LAS unsigned char* lds, const AttnArgs& a) {
    int tid_ = threadIdx.x; asm volatile("" : "+v"(tid_));
    const int tid = tid_, w = tid >> 6, lane = tid & 63, n = lane & 31, h = lane >> 5;
    LAS unsigned char* KT = lds; LAS unsigned char* VT = lds + 2 * ATILE;
    LAS float* imp = (LAS float*)(lds + 4 * ATILE); LAS unsigned* selm = (LAS unsigned*)(lds + 4 * ATILE + 32768);
    const int srow = tid >> 3, sch = tid & 7;
    for (int it = blockIdx.x; it < 2048; it += gridDim.x) {
        const int rk = 7 - (it >> 8), cc = it & 255, bg = cc & 15, js = cc >> 4, b = bg >> 2, g = bg & 3;
        const int qb = (rk & 1) ? (16 * rk + 15 - js) : (16 * rk + js);
        const int tl = w * 8 + (n >> 2), t = qb * 64 + tl, hd = g * 4 + (n & 3);
        const size_t trow = (size_t)b * SEQ + t;
        bf16x8 Qf[4];
#pragma unroll
        for (int s = 0; s < 4; ++s) Qf[s] = *(const bf16x8*)(a.q + trow * 1024 + hd * 64 + 16 * s + 8 * h);
        const float g0 = a.gates[trow * 48 + hd * 3 + 0], g1 = a.gates[trow * 48 + hd * 3 + 1], g2 = a.gates[trow * 48 + hd * 3 + 2];
        for (int i = tid; i < 8192; i += 512) imp[i] = 0.f;
        const int nct = (4 * qb + 3 + 63) >> 6, wlo = qb > 8 ? qb - 8 : 0, nwin = qb - wlo + 1;
        const int e0 = nct, e1 = 2 * nct, e2 = 2 * nct + qb + 1, total = e2 + nwin;
        const int limc = (t >= 31) ? ((t - 31) >> 4) : -1;
        const char* kcb = (const char*)(a.kc + (size_t)bg * 512 * 64); const char* vcb = (const char*)(a.vct + (size_t)bg * 64 * 512);
        const char* ksb = (const char*)(a.ks + (size_t)b * SEQ * 256 + g * 64); const char* kwb = (const char*)(a.kw + (size_t)b * SEQ * 256 + g * 64);
        const char* vsb = (const char*)(a.vst + (size_t)bg * 64 * SEQ); const char* vwb = (const char*)(a.vwt + (size_t)bg * 64 * SEQ);
        u32x4 kreg, vreg;
#define ATT_FETCH(s_) do { const int s__ = (s_); const char* kp; const char* vp; \
            if (s__ < e1) { const int ct = s__ < e0 ? s__ : s__ - e0; kp = kcb + (size_t)(ct * 64 + srow) * 128 + sch * 16; vp = vcb + (size_t)srow * 1024 + ct * 128 + sch * 16; } \
            else if (s__ < e2) { const int j = s__ - e1; kp = ksb + (size_t)(j * 64 + srow) * 512 + sch * 16; vp = vsb + (size_t)srow * (SEQ * 2) + j * 128 + sch * 16; } \
            else { const int kt = wlo + s__ - e2; kp = kwb + (size_t)(kt * 64 + srow) * 512 + sch * 16; vp = vwb + (size_t)srow * (SEQ * 2) + kt * 128 + sch * 16; } \
            kreg = *(const u32x4*)kp; vreg = *(const u32x4*)vp; } while (0)
#define ATT_PUT(s_) do { const int bsel = (s_) & 1; *(LAS u32x4*)(KT + bsel * ATILE + srow * ATP + sch * 16) = kreg; *(LAS u32x4*)(VT + bsel * ATILE + srow * ATP + sch * 16) = vreg; } while (0)
        __syncthreads();
        ATT_FETCH(0); ATT_PUT(0);
        __syncthreads();
        f32x16 OUT[2], O[2];
#pragma unroll
        for (int d = 0; d < 2; ++d)
#pragma unroll
            for (int r = 0; r < 16; ++r) { OUT[d][r] = 0.f; O[d][r] = 0.f; }
        float mrun = -1e30f, lrun = 0.f, mc = -1e30f, invlc = 0.f;
        unsigned mw0 = 0, mw1 = 0, mw2 = 0, mw3 = 0;
        for (int s = 0; s < total; ++s) {
            if (s + 1 < total) ATT_FETCH(s + 1);
            const LAS unsigned char* Kb = KT + (s & 1) * ATILE; const LAS unsigned char* Vb = VT + (s & 1) * ATILE;
            int lo = 0, hi = -1; int type;
            if (s < e0) { type = 0; hi = limc - 64 * s; }
            else if (s < e1) { type = 1; hi = limc - 64 * (s - e0); }
            else if (s < e2) { type = 2; const int j = s - e1; const unsigned wsel = (j < 32) ? mw0 : (j < 64) ? mw1 : (j < 96) ? mw2 : mw3;
                hi = ((wsel >> (j & 31)) & 1u) ? (t - 64 * j) : -1; }
            else { type = 3; const int kt = wlo + s - e2; lo = t - 511 - 64 * kt; hi = t - 64 * kt; }
            if (hi > 63) hi = 63; if (lo < 0) lo = 0;
            const bool act = __ballot(lo <= hi) != 0ull;
            if (act) {
                f32x16 S[2];
#pragma unroll
                for (int kh = 0; kh < 2; ++kh) {
#pragma unroll
                    for (int r = 0; r < 16; ++r) S[kh][r] = 0.f;
#pragma unroll
                    for (int ks = 0; ks < 4; ++ks) { const bf16x8 A = *(const LAS bf16x8*)(Kb + (32 * kh + n) * ATP + 32 * ks + 16 * h); S[kh] = ATT_MFMA(A, Qf[ks], S[kh]); }
                }
                const int lo4 = lo - 4 * h, hi4 = hi - 4 * h;
                float mx = -1e30f;
#pragma unroll
                for (int kh = 0; kh < 2; ++kh)
#pragma unroll
                    for (int r = 0; r < 16; ++r) { const int cr = 32 * kh + (r & 3) + 8 * (r >> 2); const bool ok = (cr >= lo4) && (cr <= hi4);
                        const float sv = ok ? S[kh][r] : -1e30f; S[kh][r] = sv; mx = fmaxf(mx, sv); }
                mx = fmaxf(mx, __shfl_xor(mx, 32));
                float mref, pscale;
                if (type == 1) { mref = mc; pscale = invlc; }
                else { const float mnew = fmaxf(mrun, mx); const float alpha = __builtin_amdgcn_exp2f(mrun - mnew); mrun = mnew; lrun *= alpha; mref = mnew; pscale = 1.f;
                    if (type >= 2) {
#pragma unroll
                        for (int d = 0; d < 2; ++d)
#pragma unroll
                            for (int r = 0; r < 16; ++r) O[d][r] *= alpha; } }
                float rsum = 0.f;
#pragma unroll
                for (int kh = 0; kh < 2; ++kh)
#pragma unroll
                    for (int r = 0; r < 16; ++r) { const float sv = S[kh][r]; const float pv = (sv > -1e29f) ? __builtin_amdgcn_exp2f(sv - mref) * pscale : 0.f; S[kh][r] = pv; rsum += pv; }
                rsum += __shfl_xor(rsum, 32);
                if (type != 1) lrun += rsum;
                if (type == 1) {
                    const int ct = s - e0;
#pragma unroll
                    for (int kh = 0; kh < 2; ++kh)
#pragma unroll
                        for (int q4 = 0; q4 < 4; ++q4) {
                            float G = (S[kh][4 * q4] + S[kh][4 * q4 + 1]) + (S[kh][4 * q4 + 2] + S[kh][4 * q4 + 3]); float E = S[kh][4 * q4 + 3];
                            G += __shfl_xor(G, 1); G += __shfl_xor(G, 2); E += __shfl_xor(E, 1); E += __shfl_xor(E, 2);
                            const int jj = 16 * ct + 8 * kh + 2 * q4 + h;
                            if ((lane & 3) == 0) { imp[tl * 128 + jj] += G; if (jj + 1 < 128) imp[tl * 128 + jj + 1] += E; }
                        }
                }
                if (type >= 1) {
                    bf16x8 Pf[4];
#pragma unroll
                    for (int k4 = 0; k4 < 4; ++k4) { const int kh = k4 >> 1, sb = (k4 & 1) * 8; u32x4 pk;
                        pk.x = cvt_pk_bf16(S[kh][sb + 0], S[kh][sb + 1]); pk.y = cvt_pk_bf16(S[kh][sb + 2], S[kh][sb + 3]);
                        pk.z = cvt_pk_bf16(S[kh][sb + 4], S[kh][sb + 5]); pk.w = cvt_pk_bf16(S[kh][sb + 6], S[kh][sb + 7]);
                        Pf[k4] = __builtin_bit_cast(bf16x8, pk); }
#pragma unroll
                    for (int dt = 0; dt < 2; ++dt)
#pragma unroll
                        for (int k4 = 0; k4 < 4; ++k4) { const bf16x8 A = *(const LAS bf16x8*)(Vb + (32 * dt + n) * ATP + 32 * k4 + 16 * h); O[dt] = ATT_MFMA(A, Pf[k4], O[dt]); }
                }
            }
            if (s == e0 - 1) { mc = mrun; invlc = lrun > 0.f ? 1.f / lrun : 0.f; mrun = -1e30f; lrun = 0.f; }
            if (s == e1 - 1) {
#pragma unroll
                for (int d = 0; d < 2; ++d)
#pragma unroll
                    for (int r = 0; r < 16; ++r) { OUT[d][r] = g0 * O[d][r]; O[d][r] = 0.f; }
                mrun = -1e30f; lrun = 0.f;
                for (int tk = 0; tk < 8; ++tk) {
                    const int tok = w * 8 + tk; unsigned m0 = 0, m1 = 0, m2 = 0, m3 = 0;
                    if (qb < 16) { m0 = (2u << qb) - 1u; }
                    else {
                        const float c0 = imp[tok * 128 + lane], c1 = imp[tok * 128 + 64 + lane];
                        const bool v0 = (lane >= 1) && (lane <= qb - 2), v1 = (64 + lane) <= qb - 2;
                        unsigned k0h = v0 ? __float_as_uint(c0) : 0u, k0l = v0 ? (unsigned)(127 - lane) : 0u;
                        unsigned k1h = v1 ? __float_as_uint(c1) : 0u, k1l = v1 ? (unsigned)(63 - lane) : 0u;
#define ATT_SETB(j) do { const int j_ = (j); const unsigned bit_ = 1u << (j_ & 31); const int w_ = j_ >> 5; m0 |= (w_ == 0) ? bit_ : 0u; m1 |= (w_ == 1) ? bit_ : 0u; m2 |= (w_ == 2) ? bit_ : 0u; m3 |= (w_ == 3) ? bit_ : 0u; } while (0)
                        ATT_SETB(0); ATT_SETB(qb); ATT_SETB(qb - 1);
                        for (int itn = 0; itn < 13; ++itn) {
                            const bool f1 = (k1h > k0h) || (k1h == k0h && k1l > k0l);
                            unsigned bh = f1 ? k1h : k0h, bl = f1 ? k1l : k0l;
#pragma unroll
                            for (int o = 1; o < 64; o <<= 1) { const unsigned oh = __shfl_xor(bh, o), ol = __shfl_xor(bl, o); const bool tk2 = (oh > bh) || (oh == bh && ol > bl); bh = tk2 ? oh : bh; bl = tk2 ? ol : bl; }
                            const int jst = 127 - (int)(bl & 255u);
                            ATT_SETB(jst);
                            if (k0h == bh && k0l == bl) { k0h = 0u; k0l = 0u; } else if (k1h == bh && k1l == bl) { k1h = 0u; k1l = 0u; }
                        }
                    }
                    if (lane == 0) { selm[tok * 4 + 0] = m0; selm[tok * 4 + 1] = m1; selm[tok * 4 + 2] = m2; selm[tok * 4 + 3] = m3; }
                }
                mw0 = selm[tl * 4 + 0]; mw1 = selm[tl * 4 + 1]; mw2 = selm[tl * 4 + 2]; mw3 = selm[tl * 4 + 3];
            }
            if (s == e2 - 1 || s == total - 1) {
                const float gg = (s == e2 - 1) ? g1 : g2; const float sc = gg / fmaxf(lrun, 1e-30f);
#pragma unroll
                for (int d = 0; d < 2; ++d)
#pragma unroll
                    for (int r = 0; r < 16; ++r) { OUT[d][r] += sc * O[d][r]; O[d][r] = 0.f; }
                mrun = -1e30f; lrun = 0.f;
            }
            if (s + 1 < total) ATT_PUT(s + 1);
            __syncthreads();
        }
#pragma unroll
        for (int dt = 0; dt < 2; ++dt)
#pragma unroll
            for (int rq = 0; rq < 4; ++rq) { u32x2 o; o.x = cvt_pk_bf16(OUT[dt][4 * rq], OUT[dt][4 * rq + 1]); o.y = cvt_pk_bf16(OUT[dt][4 * rq + 2], OUT[dt][4 * rq + 3]);
                *(u32x2*)(a.out + trow * 1024 + hd * 64 + 32 * dt + 8 * rq + 4 * h) = o; }
#undef ATT_FETCH
#undef ATT_PUT
    }
}
constexpr int NPHASES = 1 + 8 + 8 + 11 + 9 + 1;


__global__ void __launch_bounds__(512, 2) yoco_fwd(Params p_unused) {
    extern __shared__ __attribute__((aligned(16))) unsigned char smem_[];
    LAS unsigned char* lds = (LAS unsigned char*)smem_;
    int p0, p1; { KParams Q = kparams(); p0 = Q->p0; p1 = Q->p1; }
    const bool multi = (p1 - p0) > 1;
    LAS unsigned* xbw = (LAS unsigned*)(lds + LDS_BYTES - 16);
    unsigned xcc = 0;
    if (multi) {
        if (threadIdx.x == 0) { xbw[0] = 0u; xbw[1] = 0u; xbw[2] = 0u; xbw[3] = 0u; }
        __syncthreads();
        KParams Q = kparams();
        XcdBarrier b0 = xcd_barrier_post((unsigned*)(Q->ws + WS_ZERO), (volatile LAS unsigned*)xbw); xcc = b0.x;
    }
    int pid = 0;
#define PH_BEGIN { const int me_ = pid++; if (p0 <= me_ && me_ < p1) { KParams Q = kparams(); unsigned char* ws = Q->ws; (void)ws;
#define PH_END   } if (p0 <= me_ && me_ + 1 < p1) { KParams Q2 = kparams(); XcdBarrier bar; bar.bar = (unsigned*)(Q2->ws + WS_ZERO); bar.x = xcc; bar.st = (volatile LAS unsigned*)xbw; xcd_barrier(bar); } }
#define WSP(T, off) ((T*)(ws + (off)))

    PH_BEGIN Params pl; pl.ws = ws; pl.out = Q->out; for (int i = 0; i < 34; ++i) pl.in[i] = Q->in[i]; prologue_phase(lds, pl); PH_END

    auto layer = [&](auto LC) __attribute__((always_inline)) {
        constexpr int L = decltype(LC)::value;
        if (L < 2) {
            PH_BEGIN stencil_phase(lds, (L == 0) ? Q->in[0] : Q->out, Q->in[2] + L * 1024, WSP(bf16_t, WS_ACT)); PH_END
            PH_BEGIN
                g8::DenseSched S; S.init(T_TOK / 256, 4); S.A = (const char*)(ws + WS_ACT); S.a_tile_b = (size_t)256 * 2048; S.a_pn_b = 512;
                S.Bt = (const char*)(ws + WS_WPOOL + (size_t)L * 1024 * 256 * 2); S.b_tile_b = (size_t)256 * 256 * 2;
                EpiResid<1> E; E.L = L;
                g8::gemm_phase<EpiResid<1>, g8::DenseSched, false>(lds, 256, 2048, 128, S, E);
            PH_END
        } else {
            const int J = L - 2;
            PH_BEGIN
                g8::DenseSched S; S.init(T_TOK / 256, J == 0 ? 11 : 5); S.A = (const char*)(ws + WS_HBA); S.a_tile_b = (size_t)256 * 2048;
                S.Bt = (const char*)(ws + (J == 0 ? WS_WKVQ : WS_WQG1)); S.b_tile_b = (size_t)256 * 1024 * 2;
                EpiQkv E; E.tile0 = (J == 0) ? 0 : 6; E.J = J;
                g8::gemm_phase<EpiQkv, g8::DenseSched, false>(lds, 1024, 2048, 128, S, E);
            PH_END
            if (J == 0) {
                PH_BEGIN
                    vtrans_phase(lds, WSP(bf16_t, WS_VS), WSP(bf16_t, WS_VW), WSP(bf16_t, WS_VST), WSP(bf16_t, WS_VWT));
                    __syncthreads();
                    g8::DenseSched S; S.init(32, 2); S.A = (const char*)(ws + WS_KVC); S.a_tile_b = 0; S.a_pn_b = 512; S.tab = WSP(unsigned, WS_CMPTAB);
                    S.Bt = (const char*)(ws + WS_WC1); S.b_tile_b = (size_t)256 * 2048 * 2;
                    EpiCmp1 E; E.dummy = 0;
                    g8::gemm_phase<EpiCmp1, g8::DenseSched, true>(lds, 2048, 0, 1024, S, E);
                PH_END
                PH_BEGIN
                    g8::DenseSched S; S.init(32, 2); S.A = (const char*)(ws + WS_CHID); S.a_tile_b = (size_t)256 * 512; S.a_pn_b = (size_t)8192 * 512;
                    S.Bt = (const char*)(ws + WS_WC2); S.b_tile_b = (size_t)256 * 256 * 2;
                    EpiCmp2 E; E.dummy = 0;
                    g8::gemm_phase<EpiCmp2, g8::DenseSched, false>(lds, 256, 512, 128, S, E);
                PH_END
            }
            PH_BEGIN
                AttnArgs a; a.q = WSP(bf16_t, WS_Q); a.gates = WSP(float, WS_GATES); a.kc = WSP(bf16_t, WS_KC); a.vct = WSP(bf16_t, WS_VCT);
                a.ks = WSP(bf16_t, WS_KS); a.vst = WSP(bf16_t, WS_VST); a.kw = WSP(bf16_t, WS_KW); a.vwt = WSP(bf16_t, WS_VWT); a.out = WSP(bf16_t, WS_ACT);
                attn_phase(lds, a);
            PH_END
            PH_BEGIN
                g8::DenseSched S; S.init(T_TOK / 256, 4); S.A = (const char*)(ws + WS_ACT); S.a_tile_b = (size_t)256 * 2048;
                S.Bt = (const char*)(ws + WS_WO + (size_t)J * 1024 * 1024 * 2); S.b_tile_b = (size_t)256 * 1024 * 2;
                EpiResid<0> E; E.L = L;
                g8::gemm_phase<EpiResid<0>, g8::DenseSched, false>(lds, 1024, 2048, 128, S, E);
            PH_END
        }
        PH_BEGIN
            unsigned* counts = WSP(unsigned, WS_ZERO + ZO_COUNTS) + L * 32;
            LAS unsigned* hist = (LAS unsigned*)(lds + LDS_MISC);
            if (threadIdx.x < 32) hist[threadIdx.x] = 0u;
            __syncthreads();
            g8::DenseSched S; S.init(T_TOK / 256, 1); S.A = (const char*)(ws + WS_HBA); S.a_tile_b = (size_t)256 * 2048;
            S.Bt = (const char*)(ws + WS_WR + (size_t)L * 256 * 1024 * 2); S.b_tile_b = 0;
            EpiRouter E; E.L = L; E.hist = hist;
            g8::gemm_phase<EpiRouter, g8::DenseSched, false>(lds, 1024, 2048, 128, S, E);
            __syncthreads();
            if (threadIdx.x < 32 && hist[threadIdx.x]) __hip_atomic_fetch_add(counts + threadIdx.x, hist[threadIdx.x], __ATOMIC_RELAXED, __HIP_MEMORY_SCOPE_AGENT);
        PH_END
        PH_BEGIN scatter_phase(lds, WSP(unsigned, WS_ZERO + ZO_COUNTS) + L * 32, WSP(unsigned, WS_ZERO + ZO_CURSOR) + L * 32, WSP(int, WS_TOKE), WSP(int, WS_ROWTAB), WSP(unsigned, WS_ROWOFF)); PH_END
        PH_BEGIN
            const int ntiles = moe_tables(lds, WSP(unsigned, WS_ZERO + ZO_COUNTS) + L * 32);
            g8::MoeSched S; S.nunits = ntiles * 4; S.NPN = 4; S.G = gridDim.x; S.c = blockIdx.x; S.A = (const char*)(ws + WS_HBA); S.a_tile_b = 0;
            S.W = (const char*)(ws + WS_W13 + (size_t)L * 32 * 1024 * 1024 * 2); S.w_e_b = (size_t)1024 * 1024 * 2; S.b_tile_b = (size_t)256 * 1024 * 2;
            S.tab = WSP(unsigned, WS_ROWOFF); S.tile_e = lds + LDS_MISC + 256;
            EpiMoe1 E; E.dummy = 0;
            g8::gemm_phase<EpiMoe1, g8::MoeSched, true>(lds, 1024, 0, 128, S, E);
        PH_END
        PH_BEGIN
            const int ntiles = moe_tables(lds, WSP(unsigned, WS_ZERO + ZO_COUNTS) + L * 32);
            g8::MoeSched S; S.nunits = ntiles * 4; S.NPN = 4; S.G = gridDim.x; S.c = blockIdx.x; S.A = (const char*)(ws + WS_HBUF); S.a_tile_b = (size_t)256 * 1024;
            S.W = (const char*)(ws + WS_W2 + (size_t)L * 32 * 1024 * 512 * 2); S.w_e_b = (size_t)1024 * 512 * 2; S.b_tile_b = (size_t)256 * 512 * 2;
            S.tab = nullptr; S.tile_e = lds + LDS_MISC + 256;
            EpiMoe2 E; E.dummy = 0;
            g8::gemm_phase<EpiMoe2, g8::MoeSched, false>(lds, 512, 1024, 128, S, E);
        PH_END
        PH_BEGIN
            e1_phase(Q->out, WSP(bf16_t, WS_SLOT), WSP(bf16_t, WS_HBB), WSP(float, WS_RSP));
            g8::DenseSched S; S.init(T_TOK / 256, 4); S.A = (const char*)(ws + WS_PB + (size_t)L * T_TOK * 256 * 2); S.a_tile_b = (size_t)256 * 512;
            S.Bt = (const char*)(ws + WS_WPP + (size_t)L * 1024 * 256 * 2); S.b_tile_b = (size_t)256 * 256 * 2;
            EpiBf16 E; E.dummy = 0;
            g8::gemm_phase<EpiBf16, g8::DenseSched, false>(lds, 256, 512, 128, S, E);
        PH_END
        PH_BEGIN
            g8::DenseSched S; S.init(T_TOK / 256, 4); S.A = (const char*)(ws + WS_HBB); S.a_tile_b = (size_t)256 * 2048;
            S.Bt = (const char*)(ws + WS_WPG + (size_t)L * 1024 * 1024 * 2); S.b_tile_b = (size_t)256 * 1024 * 2;
            EpiResid<2> E; E.L = L;
            g8::gemm_phase<EpiResid<2>, g8::DenseSched, false>(lds, 1024, 2048, 128, S, E);
        PH_END
    };
    layer(IC<0>{}); layer(IC<1>{}); layer(IC<2>{}); layer(IC<3>{});
    PH_BEGIN final_phase(Q->out, Q->in[33]); PH_END
#undef PH_BEGIN
#undef PH_END
}

#ifndef MK_LAUNCHES
#define MK_LAUNCHES 0
#endif

extern "C" void kernel_launch(void* const* d_in, const int* in_sizes, int n_in, void* d_out, int out_size, void* d_ws, size_t ws_size, hipStream_t stream) {
    static int ready = 0;
    if (!ready) {
        if (n_in != 34 || out_size != T_TOK * DM || ws_size < WS_END) { fprintf(stderr, "kernel_launch: unexpected sizes (n_in %d out %d ws %zu need %zu)\n", n_in, out_size, ws_size, (size_t)WS_END); ready = -1; return; }
        if (hipFuncSetAttribute((const void*)yoco_fwd, hipFuncAttributeMaxDynamicSharedMemorySize, LDS_BYTES) != hipSuccess) { fprintf(stderr, "kernel_launch: hipFuncSetAttribute failed\n"); ready = -1; return; }
        int per_cu = 0;
        if (hipOccupancyMaxActiveBlocksPerMultiprocessor(&per_cu, (const void*)yoco_fwd, 512, LDS_BYTES) != hipSuccess || per_cu < 1) fprintf(stderr, "kernel_launch: occupancy query reports %d\n", per_cu);
        (void)hipGetLastError();
        ready = 1;
    }
    if (ready < 0) return;
    (void)hipMemsetAsync((char*)d_ws + WS_ZERO, 0, ZERO_BYTES, stream);
    Params p{};
    for (int i = 0; i < 34; ++i) p.in[i] = (const float*)d_in[i];
    p.out = (float*)d_out; p.ws = (unsigned char*)d_ws;
#if MK_LAUNCHES == 1
    p.p0 = 0; p.p1 = NPHASES;
    hipLaunchKernelGGL(yoco_fwd, dim3(256), dim3(512), LDS_BYTES, stream, p);
#else
    for (int ph = 0; ph < NPHASES; ++ph) { p.p0 = ph; p.p1 = ph + 1; hipLaunchKernelGGL(yoco_fwd, dim3(256), dim3(512), LDS_BYTES, stream, p); }
#endif
}
```

```cpp
#define MK_LAUNCHES 1
#include <hip/hip_runtime.h>
#include <stdint.h>
#include <stddef.h>
#include <stdio.h>

#define LAS __attribute__((address_space(3)))
typedef unsigned short bf16_t;
typedef short bf16x8 __attribute__((ext_vector_type(8)));
typedef float f32x4 __attribute__((ext_vector_type(4)));
typedef float f32x2 __attribute__((ext_vector_type(2)));
typedef float f32x16 __attribute__((ext_vector_type(16)));
typedef unsigned u32x4 __attribute__((ext_vector_type(4)));
typedef unsigned u32x2 __attribute__((ext_vector_type(2)));

constexpr int T_TOK = 32768, DM = 1024, SEQ = 8192, NBATCH = 4;
constexpr int NEXP = 32, DFF = 512;
constexpr int PMAX = 65536 + 8192;
constexpr float RMS_EPS = 1e-6f;
constexpr float QSCALE = 0.125f * 1.4426950408889634f;

constexpr size_t al256(size_t x) { return (x + 255) & ~(size_t)255; }
constexpr size_t WS_ZERO   = 0;
constexpr size_t ZERO_BYTES = 65536;
constexpr size_t ZO_COUNTS = 16384;
constexpr size_t ZO_CURSOR = 16384 + 1024;
constexpr size_t WS_ROPE   = WS_ZERO + ZERO_BYTES;
constexpr size_t WS_CMPTAB = WS_ROPE + (size_t)SEQ * 16 * 4;
constexpr size_t WS_CB1    = WS_CMPTAB + 8192 * 4;
constexpr size_t WS_WPOOL  = WS_CB1 + 2 * 256 * 4;
constexpr size_t WS_WKVQ   = WS_WPOOL + (size_t)2 * 1024 * 256 * 2;
constexpr size_t WS_WQG1   = WS_WKVQ + (size_t)2816 * 1024 * 2;
constexpr size_t WS_WC1    = WS_WQG1 + (size_t)1280 * 1024 * 2;
constexpr size_t WS_WC2    = WS_WC1 + (size_t)2 * 256 * 2048 * 2;
constexpr size_t WS_WO     = WS_WC2 + (size_t)2 * 256 * 256 * 2;
constexpr size_t WS_WR     = WS_WO + (size_t)2 * 1024 * 1024 * 2;
constexpr size_t WS_WPP    = WS_WR + (size_t)4 * 256 * 1024 * 2;
constexpr size_t WS_WPG    = WS_WPP + (size_t)4 * 1024 * 256 * 2;
constexpr size_t WS_W13    = WS_WPG + (size_t)4 * 1024 * 1024 * 2;
constexpr size_t WS_W2     = WS_W13 + (size_t)128 * 1024 * 1024 * 2;
constexpr size_t WS_PB     = WS_W2 + (size_t)128 * 1024 * 512 * 2;
constexpr size_t WS_HBA    = WS_PB + (size_t)4 * T_TOK * 256 * 2;
constexpr size_t WS_HBB    = WS_HBA + (size_t)T_TOK * 1024 * 2;
constexpr size_t WS_SSQ    = WS_HBB + (size_t)T_TOK * 1024 * 2;
constexpr size_t WS_RSF    = WS_SSQ + (size_t)T_TOK * 16 * 4;
constexpr size_t WS_RSP    = WS_RSF + (size_t)T_TOK * 4;
constexpr size_t WS_TOKE   = WS_RSP + (size_t)T_TOK * 4;
constexpr size_t WS_TOKW   = WS_TOKE + (size_t)T_TOK * 8;
constexpr size_t WS_ROWTAB = WS_TOKW + (size_t)T_TOK * 8;
constexpr size_t WS_ROWOFF = WS_ROWTAB + (size_t)PMAX * 4;
constexpr size_t WS_GATES  = WS_ROWOFF + (size_t)PMAX * 4;
constexpr size_t WS_KC     = WS_GATES + (size_t)T_TOK * 48 * 4;
constexpr size_t WS_VCT    = WS_KC + (size_t)16 * 512 * 64 * 2;
constexpr size_t WS_CHID   = WS_VCT + (size_t)16 * 512 * 64 * 2;
constexpr size_t WS_KS     = WS_CHID + (size_t)2 * 8192 * 256 * 2;
constexpr size_t WS_KW     = WS_KS + (size_t)T_TOK * 256 * 2;
constexpr size_t WS_VST    = WS_KW + (size_t)T_TOK * 256 * 2;
constexpr size_t WS_VWT    = WS_VST + (size_t)T_TOK * 256 * 2;
constexpr size_t WS_ACT    = WS_VWT + (size_t)T_TOK * 256 * 2;
constexpr size_t WS_HBUF   = WS_ACT + (size_t)T_TOK * 1024 * 2;
constexpr size_t WS_SLOT   = WS_HBUF + (size_t)PMAX * 512 * 2;
constexpr size_t WS_END    = WS_SLOT + (size_t)2 * T_TOK * 1024 * 2;
constexpr size_t WS_Q      = WS_HBUF;
constexpr size_t WS_KVC    = WS_SLOT;
constexpr size_t WS_VS     = WS_KVC + (size_t)T_TOK * 512 * 2;
constexpr size_t WS_VW     = WS_VS + (size_t)T_TOK * 256 * 2;

constexpr int LDS_BYTES = 160 * 1024;
constexpr int LDS_MISC  = 128 * 1024;

struct Params {
    const float* in[34];
    float* out;
    unsigned char* ws;
    int p0, p1;
};

template <int N> struct IC { static constexpr int value = N; };
typedef const __attribute__((address_space(4))) Params* KParams;
__device__ __forceinline__ KParams kparams() { KParams q = (KParams)__builtin_amdgcn_kernarg_segment_ptr(); asm volatile("" : "+s"(q)); return q; }

__device__ __forceinline__ unsigned cvt_pk_bf16(float lo, float hi) { unsigned r; asm volatile("v_cvt_pk_bf16_f32 %0, %1, %2" : "=v"(r) : "v"(lo), "v"(hi)); return r; }
__device__ __forceinline__ bf16_t f2bf(float f) { return (bf16_t)(cvt_pk_bf16(f, 0.f) & 0xffffu); }
__device__ __forceinline__ float bf2f(unsigned b) { return __uint_as_float(b << 16); }
__device__ __forceinline__ float wave_sum(float v) {
#pragma unroll
    for (int o = 1; o < 64; o <<= 1) v += __shfl_xor(v, o);
    return v;
}
__device__ __forceinline__ float sigmoidf_(float x) { return 1.f / (1.f + __expf(-x)); }
__device__ __forceinline__ int swap23(int k) { return (k & ~12) | ((k & 4) << 1) | ((k & 8) >> 1); }

#define XB_TMO      128
#define XB_XCNT(j)  (256  + 64 * (j))
#define XB_XSUB(j)  (1280 + 64 * (j))
#define XB_XGEN(j)  (2304 + 64 * (j))
#define XB_TOP      3328
#define XB_TOPGEN   3392
#define XCD_BAR_WORDS 3456
#define XB_SPIN_CAP (1u << 18)
__device__ __forceinline__ unsigned xb_ld(unsigned* p)              { return __hip_atomic_load(p, __ATOMIC_RELAXED, __HIP_MEMORY_SCOPE_AGENT); }
__device__ __forceinline__ unsigned xb_add(unsigned* p, unsigned v) { return __hip_atomic_fetch_add(p, v, __ATOMIC_RELAXED, __HIP_MEMORY_SCOPE_AGENT); }
__device__ __forceinline__ unsigned xb_xcc_id() { return (unsigned)__builtin_amdgcn_s_getreg((3 << 11) | 20) & 0xFu; }
#define XB_SPIN(cond, bar) do { unsigned _sp = 0; while (cond) { __builtin_amdgcn_s_sleep(1); \
    if ((++_sp & 255u) == 0u) { if (xb_ld(&(bar)[XB_TMO])) break; if (_sp > XB_SPIN_CAP) { atomicAdd(&(bar)[XB_TMO], 1u); break; } } } } while (0)
struct XcdBarrier { unsigned* bar; unsigned x; volatile LAS unsigned* st; };
__device__ __forceinline__ XcdBarrier xcd_barrier_post(unsigned* bar, volatile LAS unsigned* st) {
    XcdBarrier b; b.bar = bar; b.x = xb_xcc_id(); b.st = st;
    if (threadIdx.x == 0) (void)xb_add(&bar[XB_XCNT(b.x)], 1u);
    return b;
}
__device__ __forceinline__ void xcd_barrier_complete(unsigned* bar, unsigned x, unsigned& nloc, unsigned& nx) {
    const unsigned G = gridDim.x * gridDim.y * gridDim.z;
    unsigned sum, cnt, mine, sp = 0u;
    for (;;) {
        sum = 0u; cnt = 0u; mine = 0u;
#pragma unroll
        for (unsigned j = 0; j < 16; ++j) { const unsigned c = xb_ld(&bar[XB_XCNT(j)]); sum += c; cnt += (c > 0u) ? 1u : 0u; mine = (j == x) ? c : mine; }
        if (sum == G) break;
        __builtin_amdgcn_s_sleep(1);
        if ((++sp & 255u) == 0u) { if (xb_ld(&bar[XB_TMO])) break; if (sp > XB_SPIN_CAP) { atomicAdd(&bar[XB_TMO], 1u); break; } }
    }
    nloc = mine > 0u ? mine : 1u; nx = cnt > 0u ? cnt : 1u;
}
__device__ __forceinline__ void xcd_barrier(const XcdBarrier& b) {
    asm volatile("s_waitcnt vmcnt(0)" ::: "memory");
    __syncthreads();
    if (threadIdx.x == 0) {
        unsigned* bar = b.bar;
        __builtin_amdgcn_s_waitcnt(0);
        unsigned nloc = b.st[0], nx = b.st[1];
        if (nloc == 0u) { xcd_barrier_complete(bar, b.x, nloc, nx); b.st[0] = nloc; b.st[1] = nx; }
        const unsigned old = xb_add(&bar[XB_XSUB(b.x)], 1u);
        const unsigned gen = old / nloc;
        if (old + 1u == (gen + 1u) * nloc) {
            __builtin_amdgcn_fence(__ATOMIC_RELEASE, "agent");
            asm volatile("s_waitcnt vmcnt(0)" ::: "memory");
            const unsigned og = xb_add(&bar[XB_TOP], 1u);
            const unsigned tg = og / nx;
            if (og + 1u == (tg + 1u) * nx) xb_add(&bar[XB_TOPGEN], 1u);
            else XB_SPIN(xb_ld(&bar[XB_TOPGEN]) == tg, bar);
            __builtin_amdgcn_fence(__ATOMIC_ACQUIRE, "agent");
            xb_add(&bar[XB_XGEN(b.x)], 1u);
            asm volatile("s_waitcnt vmcnt(0)" ::: "memory");
        } else {
            XB_SPIN(xb_ld(&bar[XB_XGEN(b.x)]) == gen, bar);
            __builtin_amdgcn_fence(__ATOMIC_ACQUIRE, "agent");
            asm volatile("s_waitcnt vmcnt(0)" ::: "memory");
        }
    }
    __syncthreads();
}

namespace g8 {
constexpr int BM = 256, BK = 64, HALF = 128, HTB = HALF * BK * 2, STAGE_BYTES = 8 * HTB, NXCD = 8, WGM = 8;
__host__ __device__ __forceinline__ int lds_byte(int r, int c) { const int st = (r >> 4) * 2 + (c >> 5), rr = r & 15, cc = c & 31, ob = rr * 64 + cc * 2; return st * 1024 + (ob ^ (((ob >> 9) & 1) << 5)); }
__host__ __device__ __forceinline__ void stage_rc(int b, int& R, int& C) { const int st = b / 1024, sb = b % 1024, swz = sb ^ (((sb >> 9) & 1) << 5); R = (st >> 1) * 16 + swz / 64; C = (st & 1) * 32 + (swz % 64) / 2; }
__host__ __device__ __forceinline__ int perm32(int rho) { const int n = rho >> 4, i = rho & 15; return 8 * (i >> 2) + 4 * n + (i & 3); }
struct Unit { int pm, pn; };

struct DenseSched {
    int nM, nN, nwg, G, c;
    const char* A; const char* Bt; size_t a_tile_b, a_pn_b, b_tile_b; const unsigned* tab;
    __device__ __forceinline__ void init(int nM_, int nN_) { nM = nM_; nN = nN_; nwg = nM * nN; G = gridDim.x; c = blockIdx.x; tab = nullptr; a_pn_b = 0; }
    __device__ __forceinline__ bool next(int i, Unit& u) const {
        const long L = (long)i * G + c; if (L >= nwg) return false;
        int wgid = (int)L; { const int q = nwg / NXCD, r = nwg % NXCD, xcd = wgid % NXCD, off = wgid / NXCD; wgid = (xcd < r ? xcd * (q + 1) : r * (q + 1) + (xcd - r) * q) + off; }
        const int nig = WGM * nN, gid = wgid / nig, fm = gid * WGM, gsz = (nM - fm) < WGM ? (nM - fm) : WGM;
        u.pm = fm + ((wgid % nig) % gsz); u.pn = (wgid % nig) / gsz; return true;
    }
    __device__ __forceinline__ const char* a_base(const Unit& u) const { return A + (size_t)u.pm * a_tile_b + (size_t)u.pn * a_pn_b; }
    __device__ __forceinline__ const char* b_base(const Unit& u) const { return Bt + (size_t)u.pn * b_tile_b; }
    __device__ __forceinline__ const unsigned* row_tab(const Unit& u) const { return tab + u.pm * 256; }
};
struct MoeSched {
    int nunits, NPN, G, c;
    const char* A; const char* W; size_t a_tile_b, w_e_b, b_tile_b; const unsigned* tab; const LAS unsigned char* tile_e;
    __device__ __forceinline__ bool next(int i, Unit& u) const {
        const long L = (long)i * G + c; if (L >= nunits) return false;
        u.pm = (int)L / NPN; u.pn = (int)L % NPN; return true;
    }
    __device__ __forceinline__ const char* a_base(const Unit& u) const { return A + (size_t)u.pm * a_tile_b; }
    __device__ __forceinline__ const char* b_base(const Unit& u) const { return W + (size_t)tile_e[u.pm] * w_e_b + (size_t)u.pn * b_tile_b; }
    __device__ __forceinline__ const unsigned* row_tab(const Unit& u) const { return tab + u.pm * 256; }
};

template <class Epi, class Sched, bool GATHER>
__device__ __forceinline__ void gemm_phase(LAS unsigned char* lds, const int K_, const int lda_b, const int kstepA, const Sched& S, const Epi& E) {
    int K = K_; asm volatile("" : "+s"(K));
    int tid_ = threadIdx.x; asm volatile("" : "+v"(tid_));
    const int tid = tid_, wid = __builtin_amdgcn_readfirstlane(tid >> 6), lane = tid & 63, wr = wid >> 2, wc = wid & 3, fr = lane & 15, fq = lane >> 4;
    const int nt = K / BK;
    unsigned voffB[2], va[2][2], vn[2][2];
#pragma unroll
    for (int i = 0; i < 2; ++i) { int R, C; stage_rc(tid * 16 + i * 8192, R, C); const int Rb = Epi::PERM ? ((R & ~31) + perm32(R & 31)) : R;
        voffB[i] = (unsigned)(Rb * K + C) * 2u;
        va[0][i] = (unsigned)(R * lda_b + C * 2); va[1][i] = (unsigned)((R + HALF) * lda_b + C * 2); vn[0][i] = va[0][i]; vn[1][i] = va[1][i]; }
    const size_t kstepB = (size_t)(BK * 2);
    const size_t hstepB = (size_t)HALF * K * 2;
    const unsigned ldsw = (unsigned)wid * 1024u;
    const int aoff = lds_byte(wr * 64 + fr, fq * 8), boff = lds_byte(wc * 32 + fr, fq * 8);
#define G8_SA(b, h) (((b) * 2 + (h)) * HTB)
#define G8_SB(b, h) ((4 + (b) * 2 + (h)) * HTB)
#define G8_STAGEB(bufoff, gbase) do { _Pragma("unroll") for (int _i = 0; _i < 2; ++_i) \
        __builtin_amdgcn_global_load_lds((const unsigned*)((const char*)(gbase) + voffB[_i]), (LAS unsigned*)(lds + (bufoff) + ldsw + _i * 8192), 16, 0, 0); } while (0)
#define G8_STAGEA(bufoff, gbase, VA, h) do { _Pragma("unroll") for (int _i = 0; _i < 2; ++_i) \
        __builtin_amdgcn_global_load_lds((const unsigned*)((const char*)(gbase) + (VA)[h][_i]), (LAS unsigned*)(lds + (bufoff) + ldsw + _i * 8192), 16, 0, 0); } while (0)
#define G8_LDA(dst, b, h) do { _Pragma("unroll") for (int m = 0; m < 4; ++m) _Pragma("unroll") for (int k = 0; k < 2; ++k) dst[m][k] = *(const LAS bf16x8*)(lds + G8_SA(b, h) + aoff + m * 2048 + k * 1024); } while (0)
#define G8_LDB(dst, b, h) do { _Pragma("unroll") for (int n = 0; n < 2; ++n) _Pragma("unroll") for (int k = 0; k < 2; ++k) dst[n][k] = *(const LAS bf16x8*)(lds + G8_SB(b, h) + boff + n * 2048 + k * 1024); } while (0)
#define G8_MMA(ai, bj, At, Bt) do { __builtin_amdgcn_s_setprio(1); _Pragma("unroll") for (int m = 0; m < 4; ++m) _Pragma("unroll") for (int n = 0; n < 2; ++n) _Pragma("unroll") for (int k = 0; k < 2; ++k) \
        acc[ai][bj][m][n] = __builtin_amdgcn_mfma_f32_16x16x32_bf16(Bt[n][k], At[m][k], acc[ai][bj][m][n], 0, 0, 0); __builtin_amdgcn_s_setprio(0); } while (0)
#define G8_WAIT_V(n) asm volatile("s_waitcnt vmcnt(" #n ")" ::: "memory")
#define G8_WAIT_L(n) asm volatile("s_waitcnt lgkmcnt(" #n ")" ::: "memory")
#define G8_BAR __builtin_amdgcn_s_barrier()
#define G8_SCHED __builtin_amdgcn_sched_barrier(0)
    Unit cur, nxt; int ui = 0;
    if (!S.next(0, cur)) return;
    f32x4 acc[2][2][4][2];
#pragma unroll
    for (int a = 0; a < 2; ++a)
#pragma unroll
        for (int b = 0; b < 2; ++b)
#pragma unroll
            for (int m = 0; m < 4; ++m)
#pragma unroll
                for (int n = 0; n < 2; ++n) acc[a][b][m][n] = (f32x4){0.f, 0.f, 0.f, 0.f};
    bf16x8 At[4][2], B0[2][2], B1[2][2];
    const char* cA = S.a_base(cur); const char* cB = S.b_base(cur);
    if (GATHER) { const unsigned* tb = S.row_tab(cur);
#pragma unroll
        for (int i = 0; i < 2; ++i) { int R, C; stage_rc(tid * 16 + i * 8192, R, C); va[0][i] = tb[R] + (unsigned)(C * 2); va[1][i] = tb[R + HALF] + (unsigned)(C * 2); } }
    G8_STAGEB(G8_SB(0, 0), cB); G8_STAGEA(G8_SA(0, 0), cA, va, 0); G8_STAGEB(G8_SB(0, 1), cB + hstepB); G8_STAGEA(G8_SA(0, 1), cA, va, 1);
    if (wr == 1) G8_BAR;
    G8_WAIT_V(4); G8_BAR;
    G8_STAGEB(G8_SB(1, 0), cB + kstepB); G8_STAGEA(G8_SA(1, 0), cA + kstepA, va, 0); G8_STAGEB(G8_SB(1, 1), cB + hstepB + kstepB);
    G8_WAIT_V(6); G8_BAR;
    for (;;) {
        const bool has_next = S.next(ui + 1, nxt);
        const char* nA = has_next ? S.a_base(nxt) : cA; const char* nB = has_next ? S.b_base(nxt) : cB;
        if (GATHER) {
            if (has_next) { const unsigned* tb = S.row_tab(nxt);
#pragma unroll
                for (int i = 0; i < 2; ++i) { int R, C; stage_rc(tid * 16 + i * 8192, R, C); vn[0][i] = tb[R] + (unsigned)(C * 2); vn[1][i] = tb[R + HALF] + (unsigned)(C * 2); } }
            else {
#pragma unroll
                for (int i = 0; i < 2; ++i) { vn[0][i] = va[0][i]; vn[1][i] = va[1][i]; } }
        }
        for (int t = 0; t < nt; t += 2) {
            const bool last = (t == nt - 2);
            const char* a1 = cA + (size_t)(t + 1) * kstepA;
            const char* a2 = last ? nA : cA + (size_t)(t + 2) * kstepA; const char* b2 = last ? nB : cB + (size_t)(t + 2) * kstepB;
            const char* a3 = a2 + kstepA; const char* b3 = b2 + kstepB;
            unsigned vx[2][2];
#pragma unroll
            for (int hh = 0; hh < 2; ++hh)
#pragma unroll
                for (int i = 0; i < 2; ++i) vx[hh][i] = (GATHER && last) ? vn[hh][i] : va[hh][i];
            G8_LDB(B0, 0, 0); G8_SCHED; G8_LDA(At, 0, 0); G8_STAGEA(G8_SA(1, 1), a1, va, 1);
            G8_WAIT_L(8); G8_BAR; G8_WAIT_L(0); G8_MMA(0, 0, At, B0); G8_BAR; G8_SCHED;
            G8_LDB(B1, 0, 1); G8_STAGEB(G8_SB(0, 0), b2);
            G8_BAR; G8_WAIT_L(0); G8_MMA(0, 1, At, B1); G8_BAR;
            G8_LDA(At, 0, 1); G8_STAGEA(G8_SA(0, 0), a2, vx, 0);
            G8_BAR; G8_WAIT_L(0); G8_MMA(1, 0, At, B0); G8_BAR; G8_SCHED;
            G8_STAGEB(G8_SB(0, 1), b2 + hstepB);
            G8_WAIT_V(6); G8_BAR; G8_MMA(1, 1, At, B1); G8_BAR;
            G8_LDB(B0, 1, 0); G8_SCHED; G8_LDA(At, 1, 0); G8_STAGEA(G8_SA(0, 1), a2, vx, 1);
            G8_WAIT_L(8); G8_BAR; G8_WAIT_L(0); G8_MMA(0, 0, At, B0); G8_BAR; G8_SCHED;
            G8_LDB(B1, 1, 1); G8_STAGEB(G8_SB(1, 0), b3);
            G8_BAR; G8_WAIT_L(0); G8_MMA(0, 1, At, B1); G8_BAR;
            G8_LDA(At, 1, 1); G8_STAGEA(G8_SA(1, 0), a3, vx, 0);
            G8_BAR; G8_WAIT_L(0); G8_MMA(1, 0, At, B0); G8_BAR; G8_SCHED;
            G8_STAGEB(G8_SB(1, 1), b3 + hstepB);
            G8_WAIT_V(6); G8_BAR; G8_MMA(1, 1, At, B1); G8_BAR;
        }
        E(acc, cur, wr, wc, fr, fq);
        if (!has_next) break;
#pragma unroll
        for (int a = 0; a < 2; ++a)
#pragma unroll
            for (int b = 0; b < 2; ++b)
#pragma unroll
                for (int m = 0; m < 4; ++m)
#pragma unroll
                    for (int n = 0; n < 2; ++n) acc[a][b][m][n] = (f32x4){0.f, 0.f, 0.f, 0.f};
        cur = nxt; cA = nA; cB = nB; ++ui;
        if (GATHER) {
#pragma unroll
            for (int i = 0; i < 2; ++i) { va[0][i] = vn[0][i]; va[1][i] = vn[1][i]; } }
    }
    G8_WAIT_V(0);
    if (wr == 0) G8_BAR;
    G8_BAR;
#undef G8_SA
#undef G8_SB
#undef G8_STAGEA
#undef G8_STAGEB
#undef G8_LDA
#undef G8_LDB
#undef G8_MMA
#undef G8_WAIT_V
#undef G8_WAIT_L
#undef G8_BAR
#undef G8_SCHED
}
}
using g8::Unit;

typedef f32x4 AccT[2][2][4][2];

template <int MODE> struct EpiResid {
    static constexpr bool PERM = false;
    int L;
    __device__ __forceinline__ void operator()(const AccT& acc, const Unit& u, int wr, int wc, int fr, int fq) const {
        KParams Q = kparams(); unsigned char* ws = Q->ws;
        const float* hin = (MODE == 1 && L == 0) ? Q->in[0] : Q->out; float* hout = Q->out; bf16_t* hb = (bf16_t*)(ws + WS_HBA); float* ssq = (float*)(ws + WS_SSQ);
        const float* bias = (MODE == 1) ? Q->in[6] + L * 1024 : Q->in[32] + L * 1024; const float* scale = Q->in[7] + L * 1024;
        const bf16_t* ple = (const bf16_t*)(ws + WS_ACT); const float* rstd = (const float*)(ws + WS_RSP);
        const int col0 = u.pn * 256 + wc * 32 + 4 * fq;
        f32x4 bv[2][2], sv[2][2];
#pragma unroll
        for (int bj = 0; bj < 2; ++bj)
#pragma unroll
            for (int n = 0; n < 2; ++n) {
                bv[bj][n] = (MODE != 0) ? *(const f32x4*)(bias + col0 + bj * 128 + n * 16) : (f32x4){0.f, 0.f, 0.f, 0.f};
                sv[bj][n] = (MODE == 1) ? *(const f32x4*)(scale + col0 + bj * 128 + n * 16) : (f32x4){1.f, 1.f, 1.f, 1.f}; }
#pragma unroll
        for (int ai = 0; ai < 2; ++ai)
#pragma unroll
            for (int m = 0; m < 4; ++m) {
                const int row = u.pm * 256 + ai * 128 + wr * 64 + m * 16 + fr;
                const size_t off = (size_t)row * DM + col0;
                float rs = 1.f; if (MODE == 2) rs = rstd[row];
                float ss = 0.f;
#pragma unroll
                for (int bj = 0; bj < 2; ++bj)
#pragma unroll
                    for (int n = 0; n < 2; ++n) {
                        const size_t o = off + bj * 128 + n * 16;
                        const f32x4 hv = *(const f32x4*)(hin + o);
                        f32x4 v = acc[ai][bj][m][n];
                        if (MODE == 1) v = (v + bv[bj][n]) * sv[bj][n];
                        if (MODE == 2) { const u32x2 pw = *(const u32x2*)(ple + o);
                            f32x4 pl = {bf2f(pw.x & 0xffffu), bf2f(pw.x >> 16), bf2f(pw.y & 0xffffu), bf2f(pw.y >> 16)};
                            f32x4 z = v * rs + bv[bj][n];
                            v = (f32x4){pl.x * sigmoidf_(z.x), pl.y * sigmoidf_(z.y), pl.z * sigmoidf_(z.z), pl.w * sigmoidf_(z.w)}; }
                        v = v + hv;
                        *(f32x4*)(hout + o) = v;
                        u32x2 w; w.x = cvt_pk_bf16(v.x, v.y); w.y = cvt_pk_bf16(v.z, v.w);
                        *(u32x2*)(hb + o) = w;
                        ss += v.x * v.x + v.y * v.y + v.z * v.z + v.w * v.w;
                    }
                ss += __shfl_xor(ss, 16); ss += __shfl_xor(ss, 32);
                if (fq == 0) ssq[(size_t)row * 16 + u.pn * 4 + wc] = ss;
            }
    }
};

__device__ __forceinline__ float rstd_from_parts(const float* ssq, int row) {
    const f32x4* p = (const f32x4*)(ssq + (size_t)row * 16);
    const f32x4 a = p[0], b = p[1], c = p[2], d = p[3];
    const float s = ((a.x + a.y) + (a.z + a.w)) + ((b.x + b.y) + (b.z + b.w)) + ((c.x + c.y) + (c.z + c.w)) + ((d.x + d.y) + (d.z + d.w));
    return 1.f / sqrtf(s * (1.f / DM) + RMS_EPS);
}

struct EpiRouter {
    static constexpr bool PERM = false;
    int L; LAS unsigned* hist;
    __device__ __forceinline__ void operator()(const AccT& acc, const Unit& u, int wr, int wc, int fr, int fq) const {
        if (wc != 0) return;
        KParams Q = kparams(); unsigned char* ws = Q->ws;
        const float* ssq = (const float*)(ws + WS_SSQ); const float* gb = Q->in[24] + L * 4; const float* eb = Q->in[26] + L * 32;
        int* toke = (int*)(ws + WS_TOKE); float* tokw = (float*)(ws + WS_TOKW); float* rsf = (float*)(ws + WS_RSF);
#pragma unroll
        for (int ai = 0; ai < 2; ++ai)
#pragma unroll
            for (int m = 0; m < 4; ++m) {
                const int row = u.pm * 256 + ai * 128 + wr * 64 + m * 16 + fr;
                const float rs = rstd_from_parts(ssq, row);
                float gl[4];
#pragma unroll
                for (int i = 0; i < 4; ++i) gl[i] = __shfl(acc[ai][1][m][0][i], fr) * rs + gb[i];
                int grp = 0; float gm = gl[0];
#pragma unroll
                for (int i = 1; i < 4; ++i) if (gl[i] > gm) { gm = gl[i]; grp = i; }
                float gs = 0.f;
#pragma unroll
                for (int i = 0; i < 4; ++i) gs += __expf(gl[i] - gm);
                const float gprob = 1.f / gs;
                f32x4 mine;
#pragma unroll
                for (int i = 0; i < 4; ++i) { float x0 = acc[ai][0][m][0][i], x1 = acc[ai][0][m][1][i]; asm volatile("" : "+v"(x0), "+v"(x1)); mine[i] = (grp >> 1) ? x1 : x0; }
                const int src0 = fr + 16 * (2 * (grp & 1));
                float el[8];
#pragma unroll
                for (int i = 0; i < 4; ++i) { el[i] = __shfl(mine[i], src0); el[4 + i] = __shfl(mine[i], src0 + 16); }
#pragma unroll
                for (int j = 0; j < 8; ++j) el[j] = el[j] * rs + eb[grp * 8 + j];
                int i1 = 0; float v1 = el[0];
#pragma unroll
                for (int j = 1; j < 8; ++j) if (el[j] > v1) { v1 = el[j]; i1 = j; }
                int i2 = -1; float v2 = -3.0e38f;
#pragma unroll
                for (int j = 0; j < 8; ++j) if (j != i1 && el[j] > v2) { v2 = el[j]; i2 = j; }
                const float e2 = __expf(v2 - v1), inv = 1.f / (1.f + e2);
                if (fq == 0) {
                    const int e1g = grp * 8 + i1, e2g = grp * 8 + i2;
                    *(int2*)(toke + (size_t)row * 2) = make_int2(e1g, e2g);
                    *(float2*)(tokw + (size_t)row * 2) = make_float2(gprob * inv, gprob * e2 * inv);
                    rsf[row] = rs;
                    atomicAdd((unsigned*)&hist[e1g], 1u); atomicAdd((unsigned*)&hist[e2g], 1u);
                }
            }
    }
};

struct EpiMoe1 {
    static constexpr bool PERM = true;
    int dummy;
    __device__ __forceinline__ void operator()(const AccT& acc, const Unit& u, int wr, int wc, int fr, int fq) const {
        KParams Q = kparams(); unsigned char* ws = Q->ws;
        const int* rowtab = (const int*)(ws + WS_ROWTAB); const float* rsf = (const float*)(ws + WS_RSF); bf16_t* hbuf = (bf16_t*)(ws + WS_HBUF);
        const int hc0 = u.pn * 128 + wc * 16 + 4 * fq;
#pragma unroll
        for (int ai = 0; ai < 2; ++ai)
#pragma unroll
            for (int m = 0; m < 4; ++m) {
                const int pos = u.pm * 256 + ai * 128 + wr * 64 + m * 16 + fr;
                const int a = rowtab[pos];
                if (a < 0) continue;
                const float rs = rsf[a >> 1];
#pragma unroll
                for (int bj = 0; bj < 2; ++bj) {
                    const f32x4 g = acc[ai][bj][m][0] * rs, uu = acc[ai][bj][m][1] * rs;
                    f32x4 o;
#pragma unroll
                    for (int i = 0; i < 4; ++i) o[i] = g[i] * sigmoidf_(g[i]) * uu[i];
                    u32x2 w; w.x = cvt_pk_bf16(o.x, o.y); w.y = cvt_pk_bf16(o.z, o.w);
                    *(u32x2*)(hbuf + (size_t)pos * DFF + hc0 + bj * 64) = w;
                }
            }
    }
};
struct EpiMoe2 {
    static constexpr bool PERM = true;
    int dummy;
    __device__ __forceinline__ void operator()(const AccT& acc, const Unit& u, int wr, int wc, int fr, int fq) const {
        KParams Q = kparams(); unsigned char* ws = Q->ws;
        const int* rowtab = (const int*)(ws + WS_ROWTAB); const float* tokw = (const float*)(ws + WS_TOKW); bf16_t* slot = (bf16_t*)(ws + WS_SLOT);
        const int col0 = u.pn * 256 + wc * 32 + 8 * fq;
#pragma unroll
        for (int ai = 0; ai < 2; ++ai)
#pragma unroll
            for (int m = 0; m < 4; ++m) {
                const int pos = u.pm * 256 + ai * 128 + wr * 64 + m * 16 + fr;
                const int a = rowtab[pos];
                if (a < 0) continue;
                const float w = tokw[a];
#pragma unroll
                for (int bj = 0; bj < 2; ++bj) {
                    const f32x4 v0 = acc[ai][bj][m][0] * w, v1 = acc[ai][bj][m][1] * w;
                    u32x4 o; o.x = cvt_pk_bf16(v0.x, v0.y); o.y = cvt_pk_bf16(v0.z, v0.w); o.z = cvt_pk_bf16(v1.x, v1.y); o.w = cvt_pk_bf16(v1.z, v1.w);
                    *(u32x4*)(slot + (size_t)a * DM + col0 + bj * 128) = o;
                }
            }
    }
};
struct EpiBf16 {
    static constexpr bool PERM = true;
    int dummy;
    __device__ __forceinline__ void operator()(const AccT& acc, const Unit& u, int wr, int wc, int fr, int fq) const {
        KParams Q = kparams(); bf16_t* O = (bf16_t*)(Q->ws + WS_ACT); constexpr int ldc = 1024;
        const int col0 = u.pn * 256 + wc * 32 + 8 * fq;
#pragma unroll
        for (int ai = 0; ai < 2; ++ai)
#pragma unroll
            for (int m = 0; m < 4; ++m) {
                const int row = u.pm * 256 + ai * 128 + wr * 64 + m * 16 + fr;
#pragma unroll
                for (int bj = 0; bj < 2; ++bj) {
                    const f32x4 v0 = acc[ai][bj][m][0], v1 = acc[ai][bj][m][1];
                    u32x4 o; o.x = cvt_pk_bf16(v0.x, v0.y); o.y = cvt_pk_bf16(v0.z, v0.w); o.z = cvt_pk_bf16(v1.x, v1.y); o.w = cvt_pk_bf16(v1.z, v1.w);
                    *(u32x4*)(O + (size_t)row * ldc + col0 + bj * 128) = o;
                }
            }
    }
};
struct EpiQkv {
    static constexpr bool PERM = true;
    int tile0; int J;
    __device__ __forceinline__ void operator()(const AccT& acc, const Unit& u, int wr, int wc, int fr, int fq) const {
        KParams Q = kparams(); unsigned char* ws = Q->ws;
        const float* ssq = (const float*)(ws + WS_SSQ); const float* rope = (const float*)(ws + WS_ROPE); const float* bgate = Q->in[21] + J * 48;
        bf16_t* kvc = (bf16_t*)(ws + WS_KVC); bf16_t* ks = (bf16_t*)(ws + WS_KS); bf16_t* vs = (bf16_t*)(ws + WS_VS); bf16_t* kw = (bf16_t*)(ws + WS_KW); bf16_t* vw = (bf16_t*)(ws + WS_VW);
        bf16_t* q = (bf16_t*)(ws + WS_Q); float* gates = (float*)(ws + WS_GATES);
        const int ty = u.pn + tile0;
        const int cu0 = wc * 32 + 8 * fq;
        const bool roped = (ty == 2 || ty == 4 || ty >= 6) && ty != 10;
        const bool dorope = roped && ((wc & 1) == 0);
        bf16_t* dst; int ldc; int cbase;
        if (ty < 2)       { dst = kvc; ldc = 512;  cbase = ty * 256; }
        else if (ty == 2) { dst = ks;  ldc = 256;  cbase = 0; }
        else if (ty == 3) { dst = vs;  ldc = 256;  cbase = 0; }
        else if (ty == 4) { dst = kw;  ldc = 256;  cbase = 0; }
        else if (ty == 5) { dst = vw;  ldc = 256;  cbase = 0; }
        else              { dst = q;   ldc = 1024; cbase = (ty - 6) * 256; }
#pragma unroll
        for (int ai = 0; ai < 2; ++ai)
#pragma unroll
            for (int m = 0; m < 4; ++m) {
                const int row = u.pm * 256 + ai * 128 + wr * 64 + m * 16 + fr;
                const float rs = rstd_from_parts(ssq, row);
                if (ty == 10) {
                    if (wc < 2) {
#pragma unroll
                        for (int n = 0; n < 2; ++n) {
                            const int c = cu0 + 4 * n;
                            if (c < 48) { f32x4 z = acc[ai][0][m][n] * rs + *(const f32x4*)(bgate + c);
                                f32x4 o = {sigmoidf_(z.x), sigmoidf_(z.y), sigmoidf_(z.z), sigmoidf_(z.w)};
                                *(f32x4*)(gates + (size_t)row * 48 + c) = o; }
                        }
                    }
                    continue;
                }
                f32x4 cs[2], sn[2];
                if (dorope) { const float* rp = rope + (size_t)(row & (SEQ - 1)) * 16;
                    cs[0] = *(const f32x4*)(rp); cs[1] = *(const f32x4*)(rp + 4); sn[0] = *(const f32x4*)(rp + 8); sn[1] = *(const f32x4*)(rp + 12); }
#pragma unroll
                for (int bj = 0; bj < 2; ++bj) {
                    f32x4 v[2];
#pragma unroll
                    for (int n = 0; n < 2; ++n) {
                        v[n] = acc[ai][bj][m][n] * rs;
                        if (dorope) {
                            f32x4 ot;
#pragma unroll
                            for (int i = 0; i < 4; ++i) ot[i] = __shfl_xor(v[n][i], 16);
                            if (fq == 0) v[n] = v[n] * cs[n] - ot * sn[n];
                            else if (fq == 1) v[n] = v[n] * cs[n] + ot * sn[n];
                        }
                        if (ty >= 6) v[n] = v[n] * QSCALE;
                    }
                    u32x4 o; o.x = cvt_pk_bf16(v[0].x, v[0].y); o.y = cvt_pk_bf16(v[0].z, v[0].w); o.z = cvt_pk_bf16(v[1].x, v[1].y); o.w = cvt_pk_bf16(v[1].z, v[1].w);
                    *(u32x4*)(dst + (size_t)row * ldc + cbase + cu0 + bj * 128) = o;
                }
            }
    }
};
__device__ __forceinline__ float gelu_tanh(float x) {
    const float u = 0.7978845608028654f * (x + 0.044715f * x * x * x);
    const float t = 1.f - 2.f / (1.f + __expf(2.f * u));
    return 0.5f * x * (1.f + t);
}
struct EpiCmp1 {
    static constexpr bool PERM = true;
    int dummy;
    __device__ __forceinline__ void operator()(const AccT& acc, const Unit& u, int wr, int wc, int fr, int fq) const {
        KParams Q = kparams(); unsigned char* ws = Q->ws; const float* cb1 = (const float*)(ws + WS_CB1); bf16_t* chid = (bf16_t*)(ws + WS_CHID);
        const int col0 = wc * 32 + 8 * fq;
        bf16_t* O = chid + (size_t)u.pn * 8192 * 256;
#pragma unroll
        for (int ai = 0; ai < 2; ++ai)
#pragma unroll
            for (int m = 0; m < 4; ++m) {
                const int row = u.pm * 256 + ai * 128 + wr * 64 + m * 16 + fr;
#pragma unroll
                for (int bj = 0; bj < 2; ++bj) {
                    const int c = col0 + bj * 128;
                    const f32x4 b0 = *(const f32x4*)(cb1 + u.pn * 256 + c), b1 = *(const f32x4*)(cb1 + u.pn * 256 + c + 4);
                    const f32x4 v0 = acc[ai][bj][m][0] + b0, v1 = acc[ai][bj][m][1] + b1;
                    u32x4 o; o.x = cvt_pk_bf16(gelu_tanh(v0.x), gelu_tanh(v0.y)); o.y = cvt_pk_bf16(gelu_tanh(v0.z), gelu_tanh(v0.w));
                    o.z = cvt_pk_bf16(gelu_tanh(v1.x), gelu_tanh(v1.y)); o.w = cvt_pk_bf16(gelu_tanh(v1.z), gelu_tanh(v1.w));
                    *(u32x4*)(O + (size_t)row * 256 + c) = o;
                }
            }
    }
};
struct EpiCmp2 {
    static constexpr bool PERM = true;
    int dummy;
    __device__ __forceinline__ void operator()(const AccT& acc, const Unit& u, int wr, int wc, int fr, int fq) const {
        if (wc >= 2) return;
        KParams Q = kparams(); unsigned char* ws = Q->ws; const float* b2k = Q->in[14]; const float* b2v = Q->in[19]; const float* rope = (const float*)(ws + WS_ROPE);
        bf16_t* kc = (bf16_t*)(ws + WS_KC); bf16_t* vct = (bf16_t*)(ws + WS_VCT);
        const int c0 = wc * 32 + 8 * fq;
        const float* b2 = u.pn ? b2v : b2k;
        const f32x4 bb0 = *(const f32x4*)(b2 + c0), bb1 = *(const f32x4*)(b2 + c0 + 4);
#pragma unroll
        for (int ai = 0; ai < 2; ++ai)
#pragma unroll
            for (int m = 0; m < 4; ++m) {
                const int row = u.pm * 256 + ai * 128 + wr * 64 + m * 16 + fr;
                const int bg = row >> 9, n = row & 511;
                f32x4 v[2]; v[0] = acc[ai][0][m][0] + bb0; v[1] = acc[ai][0][m][1] + bb1;
                if (u.pn == 0) {
                    if (wc == 0) {
                        const int pos = (16 * n + 31) & (SEQ - 1);
                        const float* rp = rope + (size_t)pos * 16;
#pragma unroll
                        for (int nn = 0; nn < 2; ++nn) {
                            const f32x4 cs = *(const f32x4*)(rp + 4 * nn), sn = *(const f32x4*)(rp + 8 + 4 * nn);
                            f32x4 ot;
#pragma unroll
                            for (int i = 0; i < 4; ++i) ot[i] = __shfl_xor(v[nn][i], 16);
                            if (fq == 0) v[nn] = v[nn] * cs - ot * sn; else if (fq == 1) v[nn] = v[nn] * cs + ot * sn;
                        }
                    }
                    if (n == 511) { v[0] = (f32x4){0.f, 0.f, 0.f, 0.f}; v[1] = v[0]; }
                    u32x4 o; o.x = cvt_pk_bf16(v[0].x, v[0].y); o.y = cvt_pk_bf16(v[0].z, v[0].w); o.z = cvt_pk_bf16(v[1].x, v[1].y); o.w = cvt_pk_bf16(v[1].z, v[1].w);
                    *(u32x4*)(kc + ((size_t)bg * 512 + n) * 64 + c0) = o;
                } else {
                    const int np = swap23(n);
#pragma unroll
                    for (int nn = 0; nn < 2; ++nn)
#pragma unroll
                        for (int i = 0; i < 4; ++i) vct[((size_t)bg * 64 + c0 + 4 * nn + i) * 512 + np] = (n == 511) ? (bf16_t)0 : f2bf(v[nn][i]);
                }
            }
    }
};
template <class F>
__device__ __forceinline__ void cvt_family(LAS float* scr, bf16_t* dst, int nbatch, int Nd, int K, const F& f) {
    const int tilesN = Nd / 64, tilesK = K / 64, per = tilesN * tilesK, items = nbatch * per;
    int tid_ = threadIdx.x; asm volatile("" : "+v"(tid_));
    const int tid = tid_;
    for (int it = blockIdx.x; it < items; it += gridDim.x) {
        const int b = it / per, r = it % per, n0 = (r / tilesK) * 64, k0 = (r % tilesK) * 64;
#pragma unroll
        for (int i = 0; i < 8; ++i) { const int kk = (tid >> 6) + 8 * i, nn = tid & 63; scr[kk * 65 + nn] = f(b, k0 + kk, n0 + nn); }
        __syncthreads();
        { const int nn = tid >> 3, kc = tid & 7; const LAS float* s = scr + (8 * kc) * 65 + nn;
          u32x4 o; o.x = cvt_pk_bf16(s[0], s[65]); o.y = cvt_pk_bf16(s[2 * 65], s[3 * 65]); o.z = cvt_pk_bf16(s[4 * 65], s[5 * 65]); o.w = cvt_pk_bf16(s[6 * 65], s[7 * 65]);
          *(u32x4*)(dst + ((size_t)b * Nd + n0 + nn) * K + k0 + 8 * kc) = o; }
        __syncthreads();
    }
}

__device__ __forceinline__ void prologue_phase(LAS unsigned char* lds, const Params& p) {
    LAS float* scr = (LAS float*)lds;
    unsigned char* ws = p.ws;
    const int tid = threadIdx.x;
    const size_t gtid = (size_t)blockIdx.x * 512 + tid, gsz = (size_t)gridDim.x * 512;
    { float* rope = (float*)(ws + WS_ROPE);
      for (size_t i = gtid; i < (size_t)SEQ * 8; i += gsz) { const int pos = (int)(i >> 3), f = (int)(i & 7);
          const float inv = (float)pow(500000.0, -(double)f / 8.0); const float ang = (float)pos * inv;
          rope[pos * 16 + f] = (float)cos((double)ang); rope[pos * 16 + 8 + f] = (float)sin((double)ang); } }
    { unsigned* tab = (unsigned*)(ws + WS_CMPTAB);
      for (size_t i = gtid; i < 8192; i += gsz) { const int bg = (int)(i >> 9), n = (int)(i & 511), b = bg >> 2, g = bg & 3, nc = n > 510 ? 510 : n;
          tab[i] = (unsigned)((((size_t)b * SEQ + 16 * nc) * 512 + g * 64) * 2); } }
    if (blockIdx.x == 0) { float* cb1 = (float*)(ws + WS_CB1); const int which = tid >> 8, hh = tid & 255;
        const float* pos = which ? p.in[15] : p.in[10]; const float* w1 = which ? p.in[16] : p.in[11]; const float* b1 = which ? p.in[17] : p.in[12];
        float s = b1[hh]; for (int k = 0; k < 2048; ++k) s += pos[k] * w1[(size_t)k * 256 + hh];
        cb1[which * 256 + hh] = s; }
    { const f32x4* src = (const f32x4*)p.in[1]; u32x2* dst = (u32x2*)(ws + WS_PB);
      for (size_t i = gtid; i < (size_t)4 * T_TOK * 256 / 4; i += gsz) { const f32x4 v = src[i]; u32x2 o; o.x = cvt_pk_bf16(v.x, v.y); o.y = cvt_pk_bf16(v.z, v.w); dst[i] = o; } }
    { const float* pw = p.in[5];
      cvt_family(scr, (bf16_t*)(ws + WS_WPOOL), 2, 1024, 256, [=](int b, int k, int nd) { return pw[(((size_t)b * 4 + (nd >> 8)) * 256 + k) * 256 + (nd & 255)]; }); }
    { const float* wkv = p.in[9]; const float* kvn = p.in[8]; const float* wqg = p.in[20]; const float* nm = p.in[2] + 2 * 1024;
      cvt_family(scr, (bf16_t*)(ws + WS_WKVQ), 1, 2816, 1024, [=](int b, int k, int nd) {
          if (nd < 1536) return wkv[(size_t)k * 1536 + nd] * kvn[k];
          if (nd < 1536 + 1072) return wqg[(size_t)k * 1072 + (nd - 1536)] * nm[k];
          return 0.f; }); }
    { const float* wqg = p.in[20] + (size_t)1024 * 1072; const float* nm = p.in[2] + 3 * 1024;
      cvt_family(scr, (bf16_t*)(ws + WS_WQG1), 1, 1280, 1024, [=](int b, int k, int nd) { return nd < 1072 ? wqg[(size_t)k * 1072 + nd] * nm[k] : 0.f; }); }
    { const float* wk = p.in[11]; const float* wv = p.in[16];
      cvt_family(scr, (bf16_t*)(ws + WS_WC1), 2, 256, 2048, [=](int b, int k, int nd) { return (b ? wv : wk)[(size_t)k * 256 + nd]; }); }
    { const float* wk = p.in[13]; const float* wv = p.in[18];
      cvt_family(scr, (bf16_t*)(ws + WS_WC2), 2, 256, 256, [=](int b, int k, int nd) { return nd < 64 ? (b ? wv : wk)[(size_t)k * 64 + nd] : 0.f; }); }
    { const float* wo = p.in[22];
      cvt_family(scr, (bf16_t*)(ws + WS_WO), 2, 1024, 1024, [=](int b, int k, int nd) { return wo[((size_t)b * 1024 + k) * 1024 + nd]; }); }
    { const float* rg = p.in[23]; const float* re = p.in[25]; const float* nf = p.in[3];
      cvt_family(scr, (bf16_t*)(ws + WS_WR), 4, 256, 1024, [=](int b, int k, int nd) {
          if (nd < 32) return re[((size_t)b * 1024 + k) * 32 + nd] * nf[b * 1024 + k];
          if (nd >= 128 && nd < 132) return rg[((size_t)b * 1024 + k) * 4 + (nd - 128)] * nf[b * 1024 + k];
          return 0.f; }); }
    { const float* pp = p.in[30];
      cvt_family(scr, (bf16_t*)(ws + WS_WPP), 4, 1024, 256, [=](int b, int k, int nd) { return pp[((size_t)b * 256 + k) * 1024 + nd]; }); }
    { const float* pg = p.in[31]; const float* np = p.in[4];
      cvt_family(scr, (bf16_t*)(ws + WS_WPG), 4, 1024, 1024, [=](int b, int k, int nd) { return pg[((size_t)b * 1024 + k) * 1024 + nd] * np[b * 1024 + k]; }); }
    { const float* w1 = p.in[27]; const float* w3 = p.in[28]; const float* nf = p.in[3];
      cvt_family(scr, (bf16_t*)(ws + WS_W13), 128, 1024, 1024, [=](int b, int k, int nd) {
          const int c8 = nd >> 3, i = nd & 7; const long dlt = (const char*)w3 - (const char*)w1; const float* w = (const float*)((const char*)w1 + ((i < 4) ? 0l : dlt));
          return w[((size_t)b * 1024 + k) * 512 + 4 * c8 + (i & 3)] * nf[(b >> 5) * 1024 + k]; }); }
    { const float* w2 = p.in[29];
      cvt_family(scr, (bf16_t*)(ws + WS_W2), 128, 1024, 512, [=](int b, int k, int nd) { return w2[((size_t)b * 512 + k) * 1024 + nd]; }); }
}

template <int W>
__device__ __forceinline__ void stencil_rows(const float* h, const LAS float* rs, const float gx, const float gy, bf16_t* pooled, int r0, int s0, int c0) {
    f32x2 buf[16];
#pragma unroll
    for (int j = 0; j < 16; ++j) buf[j] = (f32x2){0.f, 0.f};
    for (int ch = 0; ch < 9; ++ch) {
        f32x2 ld[16];
#pragma unroll
        for (int j = 0; j < 16; ++j) { const int rr = ch * 16 + j; const bool ok = (ch > 0) || (s0 > 0);
            ld[j] = ok ? *(const f32x2*)(h + (size_t)(r0 - 16 + rr) * DM + c0) : (f32x2){0.f, 0.f}; }
#pragma unroll
        for (int j = 0; j < 16; ++j) { const int rr = ch * 16 + j; const float r = rs[rr];
            f32x2 xn; xn.x = ld[j].x * r * gx; xn.y = ld[j].y * r * gy;
            buf[j] = xn;
            if (ch > 0) {
                f32x2 s = xn;
#pragma unroll
                for (int i = 1; i < W; ++i) s = s + buf[(j - i) & 15];
                const int sp = s0 + rr - 16;
                const int cnt = (sp + 1 < W) ? (sp + 1) : W;
                const float ic = 1.f / (float)cnt;
                const float ox = s.x * ic - xn.x, oy = s.y * ic - xn.y;
                *(unsigned*)(pooled + (size_t)(r0 - 16 + rr) * DM + c0) = cvt_pk_bf16(ox, oy);
            }
        }
    }
}
__device__ __forceinline__ void stencil_phase(LAS unsigned char* lds, const float* h, const float* gain, bf16_t* pooled) {
    LAS float* rs = (LAS float*)lds;
    int tid_ = threadIdx.x; asm volatile("" : "+v"(tid_));
    const int tid = tid_, w = tid >> 6, lane = tid & 63;
    for (int it = blockIdx.x; it < T_TOK / 128; it += gridDim.x) {
        const int r0 = it * 128, s0 = r0 & (SEQ - 1);
        for (int rr = w; rr < 144; rr += 8) {
            const int row = r0 - 16 + rr; float v = 0.f;
            if (rr >= 16 || s0 > 0) { const f32x4* xr = (const f32x4*)(h + (size_t)row * DM) + lane; float s = 0.f;
#pragma unroll
                for (int j = 0; j < 4; ++j) { const f32x4 x = xr[64 * j]; s += x.x * x.x + x.y * x.y + x.z * x.z + x.w * x.w; }
                s = wave_sum(s); v = 1.f / sqrtf(s * (1.f / DM) + RMS_EPS); }
            if (lane == 0) rs[rr] = v;
        }
        __syncthreads();
        const int c0 = 2 * tid, gi = tid >> 7; const float gx = gain[c0], gy = gain[c0 + 1];
        if (gi == 0) stencil_rows<2>(h, rs, gx, gy, pooled, r0, s0, c0);
        else if (gi == 1) stencil_rows<4>(h, rs, gx, gy, pooled, r0, s0, c0);
        else if (gi == 2) stencil_rows<8>(h, rs, gx, gy, pooled, r0, s0, c0);
        else stencil_rows<16>(h, rs, gx, gy, pooled, r0, s0, c0);
        __syncthreads();
    }
}

__device__ __forceinline__ int moe_tables(LAS unsigned char* lds, const unsigned* counts) {
    LAS unsigned* pstart = (LAS unsigned*)(lds + LDS_MISC);
    LAS unsigned char* tile_e = lds + LDS_MISC + 256;
    __syncthreads();
    if (threadIdx.x == 0) { unsigned acc = 0;
        for (int e = 0; e < NEXP; ++e) { pstart[e] = acc; const unsigned nt = (counts[e] + 255u) >> 8; for (unsigned t = 0; t < nt; ++t) tile_e[(acc >> 8) + t] = (unsigned char)e; acc += nt << 8; }
        pstart[NEXP] = acc; }
    __syncthreads();
    return (int)(pstart[NEXP] >> 8);
}
__device__ __forceinline__ void scatter_phase(LAS unsigned char* lds, const unsigned* counts, unsigned* cursor, const int* toke, int* rowtab, unsigned* rowoff) {
    moe_tables(lds, counts);
    LAS unsigned* pstart = (LAS unsigned*)(lds + LDS_MISC);
    LAS unsigned* cl = (LAS unsigned*)(lds + LDS_MISC + 1024);
    const int tid = threadIdx.x;
    for (int it = blockIdx.x; it < 2 * T_TOK / 256; it += gridDim.x) {
        if (tid < 64) cl[tid] = 0;
        __syncthreads();
        int a = -1, e = 0; unsigned rank = 0;
        if (tid < 256) { a = it * 256 + tid; e = toke[a]; rank = __hip_atomic_fetch_add(&cl[e], 1u, __ATOMIC_RELAXED, __HIP_MEMORY_SCOPE_WORKGROUP); }
        __syncthreads();
        if (tid < 32) { const unsigned n = cl[tid]; cl[32 + tid] = n ? __hip_atomic_fetch_add(cursor + tid, n, __ATOMIC_RELAXED, __HIP_MEMORY_SCOPE_AGENT) : 0u; }
        __syncthreads();
        if (tid < 256) { const unsigned pos = pstart[e] + cl[32 + e] + rank; rowtab[pos] = a; rowoff[pos] = (unsigned)(a >> 1) * 2048u; }
        __syncthreads();
    }
    if (blockIdx.x < NEXP) { const int e = blockIdx.x; const unsigned lo = pstart[e] + counts[e], hi = pstart[e + 1];
        for (unsigned pos = lo + tid; pos < hi; pos += 512) { rowtab[pos] = -1; rowoff[pos] = 0u; } }
}

__device__ __forceinline__ void e1_phase(float* h, const bf16_t* slot, bf16_t* hb, float* rsp) {
    int tid_ = threadIdx.x; asm volatile("" : "+v"(tid_));
    const int w = tid_ >> 6, lane = tid_ & 63;
    for (int row = blockIdx.x * 8 + w; row < T_TOK; row += gridDim.x * 8) {
        f32x4* hr = (f32x4*)(h + (size_t)row * DM) + lane;
        const u32x2* s0 = (const u32x2*)(slot + (size_t)(2 * row) * DM) + lane; const u32x2* s1 = (const u32x2*)(slot + (size_t)(2 * row + 1) * DM) + lane;
        u32x2* ob = (u32x2*)(hb + (size_t)row * DM) + lane;
        float ss = 0.f;
#pragma unroll
        for (int j = 0; j < 4; ++j) { f32x4 v = hr[64 * j]; const u32x2 a = s0[64 * j], b = s1[64 * j];
            v.x += bf2f(a.x & 0xffffu) + bf2f(b.x & 0xffffu); v.y += bf2f(a.x >> 16) + bf2f(b.x >> 16);
            v.z += bf2f(a.y & 0xffffu) + bf2f(b.y & 0xffffu); v.w += bf2f(a.y >> 16) + bf2f(b.y >> 16);
            hr[64 * j] = v; u32x2 o; o.x = cvt_pk_bf16(v.x, v.y); o.y = cvt_pk_bf16(v.z, v.w); ob[64 * j] = o;
            ss += v.x * v.x + v.y * v.y + v.z * v.z + v.w * v.w; }
        ss = wave_sum(ss);
        if (lane == 0) rsp[row] = 1.f / sqrtf(ss * (1.f / DM) + RMS_EPS);
    }
}
__device__ __forceinline__ void final_phase(float* h, const float* gain) {
    int tid_ = threadIdx.x; asm volatile("" : "+v"(tid_));
    const int w = tid_ >> 6, lane = tid_ & 63;
    for (int row = blockIdx.x * 8 + w; row < T_TOK; row += gridDim.x * 8) {
        f32x4* hr = (f32x4*)(h + (size_t)row * DM) + lane; const f32x4* gr = (const f32x4*)gain + lane;
        f32x4 v[4]; float ss = 0.f;
#pragma unroll
        for (int j = 0; j < 4; ++j) { v[j] = hr[64 * j]; ss += v[j].x * v[j].x + v[j].y * v[j].y + v[j].z * v[j].z + v[j].w * v[j].w; }
        ss = wave_sum(ss); const float r = 1.f / sqrtf(ss * (1.f / DM) + RMS_EPS);
#pragma unroll
        for (int j = 0; j < 4; ++j) hr[64 * j] = v[j] * r * gr[64 * j];
    }
}
__device__ __forceinline__ void vtrans_phase(LAS unsigned char* lds, const bf16_t* vs, const bf16_t* vw, bf16_t* vst, bf16_t* vwt) {
    LAS bf16_t* tl = (LAS bf16_t*)lds;
    int tid_ = threadIdx.x; asm volatile("" : "+v"(tid_));
    const int tid = tid_;
    for (int it = blockIdx.x; it < 2 * 16 * 128; it += gridDim.x) {
        const int which = it >> 11, r = it & 2047, bg = r >> 7, kt = r & 127, b = bg >> 2, g = bg & 3;
        const bf16_t* src = which ? vw : vs; bf16_t* dst = which ? vwt : vst;
        { const int key = tid >> 3, ch = tid & 7;
          const u32x4 v = *(const u32x4*)(src + ((size_t)b * SEQ + kt * 64 + key) * 256 + g * 64 + ch * 8);
          const int kp = swap23(key);
          const unsigned wv[4] = {v.x, v.y, v.z, v.w};
#pragma unroll
          for (int i = 0; i < 4; ++i) { tl[(ch * 8 + 2 * i) * 72 + kp] = (bf16_t)(wv[i] & 0xffffu); tl[(ch * 8 + 2 * i + 1) * 72 + kp] = (bf16_t)(wv[i] >> 16); } }
        __syncthreads();
        { const int d = tid >> 3, ch = tid & 7;
          const u32x4 v = *(const LAS u32x4*)(tl + d * 72 + ch * 8);
          *(u32x4*)(dst + ((size_t)bg * 64 + d) * SEQ + kt * 64 + ch * 8) = v; }
        __syncthreads();
    }
}

struct AttnArgs { const bf16_t* q; const float* gates; const bf16_t* kc; const bf16_t* vct; const bf16_t* ks; const bf16_t* vst; const bf16_t* kw; const bf16_t* vwt; bf16_t* out; };
#define ATT_MFMA(a, b, c) __builtin_amdgcn_mfma_f32_32x32x16_bf16(a, b, c, 0, 0, 0)
constexpr int ATP = 144;
constexpr int ATILE = 64 * ATP;
__device__ __forceinline__ void attn_phase(LAS unsigned char* lds, const AttnArgs& a) {
    int tid_ = threadIdx.x; asm volatile("" : "+v"(tid_));
    const int tid = tid_, w = tid >> 6, lane = tid & 63, n = lane & 31, h = lane >> 5;
    LAS unsigned char* KT = lds; LAS unsigned char* VT = lds + 2 * ATILE;
    LAS float* imp = (LAS float*)(lds + 4 * ATILE); LAS unsigned* selm = (LAS unsigned*)(lds + 4 * ATILE + 32768);
    const int srow = tid >> 3, sch = tid & 7;
    for (int it = blockIdx.x; it < 2048; it += gridDim.x) {
        const int rk = 7 - (it >> 8), cc = it & 255, bg = cc & 15, js = cc >> 4, b = bg >> 2, g = bg & 3;
        const int qb = (rk & 1) ? (16 * rk + 15 - js) : (16 * rk + js);
        const int tl = w * 8 + (n >> 2), t = qb * 64 + tl, hd = g * 4 + (n & 3);
        const size_t trow = (size_t)b * SEQ + t;
        bf16x8 Qf[4];
#pragma unroll
        for (int s = 0; s < 4; ++s) Qf[s] = *(const bf16x8*)(a.q + trow * 1024 + hd * 64 + 16 * s + 8 * h);
        const float g0 = a.gates[trow * 48 + hd * 3 + 0], g1 = a.gates[trow * 48 + hd * 3 + 1], g2 = a.gates[trow * 48 + hd * 3 + 2];
        for (int i = tid; i < 8192; i += 512) imp[i] = 0.f;
        const int nct = (4 * qb + 3 + 63) >> 6, wlo = qb > 8 ? qb - 8 : 0, nwin = qb - wlo + 1;
        const int e0 = nct, e1 = 2 * nct, e2 = 2 * nct + qb + 1, total = e2 + nwin;
        const int limc = (t >= 31) ? ((t - 31) >> 4) : -1;
        const char* kcb = (const char*)(a.kc + (size_t)bg * 512 * 64); const char* vcb = (const char*)(a.vct + (size_t)bg * 64 * 512);
        const char* ksb = (const char*)(a.ks + (size_t)b * SEQ * 256 + g * 64); const char* kwb = (const char*)(a.kw + (size_t)b * SEQ * 256 + g * 64);
        const char* vsb = (const char*)(a.vst + (size_t)bg * 64 * SEQ); const char* vwb = (const char*)(a.vwt + (size_t)bg * 64 * SEQ);
        u32x4 kreg, vreg;
#define ATT_FETCH(s_) do { const int s__ = (s_); const char* kp; const char* vp; \
            if (s__ < e1) { const int ct = s__ < e0 ? s__ : s__ - e0; kp = kcb + (size_t)(ct * 64 + srow) * 128 + sch * 16; vp = vcb + (size_t)srow * 1024 + ct * 128 + sch * 16; } \
            else if (s__ < e2) { const int j = s__ - e1; kp = ksb + (size_t)(j * 64 + srow) * 512 + sch * 16; vp = vsb + (size_t)srow * (SEQ * 2) + j * 128 + sch * 16; } \
            else { const int kt = wlo + s__ - e2; kp = kwb + (size_t)(kt * 64 + srow) * 512 + sch * 16; vp = vwb + (size_t)srow * (SEQ * 2) + kt * 128 + sch * 16; } \
            kreg = *(const u32x4*)kp; vreg = *(const u32x4*)vp; } while (0)
#define ATT_PUT(s_) do { const int bsel = (s_) & 1; *(LAS u32x4*)(KT + bsel * ATILE + srow * ATP + sch * 16) = kreg; *(LAS u32x4*)(VT + bsel * ATILE + srow * ATP + sch * 16) = vreg; } while (0)
        __syncthreads();
        ATT_FETCH(0); ATT_PUT(0);
        __syncthreads();
        f32x16 OUT[2], O[2];
#pragma unroll
        for (int d = 0; d < 2; ++d)
#pragma unroll
            for (int r = 0; r < 16; ++r) { OUT[d][r] = 0.f; O[d][r] = 0.f; }
        float mrun = -1e30f, lrun = 0.f, mc = -1e30f, invlc = 0.f;
        unsigned mw0 = 0, mw1 = 0, mw2 = 0, mw3 = 0;
        for (int s = 0; s < total; ++s) {
            if (s + 1 < total) ATT_FETCH(s + 1);
            const LAS unsigned char* Kb = KT + (s & 1) * ATILE; const LAS unsigned char* Vb = VT + (s & 1) * ATILE;
            int lo = 0, hi = -1; int type;
            if (s < e0) { type = 0; hi = limc - 64 * s; }
            else if (s < e1) { type = 1; hi = limc - 64 * (s - e0); }
            else if (s < e2) { type = 2; const int j = s - e1; const unsigned wsel = (j < 32) ? mw0 : (j < 64) ? mw1 : (j < 96) ? mw2 : mw3;
                hi = ((wsel >> (j & 31)) & 1u) ? (t - 64 * j) : -1; }
            else { type = 3; const int kt = wlo + s - e2; lo = t - 511 - 64 * kt; hi = t - 64 * kt; }
            if (hi > 63) hi = 63; if (lo < 0) lo = 0;
            const bool act = __ballot(lo <= hi) != 0ull;
            if (act) {
                f32x16 S[2];
#pragma unroll
                for (int kh = 0; kh < 2; ++kh) {
#pragma unroll
                    for (int r = 0; r < 16; ++r) S[kh][r] = 0.f;
#pragma unroll
                    for (int ks = 0; ks < 4; ++ks) { const bf16x8 A = *(const LAS bf16x8*)(Kb + (32 * kh + n) * ATP + 32 * ks + 16 * h); S[kh] = ATT_MFMA(A, Qf[ks], S[kh]); }
                }
                const int lo4 = lo - 4 * h, hi4 = hi - 4 * h;
                float mx = -1e30f;
#pragma unroll
                for (int kh = 0; kh < 2; ++kh)
#pragma unroll
                    for (int r = 0; r < 16; ++r) { const int cr = 32 * kh + (r & 3) + 8 * (r >> 2); const bool ok = (cr >= lo4) && (cr <= hi4);
                        const float sv = ok ? S[kh][r] : -1e30f; S[kh][r] = sv; mx = fmaxf(mx, sv); }
                mx = fmaxf(mx, __shfl_xor(mx, 32));
                float mref, pscale;
                if (type == 1) { mref = mc; pscale = invlc; }
                else { const float mnew = fmaxf(mrun, mx); const float alpha = __builtin_amdgcn_exp2f(mrun - mnew); mrun = mnew; lrun *= alpha; mref = mnew; pscale = 1.f;
                    if (type >= 2) {
#pragma unroll
                        for (int d = 0; d < 2; ++d)
#pragma unroll
                            for (int r = 0; r < 16; ++r) O[d][r] *= alpha; } }
                float rsum = 0.f;
#pragma unroll
                for (int kh = 0; kh < 2; ++kh)
#pragma unroll
                    for (int r = 0; r < 16; ++r) { const float sv = S[kh][r]; const float pv = (sv > -1e29f) ? __builtin_amdgcn_exp2f(sv - mref) * pscale : 0.f; S[kh][r] = pv; rsum += pv; }
                rsum += __shfl_xor(rsum, 32);
                if (type != 1) lrun += rsum;
                if (type == 1) {
                    const int ct = s - e0;
#pragma unroll
                    for (int kh = 0; kh < 2; ++kh)
#pragma unroll
                        for (int q4 = 0; q4 < 4; ++q4) {
                            float G = (S[kh][4 * q4] + S[kh][4 * q4 + 1]) + (S[kh][4 * q4 + 2] + S[kh][4 * q4 + 3]); float E = S[kh][4 * q4 + 3];
                            G += __shfl_xor(G, 1); G += __shfl_xor(G, 2); E += __shfl_xor(E, 1); E += __shfl_xor(E, 2);
                            const int jj = 16 * ct + 8 * kh + 2 * q4 + h;
                            if ((lane & 3) == 0) { imp[tl * 128 + jj] += G; if (jj + 1 < 128) imp[tl * 128 + jj + 1] += E; }
                        }
                }
                if (type >= 1) {
                    bf16x8 Pf[4];
#pragma unroll
                    for (int k4 = 0; k4 < 4; ++k4) { const int kh = k4 >> 1, sb = (k4 & 1) * 8; u32x4 pk;
                        pk.x = cvt_pk_bf16(S[kh][sb + 0], S[kh][sb + 1]); pk.y = cvt_pk_bf16(S[kh][sb + 2], S[kh][sb + 3]);
                        pk.z = cvt_pk_bf16(S[kh][sb + 4], S[kh][sb + 5]); pk.w = cvt_pk_bf16(S[kh][sb + 6], S[kh][sb + 7]);
                        Pf[k4] = __builtin_bit_cast(bf16x8, pk); }
#pragma unroll
                    for (int dt = 0; dt < 2; ++dt)
#pragma unroll
                        for (int k4 = 0; k4 < 4; ++k4) { const bf16x8 A = *(const LAS bf16x8*)(Vb + (32 * dt + n) * ATP + 32 * k4 + 16 * h); O[dt] = ATT_MFMA(A, Pf[k4], O[dt]); }
                }
            }
            if (s == e0 - 1) { mc = mrun; invlc = lrun > 0.f ? 1.f / lrun : 0.f; mrun = -1e30f; lrun = 0.f; }
            if (s == e1 - 1) {
#pragma unroll
                for (int d = 0; d < 2; ++d)
#pragma unroll
                    for (int r = 0; r < 16; ++r) { OUT[d][r] = g0 * O[d][r]; O[d][r] = 0.f; }
                mrun = -1e30f; lrun = 0.f;
                for (int tk = 0; tk < 8; ++tk) {
                    const int tok = w * 8 + tk; unsigned m0 = 0, m1 = 0, m2 = 0, m3 = 0;
                    if (qb < 16) { m0 = (2u << qb) - 1u; }
                    else {
                        const float c0 = imp[tok * 128 + lane], c1 = imp[tok * 128 + 64 + lane];
                        const bool v0 = (lane >= 1) && (lane <= qb - 2), v1 = (64 + lane) <= qb - 2;
                        unsigned k0h = v0 ? __float_as_uint(c0) : 0u, k0l = v0 ? (unsigned)(127 - lane) : 0u;
                        unsigned k1h = v1 ? __float_as_uint(c1) : 0u, k1l = v1 ? (unsigned)(63 - lane) : 0u;
#define ATT_SETB(j) do { const int j_ = (j); const unsigned bit_ = 1u << (j_ & 31); const int w_ = j_ >> 5; m0 |= (w_ == 0) ? bit_ : 0u; m1 |= (w_ == 1) ? bit_ : 0u; m2 |= (w_ == 2) ? bit_ : 0u; m3 |= (w_ == 3) ? bit_ : 0u; } while (0)
                        ATT_SETB(0); ATT_SETB(qb); ATT_SETB(qb - 1);
                        for (int itn = 0; itn < 13; ++itn) {
                            const bool f1 = (k1h > k0h) || (k1h == k0h && k1l > k0l);
                            unsigned bh = f1 ? k1h : k0h, bl = f1 ? k1l : k0l;
#pragma unroll
                            for (int o = 1; o < 64; o <<= 1) { const unsigned oh = __shfl_xor(bh, o), ol = __shfl_xor(bl, o); const bool tk2 = (oh > bh) || (oh == bh && ol > bl); bh = tk2 ? oh : bh; bl = tk2 ? ol : bl; }
                            const int jst = 127 - (int)(bl & 255u);
                            ATT_SETB(jst);
                            if (k0h == bh && k0l == bl) { k0h = 0u; k0l = 0u; } else if (k1h == bh && k1l == bl) { k1h = 0u; k1l = 0u; }
                        }
                    }
                    if (lane == 0) { selm[tok * 4 + 0] = m0; selm[tok * 4 + 1] = m1; selm[tok * 4 + 2] = m2; selm[tok * 4 + 3] = m3; }
                }
                mw0 = selm[tl * 4 + 0]; mw1 = selm[tl * 4 + 1]; mw2 = selm[tl * 4 + 2]; mw3 = selm[tl * 4 + 3];
            }
            if (s == e2 - 1 || s == total - 1) {
                const float gg = (s == e2 - 1) ? g1 : g2; const float sc = gg / fmaxf(lrun, 1e-30f);
#pragma unroll
                for (int d = 0; d < 2; ++d)
#pragma unroll
                    for (int r = 0; r < 16; ++r) { OUT[d][r] += sc * O[d][r]; O[d][r] = 0.f; }
                mrun = -1e30f; lrun = 0.f;
            }
            if (s + 1 < total) ATT_PUT(s + 1);
            __syncthreads();
        }
#pragma unroll
        for (int dt = 0; dt < 2; ++dt)
#pragma unroll
            for (int rq = 0; rq < 4; ++rq) { u32x2 o; o.x = cvt_pk_bf16(OUT[dt][4 * rq], OUT[dt][4 * rq + 1]); o.y = cvt_pk_bf16(OUT[dt][4 * rq + 2], OUT[dt][4 * rq + 3]);
                *(u32x2*)(a.out + trow * 1024 + hd * 64 + 32 * dt + 8 * rq + 4 * h) = o; }
#undef ATT_FETCH
#undef ATT_PUT
    }
}
constexpr int NPHASES = 1 + 8 + 8 + 11 + 9 + 1;


__global__ void __launch_bounds__(512, 2) yoco_fwd(Params p_unused) {
    extern __shared__ __attribute__((aligned(16))) unsigned char smem_[];
    LAS unsigned char* lds = (LAS unsigned char*)smem_;
    int p0, p1; { KParams Q = kparams(); p0 = Q->p0; p1 = Q->p1; }
    const bool multi = (p1 - p0) > 1;
    LAS unsigned* xbw = (LAS unsigned*)(lds + LDS_BYTES - 16);
    unsigned xcc = 0;
    if (multi) {
        if (threadIdx.x == 0) { xbw[0] = 0u; xbw[1] = 0u; xbw[2] = 0u; xbw[3] = 0u; }
        __syncthreads();
        KParams Q = kparams();
        XcdBarrier b0 = xcd_barrier_post((unsigned*)(Q->ws + WS_ZERO), (volatile LAS unsigned*)xbw); xcc = b0.x;
    }
    int pid = 0;
#define PH_BEGIN { const int me_ = pid++; if (p0 <= me_ && me_ < p1) { KParams Q = kparams(); unsigned char* ws = Q->ws; (void)ws;
#define PH_END   } if (p0 <= me_ && me_ + 1 < p1) { KParams Q2 = kparams(); XcdBarrier bar; bar.bar = (unsigned*)(Q2->ws + WS_ZERO); bar.x = xcc; bar.st = (volatile LAS unsigned*)xbw; xcd_barrier(bar); } }
#define WSP(T, off) ((T*)(ws + (off)))

    PH_BEGIN Params pl; pl.ws = ws; pl.out = Q->out; for (int i = 0; i < 34; ++i) pl.in[i] = Q->in[i]; prologue_phase(lds, pl); PH_END

    auto layer = [&](auto LC) __attribute__((always_inline)) {
        constexpr int L = decltype(LC)::value;
        if (L < 2) {
            PH_BEGIN stencil_phase(lds, (L == 0) ? Q->in[0] : Q->out, Q->in[2] + L * 1024, WSP(bf16_t, WS_ACT)); PH_END
            PH_BEGIN
                g8::DenseSched S; S.init(T_TOK / 256, 4); S.A = (const char*)(ws + WS_ACT); S.a_tile_b = (size_t)256 * 2048; S.a_pn_b = 512;
                S.Bt = (const char*)(ws + WS_WPOOL + (size_t)L * 1024 * 256 * 2); S.b_tile_b = (size_t)256 * 256 * 2;
                EpiResid<1> E; E.L = L;
                g8::gemm_phase<EpiResid<1>, g8::DenseSched, false>(lds, 256, 2048, 128, S, E);
            PH_END
        } else {
            const int J = L - 2;
            PH_BEGIN
                g8::DenseSched S; S.init(T_TOK / 256, J == 0 ? 11 : 5); S.A = (const char*)(ws + WS_HBA); S.a_tile_b = (size_t)256 * 2048;
                S.Bt = (const char*)(ws + (J == 0 ? WS_WKVQ : WS_WQG1)); S.b_tile_b = (size_t)256 * 1024 * 2;
                EpiQkv E; E.tile0 = (J == 0) ? 0 : 6; E.J = J;
                g8::gemm_phase<EpiQkv, g8::DenseSched, false>(lds, 1024, 2048, 128, S, E);
            PH_END
            if (J == 0) {
                PH_BEGIN
                    vtrans_phase(lds, WSP(bf16_t, WS_VS), WSP(bf16_t, WS_VW), WSP(bf16_t, WS_VST), WSP(bf16_t, WS_VWT));
                    __syncthreads();
                    g8::DenseSched S; S.init(32, 2); S.A = (const char*)(ws + WS_KVC); S.a_tile_b = 0; S.a_pn_b = 512; S.tab = WSP(unsigned, WS_CMPTAB);
                    S.Bt = (const char*)(ws + WS_WC1); S.b_tile_b = (size_t)256 * 2048 * 2;
                    EpiCmp1 E; E.dummy = 0;
                    g8::gemm_phase<EpiCmp1, g8::DenseSched, true>(lds, 2048, 0, 1024, S, E);
                PH_END
                PH_BEGIN
                    g8::DenseSched S; S.init(32, 2); S.A = (const char*)(ws + WS_CHID); S.a_tile_b = (size_t)256 * 512; S.a_pn_b = (size_t)8192 * 512;
                    S.Bt = (const char*)(ws + WS_WC2); S.b_tile_b = (size_t)256 * 256 * 2;
                    EpiCmp2 E; E.dummy = 0;
                    g8::gemm_phase<EpiCmp2, g8::DenseSched, false>(lds, 256, 512, 128, S, E);
                PH_END
            }
            PH_BEGIN
                AttnArgs a; a.q = WSP(bf16_t, WS_Q); a.gates = WSP(float, WS_GATES); a.kc = WSP(bf16_t, WS_KC); a.vct = WSP(bf16_t, WS_VCT);
                a.ks = WSP(bf16_t, WS_KS); a.vst = WSP(bf16_t, WS_VST); a.kw = WSP(bf16_t, WS_KW); a.vwt = WSP(bf16_t, WS_VWT); a.out = WSP(bf16_t, WS_ACT);
                attn_phase(lds, a);
            PH_END
            PH_BEGIN
                g8::DenseSched S; S.init(T_TOK / 256, 4); S.A = (const char*)(ws + WS_ACT); S.a_tile_b = (size_t)256 * 2048;
                S.Bt = (const char*)(ws + WS_WO + (size_t)J * 1024 * 1024 * 2); S.b_tile_b = (size_t)256 * 1024 * 2;
                EpiResid<0> E; E.L = L;
                g8::gemm_phase<EpiResid<0>, g8::DenseSched, false>(lds, 1024, 2048, 128, S, E);
            PH_END
        }
        PH_BEGIN
            unsigned* counts = WSP(unsigned, WS_ZERO + ZO_COUNTS) + L * 32;
            LAS unsigned* hist = (LAS unsigned*)(lds + LDS_MISC);
            if (threadIdx.x < 32) hist[threadIdx.x] = 0u;
            __syncthreads();
            g8::DenseSched S; S.init(T_TOK / 256, 1); S.A = (const char*)(ws + WS_HBA); S.a_tile_b = (size_t)256 * 2048;
            S.Bt = (const char*)(ws + WS_WR + (size_t)L * 256 * 1024 * 2); S.b_tile_b = 0;
            EpiRouter E; E.L = L; E.hist = hist;
            g8::gemm_phase<EpiRouter, g8::DenseSched, false>(lds, 1024, 2048, 128, S, E);
            __syncthreads();
            if (threadIdx.x < 32 && hist[threadIdx.x]) __hip_atomic_fetch_add(counts + threadIdx.x, hist[threadIdx.x], __ATOMIC_RELAXED, __HIP_MEMORY_SCOPE_AGENT);
        PH_END
        PH_BEGIN scatter_phase(lds, WSP(unsigned, WS_ZERO + ZO_COUNTS) + L * 32, WSP(unsigned, WS_ZERO + ZO_CURSOR) + L * 32, WSP(int, WS_TOKE), WSP(int, WS_ROWTAB), WSP(unsigned, WS_ROWOFF)); PH_END
        PH_BEGIN
            const int ntiles = moe_tables(lds, WSP(unsigned, WS_ZERO + ZO_COUNTS) + L * 32);
            g8::MoeSched S; S.nunits = ntiles * 4; S.NPN = 4; S.G = gridDim.x; S.c = blockIdx.x; S.A = (const char*)(ws + WS_HBA); S.a_tile_b = 0;
            S.W = (const char*)(ws + WS_W13 + (size_t)L * 32 * 1024 * 1024 * 2); S.w_e_b = (size_t)1024 * 1024 * 2; S.b_tile_b = (size_t)256 * 1024 * 2;
            S.tab = WSP(unsigned, WS_ROWOFF); S.tile_e = lds + LDS_MISC + 256;
            EpiMoe1 E; E.dummy = 0;
            g8::gemm_phase<EpiMoe1, g8::MoeSched, true>(lds, 1024, 0, 128, S, E);
        PH_END
        PH_BEGIN
            const int ntiles = moe_tables(lds, WSP(unsigned, WS_ZERO + ZO_COUNTS) + L * 32);
            g8::MoeSched S; S.nunits = ntiles * 4; S.NPN = 4; S.G = gridDim.x; S.c = blockIdx.x; S.A = (const char*)(ws + WS_HBUF); S.a_tile_b = (size_t)256 * 1024;
            S.W = (const char*)(ws + WS_W2 + (size_t)L * 32 * 1024 * 512 * 2); S.w_e_b = (size_t)1024 * 512 * 2; S.b_tile_b = (size_t)256 * 512 * 2;
            S.tab = nullptr; S.tile_e = lds + LDS_MISC + 256;
            EpiMoe2 E; E.dummy = 0;
            g8::gemm_phase<EpiMoe2, g8::MoeSched, false>(lds, 512, 1024, 128, S, E);
        PH_END
        PH_BEGIN
            e1_phase(Q->out, WSP(bf16_t, WS_SLOT), WSP(bf16_t, WS_HBB), WSP(float, WS_RSP));
            g8::DenseSched S; S.init(T_TOK / 256, 4); S.A = (const char*)(ws + WS_PB + (size_t)L * T_TOK * 256 * 2); S.a_tile_b = (size_t)256 * 512;
            S.Bt = (const char*)(ws + WS_WPP + (size_t)L * 1024 * 256 * 2); S.b_tile_b = (size_t)256 * 256 * 2;
            EpiBf16 E; E.dummy = 0;
            g8::gemm_phase<EpiBf16, g8::DenseSched, false>(lds, 256, 512, 128, S, E);
        PH_END
        PH_BEGIN
            g8::DenseSched S; S.init(T_TOK / 256, 4); S.A = (const char*)(ws + WS_HBB); S.a_tile_b = (size_t)256 * 2048;
            S.Bt = (const char*)(ws + WS_WPG + (size_t)L * 1024 * 1024 * 2); S.b_tile_b = (size_t)256 * 1024 * 2;
            EpiResid<2> E; E.L = L;
            g8::gemm_phase<EpiResid<2>, g8::DenseSched, false>(lds, 1024, 2048, 128, S, E);
        PH_END
    };
    layer(IC<0>{}); layer(IC<1>{}); layer(IC<2>{}); layer(IC<3>{});
    PH_BEGIN final_phase(Q->out, Q->in[33]); PH_END
#undef PH_BEGIN
#undef PH_END
}

#ifndef MK_LAUNCHES
#define MK_LAUNCHES 0
#endif

extern "C" void kernel_launch(void* const* d_in, const int* in_sizes, int n_in, void* d_out, int out_size, void* d_ws, size_t ws_size, hipStream_t stream) {
    static int ready = 0;
    if (!ready) {
        if (n_in != 34 || out_size != T_TOK * DM || ws_size < WS_END) { fprintf(stderr, "kernel_launch: unexpected sizes (n_in %d out %d ws %zu need %zu)\n", n_in, out_size, ws_size, (size_t)WS_END); ready = -1; return; }
        if (hipFuncSetAttribute((const void*)yoco_fwd, hipFuncAttributeMaxDynamicSharedMemorySize, LDS_BYTES) != hipSuccess) { fprintf(stderr, "kernel_launch: hipFuncSetAttribute failed\n"); ready = -1; return; }
        int per_cu = 0;
        if (hipOccupancyMaxActiveBlocksPerMultiprocessor(&per_cu, (const void*)yoco_fwd, 512, LDS_BYTES) != hipSuccess || per_cu < 1) fprintf(stderr, "kernel_launch: occupancy query reports %d\n", per_cu);
        (void)hipGetLastError();
        ready = 1;
    }
    if (ready < 0) return;
    (void)hipMemsetAsync((char*)d_ws + WS_ZERO, 0, ZERO_BYTES, stream);
    Params p{};
    for (int i = 0; i < 34; ++i) p.in[i] = (const float*)d_in[i];
    p.out = (float*)d_out; p.ws = (unsigned char*)d_ws;
#if MK_LAUNCHES == 1
    p.p0 = 0; p.p1 = NPHASES;
    hipLaunchKernelGGL(yoco_fwd, dim3(256), dim3(512), LDS_BYTES, stream, p);
#else
    for (int ph = 0; ph < NPHASES; ++ph) { p.p0 = ph; p.p1 = ph + 1; hipLaunchKernelGGL(yoco_fwd, dim3(256), dim3(512), LDS_BYTES, stream, p); }
#endif
}
```

```cpp
#define MK_LAUNCHES 1
#include <hip/hip_runtime.h>
#include <stdint.h>
#include <stddef.h>
#include <stdio.h>

#define LAS __attribute__((address_space(3)))
typedef unsigned short bf16_t;
typedef short bf16x8 __attribute__((ext_vector_type(8)));
typedef float f32x4 __attribute__((ext_vector_type(4)));
typedef float f32x2 __attribute__((ext_vector_type(2)));
typedef float f32x16 __attribute__((ext_vector_type(16)));
typedef unsigned u32x4 __attribute__((ext_vector_type(4)));
typedef unsigned u32x2 __attribute__((ext_vector_type(2)));

constexpr int T_TOK = 32768, DM = 1024, SEQ = 8192, NBATCH = 4;
constexpr int NEXP = 32, DFF = 512;
constexpr int PMAX = 65536 + 8192;
constexpr float RMS_EPS = 1e-6f;
constexpr float QSCALE = 0.125f * 1.4426950408889634f;

constexpr size_t al256(size_t x) { return (x + 255) & ~(size_t)255; }
constexpr size_t WS_ZERO   = 0;
constexpr size_t ZERO_BYTES = 65536;
constexpr size_t ZO_COUNTS = 16384;
constexpr size_t ZO_CURSOR = 16384 + 1024;
constexpr size_t WS_ROPE   = WS_ZERO + ZERO_BYTES;
constexpr size_t WS_CMPTAB = WS_ROPE + (size_t)SEQ * 16 * 4;
constexpr size_t WS_CB1    = WS_CMPTAB + 8192 * 4;
constexpr size_t WS_WPOOL  = WS_CB1 + 2 * 256 * 4;
constexpr size_t WS_WKVQ   = WS_WPOOL + (size_t)2 * 1024 * 256 * 2;
constexpr size_t WS_WQG1   = WS_WKVQ + (size_t)2816 * 1024 * 2;
constexpr size_t WS_WC1    = WS_WQG1 + (size_t)1280 * 1024 * 2;
constexpr size_t WS_WC2    = WS_WC1 + (size_t)2 * 256 * 2048 * 2;
constexpr size_t WS_WO     = WS_WC2 + (size_t)2 * 256 * 256 * 2;
constexpr size_t WS_WR     = WS_WO + (size_t)2 * 1024 * 1024 * 2;
constexpr size_t WS_WPP    = WS_WR + (size_t)4 * 256 * 1024 * 2;
constexpr size_t WS_WPG    = WS_WPP + (size_t)4 * 1024 * 256 * 2;
constexpr size_t WS_W13    = WS_WPG + (size_t)4 * 1024 * 1024 * 2;
constexpr size_t WS_W2     = WS_W13 + (size_t)128 * 1024 * 1024 * 2;
constexpr size_t WS_PB     = WS_W2 + (size_t)128 * 1024 * 512 * 2;
constexpr size_t WS_HBA    = WS_PB + (size_t)4 * T_TOK * 256 * 2;
constexpr size_t WS_HBB    = WS_HBA + (size_t)T_TOK * 1024 * 2;
constexpr size_t WS_SSQ    = WS_HBB + (size_t)T_TOK * 1024 * 2;
constexpr size_t WS_RSF    = WS_SSQ + (size_t)T_TOK * 16 * 4;
constexpr size_t WS_RSP    = WS_RSF + (size_t)T_TOK * 4;
constexpr size_t WS_TOKE   = WS_RSP + (size_t)T_TOK * 4;
constexpr size_t WS_TOKW   = WS_TOKE + (size_t)T_TOK * 8;
constexpr size_t WS_ROWTAB = WS_TOKW + (size_t)T_TOK * 8;
constexpr size_t WS_ROWOFF = WS_ROWTAB + (size_t)PMAX * 4;
constexpr size_t WS_GATES  = WS_ROWOFF + (size_t)PMAX * 4;
constexpr size_t WS_KC     = WS_GATES + (size_t)T_TOK * 48 * 4;
constexpr size_t WS_VCT    = WS_KC + (size_t)16 * 512 * 64 * 2;
constexpr size_t WS_CHID   = WS_VCT + (size_t)16 * 512 * 64 * 2;
constexpr size_t WS_KS     = WS_CHID + (size_t)2 * 8192 * 256 * 2;
constexpr size_t WS_KW     = WS_KS + (size_t)T_TOK * 256 * 2;
constexpr size_t WS_VST    = WS_KW + (size_t)T_TOK * 256 * 2;
constexpr size_t WS_VWT    = WS_VST + (size_t)T_TOK * 256 * 2;
constexpr size_t WS_ACT    = WS_VWT + (size_t)T_TOK * 256 * 2;
constexpr size_t WS_HBUF   = WS_ACT + (size_t)T_TOK * 1024 * 2;
constexpr size_t WS_SLOT   = WS_HBUF + (size_t)PMAX * 512 * 2;
constexpr size_t WS_END    = WS_SLOT + (size_t)2 * T_TOK * 1024 * 2;
constexpr size_t WS_Q      = WS_HBUF;
constexpr size_t WS_KVC    = WS_SLOT;
constexpr size_t WS_VS     = WS_KVC + (size_t)T_TOK * 512 * 2;
constexpr size_t WS_VW     = WS_VS + (size_t)T_TOK * 256 * 2;

constexpr int LDS_BYTES = 160 * 1024;
constexpr int LDS_MISC  = 128 * 1024;

struct Params {
    const float* in[34];
    float* out;
    unsigned char* ws;
    int p0, p1;
};

template <int N> struct IC { static constexpr int value = N; };
typedef const __attribute__((address_space(4))) Params* KParams;
__device__ __forceinline__ KParams kparams() { KParams q = (KParams)__builtin_amdgcn_kernarg_segment_ptr(); asm volatile("" : "+s"(q)); return q; }

__device__ __forceinline__ unsigned cvt_pk_bf16(float lo, float hi) { unsigned r; asm volatile("v_cvt_pk_bf16_f32 %0, %1, %2" : "=v"(r) : "v"(lo), "v"(hi)); return r; }
__device__ __forceinline__ bf16_t f2bf(float f) { return (bf16_t)(cvt_pk_bf16(f, 0.f) & 0xffffu); }
__device__ __forceinline__ float bf2f(unsigned b) { return __uint_as_float(b << 16); }
__device__ __forceinline__ float wave_sum(float v) {
#pragma unroll
    for (int o = 1; o < 64; o <<= 1) v += __shfl_xor(v, o);
    return v;
}
__device__ __forceinline__ float sigmoidf_(float x) { return 1.f / (1.f + __expf(-x)); }
__device__ __forceinline__ int swap23(int k) { return (k & ~12) | ((k & 4) << 1) | ((k & 8) >> 1); }

#define XB_TMO      128
#define XB_XCNT(j)  (256  + 64 * (j))
#define XB_XSUB(j)  (1280 + 64 * (j))
#define XB_XGEN(j)  (2304 + 64 * (j))
#define XB_TOP      3328
#define XB_TOPGEN   3392
#define XCD_BAR_WORDS 3456
#define XB_SPIN_CAP (1u << 18)
__device__ __forceinline__ unsigned xb_ld(unsigned* p)              { return __hip_atomic_load(p, __ATOMIC_RELAXED, __HIP_MEMORY_SCOPE_AGENT); }
__device__ __forceinline__ unsigned xb_add(unsigned* p, unsigned v) { return __hip_atomic_fetch_add(p, v, __ATOMIC_RELAXED, __HIP_MEMORY_SCOPE_AGENT); }
__device__ __forceinline__ unsigned xb_xcc_id() { return (unsigned)__builtin_amdgcn_s_getreg((3 << 11) | 20) & 0xFu; }
#define XB_SPIN(cond, bar) do { unsigned _sp = 0; while (cond) { __builtin_amdgcn_s_sleep(1); \
    if ((++_sp & 255u) == 0u) { if (xb_ld(&(bar)[XB_TMO])) break; if (_sp > XB_SPIN_CAP) { atomicAdd(&(bar)[XB_TMO], 1u); break; } } } } while (0)
struct XcdBarrier { unsigned* bar; unsigned x; volatile LAS unsigned* st; };
__device__ __forceinline__ XcdBarrier xcd_barrier_post(unsigned* bar, volatile LAS unsigned* st) {
    XcdBarrier b; b.bar = bar; b.x = xb_xcc_id(); b.st = st;
    if (threadIdx.x == 0) (void)xb_add(&bar[XB_XCNT(b.x)], 1u);
    return b;
}
__device__ __forceinline__ void xcd_barrier_complete(unsigned* bar, unsigned x, unsigned& nloc, unsigned& nx) {
    const unsigned G = gridDim.x * gridDim.y * gridDim.z;
    unsigned sum, cnt, mine, sp = 0u;
    for (;;) {
        sum = 0u; cnt = 0u; mine = 0u;
#pragma unroll
        for (unsigned j = 0; j < 16; ++j) { const unsigned c = xb_ld(&bar[XB_XCNT(j)]); sum += c; cnt += (c > 0u) ? 1u : 0u; mine = (j == x) ? c : mine; }
        if (sum == G) break;
        __builtin_amdgcn_s_sleep(1);
        if ((++sp & 255u) == 0u) { if (xb_ld(&bar[XB_TMO])) break; if (sp > XB_SPIN_CAP) { atomicAdd(&bar[XB_TMO], 1u); break; } }
    }
    nloc = mine > 0u ? mine : 1u; nx = cnt > 0u ? cnt : 1u;
}
__device__ __forceinline__ void xcd_barrier(const XcdBarrier& b) {
    asm volatile("s_waitcnt vmcnt(0)" ::: "memory");
    __syncthreads();
    if (threadIdx.x == 0) {
        unsigned* bar = b.bar;
        __builtin_amdgcn_s_waitcnt(0);
        unsigned nloc = b.st[0], nx = b.st[1];
        if (nloc == 0u) { xcd_barrier_complete(bar, b.x, nloc, nx); b.st[0] = nloc; b.st[1] = nx; }
        const unsigned old = xb_add(&bar[XB_XSUB(b.x)], 1u);
        const unsigned gen = old / nloc;
        if (old + 1u == (gen + 1u) * nloc) {
            __builtin_amdgcn_fence(__ATOMIC_RELEASE, "agent");
            asm volatile("s_waitcnt vmcnt(0)" ::: "memory");
            const unsigned og = xb_add(&bar[XB_TOP], 1u);
            const unsigned tg = og / nx;
            if (og + 1u == (tg + 1u) * nx) xb_add(&bar[XB_TOPGEN], 1u);
            else XB_SPIN(xb_ld(&bar[XB_TOPGEN]) == tg, bar);
            __builtin_amdgcn_fence(__ATOMIC_ACQUIRE, "agent");
            xb_add(&bar[XB_XGEN(b.x)], 1u);
            asm volatile("s_waitcnt vmcnt(0)" ::: "memory");
        } else {
            XB_SPIN(xb_ld(&bar[XB_XGEN(b.x)]) == gen, bar);
            __builtin_amdgcn_fence(__ATOMIC_ACQUIRE, "agent");
            asm volatile("s_waitcnt vmcnt(0)" ::: "memory");
        }
    }
    __syncthreads();
}

namespace g8 {
constexpr int BM = 256, BK = 64, HALF = 128, HTB = HALF * BK * 2, STAGE_BYTES = 8 * HTB, NXCD = 8, WGM = 8;
__host__ __device__ __forceinline__ int lds_byte(int r, int c) { const int st = (r >> 4) * 2 + (c >> 5), rr = r & 15, cc = c & 31, ob = rr * 64 + cc * 2; return st * 1024 + (ob ^ (((ob >> 9) & 1) << 5)); }
__host__ __device__ __forceinline__ void stage_rc(int b, int& R, int& C) { const int st = b / 1024, sb = b % 1024, swz = sb ^ (((sb >> 9) & 1) << 5); R = (st >> 1) * 16 + swz / 64; C = (st & 1) * 32 + (swz % 64) / 2; }
__host__ __device__ __forceinline__ int perm32(int rho) { const int n = rho >> 4, i = rho & 15; return 8 * (i >> 2) + 4 * n + (i & 3); }
struct Unit { int pm, pn; };

struct DenseSched {
    int nM, nN, nwg, G, c;
    const char* A; const char* Bt; size_t a_tile_b, a_pn_b, b_tile_b; const unsigned* tab;
    __device__ __forceinline__ void init(int nM_, int nN_) { nM = nM_; nN = nN_; nwg = nM * nN; G = gridDim.x; c = blockIdx.x; tab = nullptr; a_pn_b = 0; }
    __device__ __forceinline__ bool next(int i, Unit& u) const {
        const long L = (long)i * G + c; if (L >= nwg) return false;
        int wgid = (int)L; { const int q = nwg / NXCD, r = nwg % NXCD, xcd = wgid % NXCD, off = wgid / NXCD; wgid = (xcd < r ? xcd * (q + 1) : r * (q + 1) + (xcd - r) * q) + off; }
        const int nig = WGM * nN, gid = wgid / nig, fm = gid * WGM, gsz = (nM - fm) < WGM ? (nM - fm) : WGM;
        u.pm = fm + ((wgid % nig) % gsz); u.pn = (wgid % nig) / gsz; return true;
    }
    __device__ __forceinline__ const char* a_base(const Unit& u) const { return A + (size_t)u.pm * a_tile_b + (size_t)u.pn * a_pn_b; }
    __device__ __forceinline__ const char* b_base(const Unit& u) const { return Bt + (size_t)u.pn * b_tile_b; }
    __device__ __forceinline__ const unsigned* row_tab(const Unit& u) const { return tab + u.pm * 256; }
};
struct MoeSched {
    int nunits, NPN, G, c;
    const char* A; const char* W; size_t a_tile_b, w_e_b, b_tile_b; const unsigned* tab; const LAS unsigned char* tile_e;
    __device__ __forceinline__ bool next(int i, Unit& u) const {
        const long L = (long)i * G + c; if (L >= nunits) return false;
        u.pm = (int)L / NPN; u.pn = (int)L % NPN; return true;
    }
    __device__ __forceinline__ const char* a_base(const Unit& u) const { return A + (size_t)u.pm * a_tile_b; }
    __device__ __forceinline__ const char* b_base(const Unit& u) const { return W + (size_t)tile_e[u.pm] * w_e_b + (size_t)u.pn * b_tile_b; }
    __device__ __forceinline__ const unsigned* row_tab(const Unit& u) const { return tab + u.pm * 256; }
};

template <class Epi, class Sched, bool GATHER>
__device__ __forceinline__ void gemm_phase(LAS unsigned char* lds, const int K_, const int lda_b, const int kstepA, const Sched& S, const Epi& E) {
    int K = K_; asm volatile("" : "+s"(K));
    int tid_ = threadIdx.x; asm volatile("" : "+v"(tid_));
    const int tid = tid_, wid = __builtin_amdgcn_readfirstlane(tid >> 6), lane = tid & 63, wr = wid >> 2, wc = wid & 3, fr = lane & 15, fq = lane >> 4;
    const int nt = K / BK;
    unsigned voffB[2], va[2][2], vn[2][2];
#pragma unroll
    for (int i = 0; i < 2; ++i) { int R, C; stage_rc(tid * 16 + i * 8192, R, C); const int Rb = Epi::PERM ? ((R & ~31) + perm32(R & 31)) : R;
        voffB[i] = (unsigned)(Rb * K + C) * 2u;
        va[0][i] = (unsigned)(R * lda_b + C * 2); va[1][i] = (unsigned)((R + HALF) * lda_b + C * 2); vn[0][i] = va[0][i]; vn[1][i] = va[1][i]; }
    const size_t kstepB = (size_t)(BK * 2);
    const size_t hstepB = (size_t)HALF * K * 2;
    const unsigned ldsw = (unsigned)wid * 1024u;
    const int aoff = lds_byte(wr * 64 + fr, fq * 8), boff = lds_byte(wc * 32 + fr, fq * 8);
#define G8_SA(b, h) (((b) * 2 + (h)) * HTB)
#define G8_SB(b, h) ((4 + (b) * 2 + (h)) * HTB)
#define G8_STAGEB(bufoff, gbase) do { _Pragma("unroll") for (int _i = 0; _i < 2; ++_i) \
        __builtin_amdgcn_global_load_lds((const unsigned*)((const char*)(gbase) + voffB[_i]), (LAS unsigned*)(lds + (bufoff) + ldsw + _i * 8192), 16, 0, 0); } while (0)
#define G8_STAGEA(bufoff, gbase, VA, h) do { _Pragma("unroll") for (int _i = 0; _i < 2; ++_i) \
        __builtin_amdgcn_global_load_lds((const unsigned*)((const char*)(gbase) + (VA)[h][_i]), (LAS unsigned*)(lds + (bufoff) + ldsw + _i * 8192), 16, 0, 0); } while (0)
#define G8_LDA(dst, b, h) do { _Pragma("unroll") for (int m = 0; m < 4; ++m) _Pragma("unroll") for (int k = 0; k < 2; ++k) dst[m][k] = *(const LAS bf16x8*)(lds + G8_SA(b, h) + aoff + m * 2048 + k * 1024); } while (0)
#define G8_LDB(dst, b, h) do { _Pragma("unroll") for (int n = 0; n < 2; ++n) _Pragma("unroll") for (int k = 0; k < 2; ++k) dst[n][k] = *(const LAS bf16x8*)(lds + G8_SB(b, h) + boff + n * 2048 + k * 1024); } while (0)
#define G8_MMA(ai, bj, At, Bt) do { __builtin_amdgcn_s_setprio(1); _Pragma("unroll") for (int m = 0; m < 4; ++m) _Pragma("unroll") for (int n = 0; n < 2; ++n) _Pragma("unroll") for (int k = 0; k < 2; ++k) \
        acc[ai][bj][m][n] = __builtin_amdgcn_mfma_f32_16x16x32_bf16(Bt[n][k], At[m][k], acc[ai][bj][m][n], 0, 0, 0); __builtin_amdgcn_s_setprio(0); } while (0)
#define G8_WAIT_V(n) asm volatile("s_waitcnt vmcnt(" #n ")" ::: "memory")
#define G8_WAIT_L(n) asm volatile("s_waitcnt lgkmcnt(" #n ")" ::: "memory")
#define G8_BAR __builtin_amdgcn_s_barrier()
#define G8_SCHED __builtin_amdgcn_sched_barrier(0)
    Unit cur, nxt; int ui = 0;
    if (!S.next(0, cur)) return;
    f32x4 acc[2][2][4][2];
#pragma unroll
    for (int a = 0; a < 2; ++a)
#pragma unroll
        for (int b = 0; b < 2; ++b)
#pragma unroll
            for (int m = 0; m < 4; ++m)
#pragma unroll
                for (int n = 0; n < 2; ++n) acc[a][b][m][n] = (f32x4){0.f, 0.f, 0.f, 0.f};
    bf16x8 At[4][2], B0[2][2], B1[2][2];
    const char* cA = S.a_base(cur); const char* cB = S.b_base(cur);
    if (GATHER) { const unsigned* tb = S.row_tab(cur);
#pragma unroll
        for (int i = 0; i < 2; ++i) { int R, C; stage_rc(tid * 16 + i * 8192, R, C); va[0][i] = tb[R] + (unsigned)(C * 2); va[1][i] = tb[R + HALF] + (unsigned)(C * 2); } }
    G8_STAGEB(G8_SB(0, 0), cB); G8_STAGEA(G8_SA(0, 0), cA, va, 0); G8_STAGEB(G8_SB(0, 1), cB + hstepB); G8_STAGEA(G8_SA(0, 1), cA, va, 1);
    if (wr == 1) G8_BAR;
    G8_WAIT_V(4); G8_BAR;
    G8_STAGEB(G8_SB(1, 0), cB + kstepB); G8_STAGEA(G8_SA(1, 0), cA + kstepA, va, 0); G8_STAGEB(G8_SB(1, 1), cB + hstepB + kstepB);
    G8_WAIT_V(6); G8_BAR;
    for (;;) {
        const bool has_next = S.next(ui + 1, nxt);
        const char* nA = has_next ? S.a_base(nxt) : cA; const char* nB = has_next ? S.b_base(nxt) : cB;
        if (GATHER) {
            if (has_next) { const unsigned* tb = S.row_tab(nxt);
#pragma unroll
                for (int i = 0; i < 2; ++i) { int R, C; stage_rc(tid * 16 + i * 8192, R, C); vn[0][i] = tb[R] + (unsigned)(C * 2); vn[1][i] = tb[R + HALF] + (unsigned)(C * 2); } }
            else {
#pragma unroll
                for (int i = 0; i < 2; ++i) { vn[0][i] = va[0][i]; vn[1][i] = va[1][i]; } }
        }
        for (int t = 0; t < nt; t += 2) {
            const bool last = (t == nt - 2);
            const char* a1 = cA + (size_t)(t + 1) * kstepA;
            const char* a2 = last ? nA : cA + (size_t)(t + 2) * kstepA; const char* b2 = last ? nB : cB + (size_t)(t + 2) * kstepB;
            const char* a3 = a2 + kstepA; const char* b3 = b2 + kstepB;
            unsigned vx[2][2];
#pragma unroll
            for (int hh = 0; hh < 2; ++hh)
#pragma unroll
                for (int i = 0; i < 2; ++i) vx[hh][i] = (GATHER && last) ? vn[hh][i] : va[hh][i];
            G8_LDB(B0, 0, 0); G8_SCHED; G8_LDA(At, 0, 0); G8_STAGEA(G8_SA(1, 1), a1, va, 1);
            G8_WAIT_L(8); G8_BAR; G8_WAIT_L(0); G8_MMA(0, 0, At, B0); G8_BAR; G8_SCHED;
            G8_LDB(B1, 0, 1); G8_STAGEB(G8_SB(0, 0), b2);
            G8_BAR; G8_WAIT_L(0); G8_MMA(0, 1, At, B1); G8_BAR;
            G8_LDA(At, 0, 1); G8_STAGEA(G8_SA(0, 0), a2, vx, 0);
            G8_BAR; G8_WAIT_L(0); G8_MMA(1, 0, At, B0); G8_BAR; G8_SCHED;
            G8_STAGEB(G8_SB(0, 1), b2 + hstepB);
            G8_WAIT_V(6); G8_BAR; G8_MMA(1, 1, At, B1); G8_BAR;
            G8_LDB(B0, 1, 0); G8_SCHED; G8_LDA(At, 1, 0); G8_STAGEA(G8_SA(0, 1), a2, vx, 1);
            G8_WAIT_L(8); G8_BAR; G8_WAIT_L(0); G8_MMA(0, 0, At, B0); G8_BAR; G8_SCHED;
            G8_LDB(B1, 1, 1); G8_STAGEB(G8_SB(1, 0), b3);
            G8_BAR; G8_WAIT_L(0); G8_MMA(0, 1, At, B1); G8_BAR;
            G8_LDA(At, 1, 1); G8_STAGEA(G8_SA(1, 0), a3, vx, 0);
            G8_BAR; G8_WAIT_L(0); G8_MMA(1, 0, At, B0); G8_BAR; G8_SCHED;
            G8_STAGEB(G8_SB(1, 1), b3 + hstepB);
            G8_WAIT_V(6); G8_BAR; G8_MMA(1, 1, At, B1); G8_BAR;
        }
        E(acc, cur, wr, wc, fr, fq);
        if (!has_next) break;
#pragma unroll
        for (int a = 0; a < 2; ++a)
#pragma unroll
            for (int b = 0; b < 2; ++b)
#pragma unroll
                for (int m = 0; m < 4; ++m)
#pragma unroll
                    for (int n = 0; n < 2; ++n) acc[a][b][m][n] = (f32x4){0.f, 0.f, 0.f, 0.f};
        cur = nxt; cA = nA; cB = nB; ++ui;
        if (GATHER) {
#pragma unroll
            for (int i = 0; i < 2; ++i) { va[0][i] = vn[0][i]; va[1][i] = vn[1][i]; } }
    }
    G8_WAIT_V(0);
    if (wr == 0) G8_BAR;
    G8_BAR;
#undef G8_SA
#undef G8_SB
#undef G8_STAGEA
#undef G8_STAGEB
#undef G8_LDA
#undef G8_LDB
#undef G8_MMA
#undef G8_WAIT_V
#undef G8_WAIT_L
#undef G8_BAR
#undef G8_SCHED
}
}
using g8::Unit;

typedef f32x4 AccT[2][2][4][2];

template <int MODE> struct EpiResid {
    static constexpr bool PERM = false;
    int L;
    __device__ __forceinline__ void operator()(const AccT& acc, const Unit& u, int wr, int wc, int fr, int fq) const {
        KParams Q = kparams(); unsigned char* ws = Q->ws;
        const float* hin = (MODE == 1 && L == 0) ? Q->in[0] : Q->out; float* hout = Q->out; bf16_t* hb = (bf16_t*)(ws + WS_HBA); float* ssq = (float*)(ws + WS_SSQ);
        const float* bias = (MODE == 1) ? Q->in[6] + L * 1024 : Q->in[32] + L * 1024; const float* scale = Q->in[7] + L * 1024;
        const bf16_t* ple = (const bf16_t*)(ws + WS_ACT); const float* rstd = (const float*)(ws + WS_RSP);
        const int col0 = u.pn * 256 + wc * 32 + 4 * fq;
        f32x4 bv[2][2], sv[2][2];
#pragma unroll
        for (int bj = 0; bj < 2; ++bj)
#pragma unroll
            for (int n = 0; n < 2; ++n) {
                bv[bj][n] = (MODE != 0) ? *(const f32x4*)(bias + col0 + bj * 128 + n * 16) : (f32x4){0.f, 0.f, 0.f, 0.f};
                sv[bj][n] = (MODE == 1) ? *(const f32x4*)(scale + col0 + bj * 128 + n * 16) : (f32x4){1.f, 1.f, 1.f, 1.f}; }
#pragma unroll
        for (int ai = 0; ai < 2; ++ai)
#pragma unroll
            for (int m = 0; m < 4; ++m) {
                const int row = u.pm * 256 + ai * 128 + wr * 64 + m * 16 + fr;
                const size_t off = (size_t)row * DM + col0;
                float rs = 1.f; if (MODE == 2) rs = rstd[row];
                float ss = 0.f;
#pragma unroll
                for (int bj = 0; bj < 2; ++bj)
#pragma unroll
                    for (int n = 0; n < 2; ++n) {
                        const size_t o = off + bj * 128 + n * 16;
                        const f32x4 hv = *(const f32x4*)(hin + o);
                        f32x4 v = acc[ai][bj][m][n];
                        if (MODE == 1) v = (v + bv[bj][n]) * sv[bj][n];
                        if (MODE == 2) { const u32x2 pw = *(const u32x2*)(ple + o);
                            f32x4 pl = {bf2f(pw.x & 0xffffu), bf2f(pw.x >> 16), bf2f(pw.y & 0xffffu), bf2f(pw.y >> 16)};
                            f32x4 z = v * rs + bv[bj][n];
                            v = (f32x4){pl.x * sigmoidf_(z.x), pl.y * sigmoidf_(z.y), pl.z * sigmoidf_(z.z), pl.w * sigmoidf_(z.w)}; }
                        v = v + hv;
                        *(f32x4*)(hout + o) = v;
                        u32x2 w; w.x = cvt_pk_bf16(v.x, v.y); w.y = cvt_pk_bf16(v.z, v.w);
                        *(u32x2*)(hb + o) = w;
                        ss += v.x * v.x + v.y * v.y + v.z * v.z + v.w * v.w;
                    }
                ss += __shfl_xor(ss, 16); ss += __shfl_xor(ss, 32);
                if (fq == 0) ssq[(size_t)row * 16 + u.pn * 4 + wc] = ss;
            }
    }
};

__device__ __forceinline__ float rstd_from_parts(const float* ssq, int row) {
    const f32x4* p = (const f32x4*)(ssq + (size_t)row * 16);
    const f32x4 a = p[0], b = p[1], c = p[2], d = p[3];
    const float s = ((a.x + a.y) + (a.z + a.w)) + ((b.x + b.y) + (b.z + b.w)) + ((c.x + c.y) + (c.z + c.w)) + ((d.x + d.y) + (d.z + d.w));
    return 1.f / sqrtf(s * (1.f / DM) + RMS_EPS);
}

struct EpiRouter {
    static constexpr bool PERM = false;
    int L; LAS unsigned* hist;
    __device__ __forceinline__ void operator()(const AccT& acc, const Unit& u, int wr, int wc, int fr, int fq) const {
        if (wc != 0) return;
        KParams Q = kparams(); unsigned char* ws = Q->ws;
        const float* ssq = (const float*)(ws + WS_SSQ); const float* gb = Q->in[24] + L * 4; const float* eb = Q->in[26] + L * 32;
        int* toke = (int*)(ws + WS_TOKE); float* tokw = (float*)(ws + WS_TOKW); float* rsf = (float*)(ws + WS_RSF);
#pragma unroll
        for (int ai = 0; ai < 2; ++ai)
#pragma unroll
            for (int m = 0; m < 4; ++m) {
                const int row = u.pm * 256 + ai * 128 + wr * 64 + m * 16 + fr;
                const float rs = rstd_from_parts(ssq, row);
                float gl[4];
#pragma unroll
                for (int i = 0; i < 4; ++i) gl[i] = __shfl(acc[ai][1][m][0][i], fr) * rs + gb[i];
                int grp = 0; float gm = gl[0];
#pragma unroll
                for (int i = 1; i < 4; ++i) if (gl[i] > gm) { gm = gl[i]; grp = i; }
                float gs = 0.f;
#pragma unroll
                for (int i = 0; i < 4; ++i) gs += __expf(gl[i] - gm);
                const float gprob = 1.f / gs;
                f32x4 mine;
#pragma unroll
                for (int i = 0; i < 4; ++i) { float x0 = acc[ai][0][m][0][i], x1 = acc[ai][0][m][1][i]; asm volatile("" : "+v"(x0), "+v"(x1)); mine[i] = (grp >> 1) ? x1 : x0; }
                const int src0 = fr + 16 * (2 * (grp & 1));
                float el[8];
#pragma unroll
                for (int i = 0; i < 4; ++i) { el[i] = __shfl(mine[i], src0); el[4 + i] = __shfl(mine[i], src0 + 16); }
#pragma unroll
                for (int j = 0; j < 8; ++j) el[j] = el[j] * rs + eb[grp * 8 + j];
                int i1 = 0; float v1 = el[0];
#pragma unroll
                for (int j = 1; j < 8; ++j) if (el[j] > v1) { v1 = el[j]; i1 = j; }
                int i2 = -1; float v2 = -3.0e38f;
#pragma unroll
                for (int j = 0; j < 8; ++j) if (j != i1 && el[j] > v2) { v2 = el[j]; i2 = j; }
                const float e2 = __expf(v2 - v1), inv = 1.f / (1.f + e2);
                if (fq == 0) {
                    const int e1g = grp * 8 + i1, e2g = grp * 8 + i2;
                    *(int2*)(toke + (size_t)row * 2) = make_int2(e1g, e2g);
                    *(float2*)(tokw + (size_t)row * 2) = make_float2(gprob * inv, gprob * e2 * inv);
                    rsf[row] = rs;
                    atomicAdd((unsigned*)&hist[e1g], 1u); atomicAdd((unsigned*)&hist[e2g], 1u);
                }
            }
    }
};

struct EpiMoe1 {
    static constexpr bool PERM = true;
    int dummy;
    __device__ __forceinline__ void operator()(const AccT& acc, const Unit& u, int wr, int wc, int fr, int fq) const {
        KParams Q = kparams(); unsigned char* ws = Q->ws;
        const int* rowtab = (const int*)(ws + WS_ROWTAB); const float* rsf = (const float*)(ws + WS_RSF); bf16_t* hbuf = (bf16_t*)(ws + WS_HBUF);
        const int hc0 = u.pn * 128 + wc * 16 + 4 * fq;
#pragma unroll
        for (int ai = 0; ai < 2; ++ai)
#pragma unroll
            for (int m = 0; m < 4; ++m) {
                const int pos = u.pm * 256 + ai * 128 + wr * 64 + m * 16 + fr;
                const int a = rowtab[pos];
                if (a < 0) continue;
                const float rs = rsf[a >> 1];
#pragma unroll
                for (int bj = 0; bj < 2; ++bj) {
                    const f32x4 g = acc[ai][bj][m][0] * rs, uu = acc[ai][bj][m][1] * rs;
                    f32x4 o;
#pragma unroll
                    for (int i = 0; i < 4; ++i) o[i] = g[i] * sigmoidf_(g[i]) * uu[i];
                    u32x2 w; w.x = cvt_pk_bf16(o.x, o.y); w.y = cvt_pk_bf16(o.z, o.w);
                    *(u32x2*)(hbuf + (size_t)pos * DFF + hc0 + bj * 64) = w;
                }
            }
    }
};
struct EpiMoe2 {
    static constexpr bool PERM = true;
    int dummy;
    __device__ __forceinline__ void operator()(const AccT& acc, const Unit& u, int wr, int wc, int fr, int fq) const {
        KParams Q = kparams(); unsigned char* ws = Q->ws;
        const int* rowtab = (const int*)(ws + WS_ROWTAB); const float* tokw = (const float*)(ws + WS_TOKW); bf16_t* slot = (bf16_t*)(ws + WS_SLOT);
        const int col0 = u.pn * 256 + wc * 32 + 8 * fq;
#pragma unroll
        for (int ai = 0; ai < 2; ++ai)
#pragma unroll
            for (int m = 0; m < 4; ++m) {
                const int pos = u.pm * 256 + ai * 128 + wr * 64 + m * 16 + fr;
                const int a = rowtab[pos];
                if (a < 0) continue;
                const float w = tokw[a];
#pragma unroll
                for (int bj = 0; bj < 2; ++bj) {
                    const f32x4 v0 = acc[ai][bj][m][0] * w, v1 = acc[ai][bj][m][1] * w;
                    u32x4 o; o.x = cvt_pk_bf16(v0.x, v0.y); o.y = cvt_pk_bf16(v0.z, v0.w); o.z = cvt_pk_bf16(v1.x, v1.y); o.w = cvt_pk_bf16(v1.z, v1.w);
                    *(u32x4*)(slot + (size_t)a * DM + col0 + bj * 128) = o;
                }
            }
    }
};
struct EpiBf16 {
    static constexpr bool PERM = true;
    int dummy;
    __device__ __forceinline__ void operator()(const AccT& acc, const Unit& u, int wr, int wc, int fr, int fq) const {
        KParams Q = kparams(); bf16_t* O = (bf16_t*)(Q->ws + WS_ACT); constexpr int ldc = 1024;
        const int col0 = u.pn * 256 + wc * 32 + 8 * fq;
#pragma unroll
        for (int ai = 0; ai < 2; ++ai)
#pragma unroll
            for (int m = 0; m < 4; ++m) {
                const int row = u.pm * 256 + ai * 128 + wr * 64 + m * 16 + fr;
#pragma unroll
                for (int bj = 0; bj < 2; ++bj) {
                    const f32x4 v0 = acc[ai][bj][m][0], v1 = acc[ai][bj][m][1];
                    u32x4 o; o.x = cvt_pk_bf16(v0.x, v0.y); o.y = cvt_pk_bf16(v0.z, v0.w); o.z = cvt_pk_bf16(v1.x, v1.y); o.w = cvt_pk_bf16(v1.z, v1.w);
                    *(u32x4*)(O + (size_t)row * ldc + col0 + bj * 128) = o;
                }
            }
    }
};
struct EpiQkv {
    static constexpr bool PERM = true;
    int tile0; int J;
    __device__ __forceinline__ void operator()(const AccT& acc, const Unit& u, int wr, int wc, int fr, int fq) const {
        KParams Q = kparams(); unsigned char* ws = Q->ws;
        const float* ssq = (const float*)(ws + WS_SSQ); const float* rope = (const float*)(ws + WS_ROPE); const float* bgate = Q->in[21] + J * 48;
        bf16_t* kvc = (bf16_t*)(ws + WS_KVC); bf16_t* ks = (bf16_t*)(ws + WS_KS); bf16_t* vs = (bf16_t*)(ws + WS_VS); bf16_t* kw = (bf16_t*)(ws + WS_KW); bf16_t* vw = (bf16_t*)(ws + WS_VW);
        bf16_t* q = (bf16_t*)(ws + WS_Q); float* gates = (float*)(ws + WS_GATES);
        const int ty = u.pn + tile0;
        const int cu0 = wc * 32 + 8 * fq;
        const bool roped = (ty == 2 || ty == 4 || ty >= 6) && ty != 10;
        const bool dorope = roped && ((wc & 1) == 0);
        bf16_t* dst; int ldc; int cbase;
        if (ty < 2)       { dst = kvc; ldc = 512;  cbase = ty * 256; }
        else if (ty == 2) { dst = ks;  ldc = 256;  cbase = 0; }
        else if (ty == 3) { dst = vs;  ldc = 256;  cbase = 0; }
        else if (ty == 4) { dst = kw;  ldc = 256;  cbase = 0; }
        else if (ty == 5) { dst = vw;  ldc = 256;  cbase = 0; }
        else              { dst = q;   ldc = 1024; cbase = (ty - 6) * 256; }
#pragma unroll
        for (int ai = 0; ai < 2; ++ai)
#pragma unroll
            for (int m = 0; m < 4; ++m) {
                const int row = u.pm * 256 + ai * 128 + wr * 64 + m * 16 + fr;
                const float rs = rstd_from_parts(ssq, row);
                if (ty == 10) {
                    if (wc < 2) {
#pragma unroll
                        for (int n = 0; n < 2; ++n) {
                            const int c = cu0 + 4 * n;
                            if (c < 48) { f32x4 z = acc[ai][0][m][n] * rs + *(const f32x4*)(bgate + c);
                                f32x4 o = {sigmoidf_(z.x), sigmoidf_(z.y), sigmoidf_(z.z), sigmoidf_(z.w)};
                                *(f32x4*)(gates + (size_t)row * 48 + c) = o; }
                        }
                    }
                    continue;
                }
                f32x4 cs[2], sn[2];
                if (dorope) { const float* rp = rope + (size_t)(row & (SEQ - 1)) * 16;
                    cs[0] = *(const f32x4*)(rp); cs[1] = *(const f32x4*)(rp + 4); sn[0] = *(const f32x4*)(rp + 8); sn[1] = *(const f32x4*)(rp + 12); }
#pragma unroll
                for (int bj = 0; bj < 2; ++bj) {
                    f32x4 v[2];
#pragma unroll
                    for (int n = 0; n < 2; ++n) {
                        v[n] = acc[ai][bj][m][n] * rs;
                        if (dorope) {
                            f32x4 ot;
#pragma unroll
                            for (int i = 0; i < 4; ++i) ot[i] = __shfl_xor(v[n][i], 16);
                            if (fq == 0) v[n] = v[n] * cs[n] - ot * sn[n];
                            else if (fq == 1) v[n] = v[n] * cs[n] + ot * sn[n];
                        }
                        if (ty >= 6) v[n] = v[n] * QSCALE;
                    }
                    u32x4 o; o.x = cvt_pk_bf16(v[0].x, v[0].y); o.y = cvt_pk_bf16(v[0].z, v[0].w); o.z = cvt_pk_bf16(v[1].x, v[1].y); o.w = cvt_pk_bf16(v[1].z, v[1].w);
                    if (ty == 2 || ty == 4) *(u32x4*)(dst + (((size_t)((row >> 13) * 4 + 2 * bj + (wc >> 1))) * SEQ + (row & (SEQ - 1))) * 64 + (wc & 1) * 32 + 8 * fq) = o;
                    else *(u32x4*)(dst + (size_t)row * ldc + cbase + cu0 + bj * 128) = o;
                }
            }
    }
};
__device__ __forceinline__ float gelu_tanh(float x) {
    const float u = 0.7978845608028654f * (x + 0.044715f * x * x * x);
    const float t = 1.f - 2.f / (1.f + __expf(2.f * u));
    return 0.5f * x * (1.f + t);
}
struct EpiCmp1 {
    static constexpr bool PERM = true;
    int dummy;
    __device__ __forceinline__ void operator()(const AccT& acc, const Unit& u, int wr, int wc, int fr, int fq) const {
        KParams Q = kparams(); unsigned char* ws = Q->ws; const float* cb1 = (const float*)(ws + WS_CB1); bf16_t* chid = (bf16_t*)(ws + WS_CHID);
        const int col0 = wc * 32 + 8 * fq;
        bf16_t* O = chid + (size_t)u.pn * 8192 * 256;
#pragma unroll
        for (int ai = 0; ai < 2; ++ai)
#pragma unroll
            for (int m = 0; m < 4; ++m) {
                const int row = u.pm * 256 + ai * 128 + wr * 64 + m * 16 + fr;
#pragma unroll
                for (int bj = 0; bj < 2; ++bj) {
                    const int c = col0 + bj * 128;
                    const f32x4 b0 = *(const f32x4*)(cb1 + u.pn * 256 + c), b1 = *(const f32x4*)(cb1 + u.pn * 256 + c + 4);
                    const f32x4 v0 = acc[ai][bj][m][0] + b0, v1 = acc[ai][bj][m][1] + b1;
                    u32x4 o; o.x = cvt_pk_bf16(gelu_tanh(v0.x), gelu_tanh(v0.y)); o.y = cvt_pk_bf16(gelu_tanh(v0.z), gelu_tanh(v0.w));
                    o.z = cvt_pk_bf16(gelu_tanh(v1.x), gelu_tanh(v1.y)); o.w = cvt_pk_bf16(gelu_tanh(v1.z), gelu_tanh(v1.w));
                    *(u32x4*)(O + (size_t)row * 256 + c) = o;
                }
            }
    }
};
struct EpiCmp2 {
    static constexpr bool PERM = true;
    int dummy;
    __device__ __forceinline__ void operator()(const AccT& acc, const Unit& u, int wr, int wc, int fr, int fq) const {
        if (wc >= 2) return;
        KParams Q = kparams(); unsigned char* ws = Q->ws; const float* b2k = Q->in[14]; const float* b2v = Q->in[19]; const float* rope = (const float*)(ws + WS_ROPE);
        bf16_t* kc = (bf16_t*)(ws + WS_KC); bf16_t* vct = (bf16_t*)(ws + WS_VCT);
        const int c0 = wc * 32 + 8 * fq;
        const float* b2 = u.pn ? b2v : b2k;
        const f32x4 bb0 = *(const f32x4*)(b2 + c0), bb1 = *(const f32x4*)(b2 + c0 + 4);
#pragma unroll
        for (int ai = 0; ai < 2; ++ai)
#pragma unroll
            for (int m = 0; m < 4; ++m) {
                const int row = u.pm * 256 + ai * 128 + wr * 64 + m * 16 + fr;
                const int bg = row >> 9, n = row & 511;
                f32x4 v[2]; v[0] = acc[ai][0][m][0] + bb0; v[1] = acc[ai][0][m][1] + bb1;
                if (u.pn == 0) {
                    if (wc == 0) {
                        const int pos = (16 * n + 31) & (SEQ - 1);
                        const float* rp = rope + (size_t)pos * 16;
#pragma unroll
                        for (int nn = 0; nn < 2; ++nn) {
                            const f32x4 cs = *(const f32x4*)(rp + 4 * nn), sn = *(const f32x4*)(rp + 8 + 4 * nn);
                            f32x4 ot;
#pragma unroll
                            for (int i = 0; i < 4; ++i) ot[i] = __shfl_xor(v[nn][i], 16);
                            if (fq == 0) v[nn] = v[nn] * cs - ot * sn; else if (fq == 1) v[nn] = v[nn] * cs + ot * sn;
                        }
                    }
                    if (n == 511) { v[0] = (f32x4){0.f, 0.f, 0.f, 0.f}; v[1] = v[0]; }
                    u32x4 o; o.x = cvt_pk_bf16(v[0].x, v[0].y); o.y = cvt_pk_bf16(v[0].z, v[0].w); o.z = cvt_pk_bf16(v[1].x, v[1].y); o.w = cvt_pk_bf16(v[1].z, v[1].w);
                    *(u32x4*)(kc + ((size_t)bg * 512 + n) * 64 + c0) = o;
                } else {
                    const int np = swap23(n & 63), ntile = n >> 6;
#pragma unroll
                    for (int nn = 0; nn < 2; ++nn)
#pragma unroll
                        for (int i = 0; i < 4; ++i) vct[(((size_t)bg * 8 + ntile) * 64 + c0 + 4 * nn + i) * 64 + np] = (n == 511) ? (bf16_t)0 : f2bf(v[nn][i]);
                }
            }
    }
};
template <class F>
__device__ __forceinline__ void cvt_family(LAS float* scr, bf16_t* dst, int nbatch, int Nd, int K, const F& f) {
    const int tilesN = Nd / 64, tilesK = K / 64, per = tilesN * tilesK, items = nbatch * per;
    int tid_ = threadIdx.x; asm volatile("" : "+v"(tid_));
    const int tid = tid_;
    for (int it = blockIdx.x; it < items; it += gridDim.x) {
        const int b = it / per, r = it % per, n0 = (r / tilesK) * 64, k0 = (r % tilesK) * 64;
#pragma unroll
        for (int i = 0; i < 8; ++i) { const int kk = (tid >> 6) + 8 * i, nn = tid & 63; scr[kk * 65 + nn] = f(b, k0 + kk, n0 + nn); }
        __syncthreads();
        { const int nn = tid >> 3, kc = tid & 7; const LAS float* s = scr + (8 * kc) * 65 + nn;
          u32x4 o; o.x = cvt_pk_bf16(s[0], s[65]); o.y = cvt_pk_bf16(s[2 * 65], s[3 * 65]); o.z = cvt_pk_bf16(s[4 * 65], s[5 * 65]); o.w = cvt_pk_bf16(s[6 * 65], s[7 * 65]);
          *(u32x4*)(dst + ((size_t)b * Nd + n0 + nn) * K + k0 + 8 * kc) = o; }
        __syncthreads();
    }
}

__device__ __forceinline__ void prologue_phase(LAS unsigned char* lds, const Params& p) {
    LAS float* scr = (LAS float*)lds;
    unsigned char* ws = p.ws;
    const int tid = threadIdx.x;
    const size_t gtid = (size_t)blockIdx.x * 512 + tid, gsz = (size_t)gridDim.x * 512;
    { float* rope = (float*)(ws + WS_ROPE);
      for (size_t i = gtid; i < (size_t)SEQ * 8; i += gsz) { const int pos = (int)(i >> 3), f = (int)(i & 7);
          const float inv = (float)pow(500000.0, -(double)f / 8.0); const float ang = (float)pos * inv;
          rope[pos * 16 + f] = (float)cos((double)ang); rope[pos * 16 + 8 + f] = (float)sin((double)ang); } }
    { unsigned* tab = (unsigned*)(ws + WS_CMPTAB);
      for (size_t i = gtid; i < 8192; i += gsz) { const int bg = (int)(i >> 9), n = (int)(i & 511), b = bg >> 2, g = bg & 3, nc = n > 510 ? 510 : n;
          tab[i] = (unsigned)((((size_t)b * SEQ + 16 * nc) * 512 + g * 64) * 2); } }
    if (blockIdx.x == 0) { float* cb1 = (float*)(ws + WS_CB1); const int which = tid >> 8, hh = tid & 255;
        const float* pos = which ? p.in[15] : p.in[10]; const float* w1 = which ? p.in[16] : p.in[11]; const float* b1 = which ? p.in[17] : p.in[12];
        float s = b1[hh]; for (int k = 0; k < 2048; ++k) s += pos[k] * w1[(size_t)k * 256 + hh];
        cb1[which * 256 + hh] = s; }
    { const f32x4* src = (const f32x4*)p.in[1]; u32x2* dst = (u32x2*)(ws + WS_PB);
      for (size_t i = gtid; i < (size_t)4 * T_TOK * 256 / 4; i += gsz) { const f32x4 v = src[i]; u32x2 o; o.x = cvt_pk_bf16(v.x, v.y); o.y = cvt_pk_bf16(v.z, v.w); dst[i] = o; } }
    { const float* pw = p.in[5];
      cvt_family(scr, (bf16_t*)(ws + WS_WPOOL), 2, 1024, 256, [=](int b, int k, int nd) { return pw[(((size_t)b * 4 + (nd >> 8)) * 256 + k) * 256 + (nd & 255)]; }); }
    { const float* wkv = p.in[9]; const float* kvn = p.in[8]; const float* wqg = p.in[20]; const float* nm = p.in[2] + 2 * 1024;
      cvt_family(scr, (bf16_t*)(ws + WS_WKVQ), 1, 2816, 1024, [=](int b, int k, int nd) {
          if (nd < 1536) return wkv[(size_t)k * 1536 + nd] * kvn[k];
          if (nd < 1536 + 1072) return wqg[(size_t)k * 1072 + (nd - 1536)] * nm[k];
          return 0.f; }); }
    { const float* wqg = p.in[20] + (size_t)1024 * 1072; const float* nm = p.in[2] + 3 * 1024;
      cvt_family(scr, (bf16_t*)(ws + WS_WQG1), 1, 1280, 1024, [=](int b, int k, int nd) { return nd < 1072 ? wqg[(size_t)k * 1072 + nd] * nm[k] : 0.f; }); }
    { const float* wk = p.in[11]; const float* wv = p.in[16];
      cvt_family(scr, (bf16_t*)(ws + WS_WC1), 2, 256, 2048, [=](int b, int k, int nd) { return (b ? wv : wk)[(size_t)k * 256 + nd]; }); }
    { const float* wk = p.in[13]; const float* wv = p.in[18];
      cvt_family(scr, (bf16_t*)(ws + WS_WC2), 2, 256, 256, [=](int b, int k, int nd) { return nd < 64 ? (b ? wv : wk)[(size_t)k * 64 + nd] : 0.f; }); }
    { const float* wo = p.in[22];
      cvt_family(scr, (bf16_t*)(ws + WS_WO), 2, 1024, 1024, [=](int b, int k, int nd) { return wo[((size_t)b * 1024 + k) * 1024 + nd]; }); }
    { const float* rg = p.in[23]; const float* re = p.in[25]; const float* nf = p.in[3];
      cvt_family(scr, (bf16_t*)(ws + WS_WR), 4, 256, 1024, [=](int b, int k, int nd) {
          if (nd < 32) return re[((size_t)b * 1024 + k) * 32 + nd] * nf[b * 1024 + k];
          if (nd >= 128 && nd < 132) return rg[((size_t)b * 1024 + k) * 4 + (nd - 128)] * nf[b * 1024 + k];
          return 0.f; }); }
    { const float* pp = p.in[30];
      cvt_family(scr, (bf16_t*)(ws + WS_WPP), 4, 1024, 256, [=](int b, int k, int nd) { return pp[((size_t)b * 256 + k) * 1024 + nd]; }); }
    { const float* pg = p.in[31]; const float* np = p.in[4];
      cvt_family(scr, (bf16_t*)(ws + WS_WPG), 4, 1024, 1024, [=](int b, int k, int nd) { return pg[((size_t)b * 1024 + k) * 1024 + nd] * np[b * 1024 + k]; }); }
    { const float* w1 = p.in[27]; const float* w3 = p.in[28]; const float* nf = p.in[3];
      cvt_family(scr, (bf16_t*)(ws + WS_W13), 128, 1024, 1024, [=](int b, int k, int nd) {
          const int c8 = nd >> 3, i = nd & 7; const long dlt = (const char*)w3 - (const char*)w1; const float* w = (const float*)((const char*)w1 + ((i < 4) ? 0l : dlt));
          return w[((size_t)b * 1024 + k) * 512 + 4 * c8 + (i & 3)] * nf[(b >> 5) * 1024 + k]; }); }
    { const float* w2 = p.in[29];
      cvt_family(scr, (bf16_t*)(ws + WS_W2), 128, 1024, 512, [=](int b, int k, int nd) { return w2[((size_t)b * 512 + k) * 1024 + nd]; }); }
}

template <int W>
__device__ __forceinline__ void stencil_rows(const float* h, const LAS float* rs, const float gx, const float gy, bf16_t* pooled, int r0, int s0, int c0) {
    f32x2 buf[16];
#pragma unroll
    for (int j = 0; j < 16; ++j) buf[j] = (f32x2){0.f, 0.f};
    for (int ch = 0; ch < 9; ++ch) {
        f32x2 ld[16];
#pragma unroll
        for (int j = 0; j < 16; ++j) { const int rr = ch * 16 + j; const bool ok = (ch > 0) || (s0 > 0);
            ld[j] = ok ? *(const f32x2*)(h + (size_t)(r0 - 16 + rr) * DM + c0) : (f32x2){0.f, 0.f}; }
#pragma unroll
        for (int j = 0; j < 16; ++j) { const int rr = ch * 16 + j; const float r = rs[rr];
            f32x2 xn; xn.x = ld[j].x * r * gx; xn.y = ld[j].y * r * gy;
            buf[j] = xn;
            if (ch > 0) {
                f32x2 s = xn;
#pragma unroll
                for (int i = 1; i < W; ++i) s = s + buf[(j - i) & 15];
                const int sp = s0 + rr - 16;
                const int cnt = (sp + 1 < W) ? (sp + 1) : W;
                const float ic = 1.f / (float)cnt;
                const float ox = s.x * ic - xn.x, oy = s.y * ic - xn.y;
                *(unsigned*)(pooled + (size_t)(r0 - 16 + rr) * DM + c0) = cvt_pk_bf16(ox, oy);
            }
        }
    }
}
__device__ __forceinline__ void stencil_phase(LAS unsigned char* lds, const float* h, const float* gain, bf16_t* pooled) {
    LAS float* rs = (LAS float*)lds;
    int tid_ = threadIdx.x; asm volatile("" : "+v"(tid_));
    const int tid = tid_, w = tid >> 6, lane = tid & 63;
    for (int it = blockIdx.x; it < T_TOK / 128; it += gridDim.x) {
        const int r0 = it * 128, s0 = r0 & (SEQ - 1);
        for (int rr = w; rr < 144; rr += 8) {
            const int row = r0 - 16 + rr; float v = 0.f;
            if (rr >= 16 || s0 > 0) { const f32x4* xr = (const f32x4*)(h + (size_t)row * DM) + lane; float s = 0.f;
#pragma unroll
                for (int j = 0; j < 4; ++j) { const f32x4 x = xr[64 * j]; s += x.x * x.x + x.y * x.y + x.z * x.z + x.w * x.w; }
                s = wave_sum(s); v = 1.f / sqrtf(s * (1.f / DM) + RMS_EPS); }
            if (lane == 0) rs[rr] = v;
        }
        __syncthreads();
        const int c0 = 2 * tid, gi = tid >> 7; const float gx = gain[c0], gy = gain[c0 + 1];
        if (gi == 0) stencil_rows<2>(h, rs, gx, gy, pooled, r0, s0, c0);
        else if (gi == 1) stencil_rows<4>(h, rs, gx, gy, pooled, r0, s0, c0);
        else if (gi == 2) stencil_rows<8>(h, rs, gx, gy, pooled, r0, s0, c0);
        else stencil_rows<16>(h, rs, gx, gy, pooled, r0, s0, c0);
        __syncthreads();
    }
}

__device__ __forceinline__ int moe_tables(LAS unsigned char* lds, const unsigned* counts) {
    LAS unsigned* pstart = (LAS unsigned*)(lds + LDS_MISC);
    LAS unsigned char* tile_e = lds + LDS_MISC + 256;
    __syncthreads();
    if (threadIdx.x == 0) { unsigned acc = 0;
        for (int e = 0; e < NEXP; ++e) { pstart[e] = acc; const unsigned nt = (counts[e] + 255u) >> 8; for (unsigned t = 0; t < nt; ++t) tile_e[(acc >> 8) + t] = (unsigned char)e; acc += nt << 8; }
        pstart[NEXP] = acc; }
    __syncthreads();
    return (int)(pstart[NEXP] >> 8);
}
__device__ __forceinline__ void scatter_phase(LAS unsigned char* lds, const unsigned* counts, unsigned* cursor, const int* toke, int* rowtab, unsigned* rowoff) {
    moe_tables(lds, counts);
    LAS unsigned* pstart = (LAS unsigned*)(lds + LDS_MISC);
    LAS unsigned* cl = (LAS unsigned*)(lds + LDS_MISC + 1024);
    const int tid = threadIdx.x;
    for (int it = blockIdx.x; it < 2 * T_TOK / 256; it += gridDim.x) {
        if (tid < 64) cl[tid] = 0;
        __syncthreads();
        int a = -1, e = 0; unsigned rank = 0;
        if (tid < 256) { a = it * 256 + tid; e = toke[a]; rank = __hip_atomic_fetch_add(&cl[e], 1u, __ATOMIC_RELAXED, __HIP_MEMORY_SCOPE_WORKGROUP); }
        __syncthreads();
        if (tid < 32) { const unsigned n = cl[tid]; cl[32 + tid] = n ? __hip_atomic_fetch_add(cursor + tid, n, __ATOMIC_RELAXED, __HIP_MEMORY_SCOPE_AGENT) : 0u; }
        __syncthreads();
        if (tid < 256) { const unsigned pos = pstart[e] + cl[32 + e] + rank; rowtab[pos] = a; rowoff[pos] = (unsigned)(a >> 1) * 2048u; }
        __syncthreads();
    }
    if (blockIdx.x < NEXP) { const int e = blockIdx.x; const unsigned lo = pstart[e] + counts[e], hi = pstart[e + 1];
        for (unsigned pos = lo + tid; pos < hi; pos += 512) { rowtab[pos] = -1; rowoff[pos] = 0u; } }
}

__device__ __forceinline__ void e1_phase(float* h, const bf16_t* slot, bf16_t* hb, float* rsp) {
    int tid_ = threadIdx.x; asm volatile("" : "+v"(tid_));
    const int w = tid_ >> 6, lane = tid_ & 63;
    for (int row = blockIdx.x * 8 + w; row < T_TOK; row += gridDim.x * 8) {
        f32x4* hr = (f32x4*)(h + (size_t)row * DM) + lane;
        const u32x2* s0 = (const u32x2*)(slot + (size_t)(2 * row) * DM) + lane; const u32x2* s1 = (const u32x2*)(slot + (size_t)(2 * row + 1) * DM) + lane;
        u32x2* ob = (u32x2*)(hb + (size_t)row * DM) + lane;
        float ss = 0.f;
#pragma unroll
        for (int j = 0; j < 4; ++j) { f32x4 v = hr[64 * j]; const u32x2 a = s0[64 * j], b = s1[64 * j];
            v.x += bf2f(a.x & 0xffffu) + bf2f(b.x & 0xffffu); v.y += bf2f(a.x >> 16) + bf2f(b.x >> 16);
            v.z += bf2f(a.y & 0xffffu) + bf2f(b.y & 0xffffu); v.w += bf2f(a.y >> 16) + bf2f(b.y >> 16);
            hr[64 * j] = v; u32x2 o; o.x = cvt_pk_bf16(v.x, v.y); o.y = cvt_pk_bf16(v.z, v.w); ob[64 * j] = o;
            ss += v.x * v.x + v.y * v.y + v.z * v.z + v.w * v.w; }
        ss = wave_sum(ss);
        if (lane == 0) rsp[row] = 1.f / sqrtf(ss * (1.f / DM) + RMS_EPS);
    }
}
__device__ __forceinline__ void final_phase(float* h, const float* gain) {
    int tid_ = threadIdx.x; asm volatile("" : "+v"(tid_));
    const int w = tid_ >> 6, lane = tid_ & 63;
    for (int row = blockIdx.x * 8 + w; row < T_TOK; row += gridDim.x * 8) {
        f32x4* hr = (f32x4*)(h + (size_t)row * DM) + lane; const f32x4* gr = (const f32x4*)gain + lane;
        f32x4 v[4]; float ss = 0.f;
#pragma unroll
        for (int j = 0; j < 4; ++j) { v[j] = hr[64 * j]; ss += v[j].x * v[j].x + v[j].y * v[j].y + v[j].z * v[j].z + v[j].w * v[j].w; }
        ss = wave_sum(ss); const float r = 1.f / sqrtf(ss * (1.f / DM) + RMS_EPS);
#pragma unroll
        for (int j = 0; j < 4; ++j) hr[64 * j] = v[j] * r * gr[64 * j];
    }
}
__device__ __forceinline__ void vtrans_phase(LAS unsigned char* lds, const bf16_t* vs, const bf16_t* vw, bf16_t* vst, bf16_t* vwt) {
    LAS bf16_t* tl = (LAS bf16_t*)lds;
    int tid_ = threadIdx.x; asm volatile("" : "+v"(tid_));
    const int tid = tid_;
    for (int it = blockIdx.x; it < 2 * 16 * 128; it += gridDim.x) {
        const int which = it >> 11, r = it & 2047, bg = r >> 7, kt = r & 127, b = bg >> 2, g = bg & 3;
        const bf16_t* src = which ? vw : vs; bf16_t* dst = which ? vwt : vst;
        { const int key = tid >> 3, ch = tid & 7;
          const u32x4 v = *(const u32x4*)(src + ((size_t)b * SEQ + kt * 64 + key) * 256 + g * 64 + ch * 8);
          const int kp = swap23(key);
          const unsigned wv[4] = {v.x, v.y, v.z, v.w};
#pragma unroll
          for (int i = 0; i < 4; ++i) { tl[(ch * 8 + 2 * i) * 72 + kp] = (bf16_t)(wv[i] & 0xffffu); tl[(ch * 8 + 2 * i + 1) * 72 + kp] = (bf16_t)(wv[i] >> 16); } }
        __syncthreads();
        { const int d = tid >> 3, ch = tid & 7;
          const u32x4 v = *(const LAS u32x4*)(tl + d * 72 + ch * 8);
          *(u32x4*)(dst + (((size_t)bg * 128 + kt) * 64 + d) * 64 + ch * 8) = v; }
        __syncthreads();
    }
}

struct AttnArgs { const bf16_t* q; const float* gates; const bf16_t* kc; const bf16_t* vct; const bf16_t* ks; const bf16_t* vst; const bf16_t* kw; const bf16_t* vwt; bf16_t* out; };
#define ATT_MFMA(a, b, c) __builtin_amdgcn_mfma_f32_32x32x16_bf16(a, b, c, 0, 0, 0)
constexpr int ATT_SLOT = 16384, ATT_RING = 6, ATT_IMP = ATT_RING * ATT_SLOT, ATT_SELM = ATT_IMP + 32768;
constexpr float ATT_THR = 8.f;
typedef float f32x8 __attribute__((ext_vector_type(8)));
__device__ __forceinline__ float hsum16(const f32x16 a) { const f32x8 b = a.lo + a.hi; const f32x4 c = b.lo + b.hi; const f32x2 d = c.lo + c.hi; return d.x + d.y; }
__device__ __forceinline__ float hmax16(const f32x16 a) {
    float m0 = fmaxf(fmaxf(a[0], a[1]), a[2]), m1 = fmaxf(fmaxf(a[3], a[4]), a[5]), m2 = fmaxf(fmaxf(a[6], a[7]), a[8]), m3 = fmaxf(fmaxf(a[9], a[10]), a[11]), m4 = fmaxf(fmaxf(a[12], a[13]), a[14]);
    return fmaxf(fmaxf(fmaxf(m0, m1), fmaxf(m2, m3)), fmaxf(m4, a[15]));
}
template <bool MASKED, bool ONLINE, bool DO_PV, bool DO_IMP>
__device__ __forceinline__ void attn_step(const LAS unsigned char* Kb, const LAS unsigned char* Vb, const bf16x8 (&Qf)[4], const int (&ro)[4],
                                          const int lo4, const int hi4, const bool rowsel, f32x16& O0, f32x16& O1, float& mref, float& lsum,
                                          LAS float* impw, const int jbase, const int lane) {
    f32x16 S0, S1;
#pragma unroll
    for (int r = 0; r < 16; ++r) { S0[r] = 0.f; S1[r] = 0.f; }
#pragma unroll
    for (int ks = 0; ks < 4; ++ks) { const bf16x8 A0 = *(const LAS bf16x8*)(Kb + ro[ks]); const bf16x8 A1 = *(const LAS bf16x8*)(Kb + 4096 + ro[ks]);
        S0 = ATT_MFMA(A0, Qf[ks], S0); S1 = ATT_MFMA(A1, Qf[ks], S1); }
    __builtin_amdgcn_sched_barrier(0);
    if (MASKED) {
        int lo_o = lo4, hi_o = hi4; asm volatile("" : "+v"(lo_o), "+v"(hi_o));
        const int lo_c = lo_o < 0 ? 0 : lo_o, hi_c = hi_o > 63 ? 63 : hi_o;
        unsigned long long vm = (hi_c >= 63) ? ~0ull : ((1ull << (hi_c + 1)) - 1ull);
        vm &= ~((1ull << lo_c) - 1ull);
        if (hi_c < lo_c) vm = 0ull;
        const unsigned vlo = (unsigned)vm, vhi = (unsigned)(vm >> 32);
        const unsigned negbits = __float_as_uint(-1e30f);
#pragma unroll
        for (int r = 0; r < 16; ++r) { const int cr = (r & 3) + 8 * (r >> 2);
            const unsigned m0 = (unsigned)__builtin_amdgcn_sbfe((int)vlo, cr, 1), m1 = (unsigned)__builtin_amdgcn_sbfe((int)vhi, cr, 1);
            S0[r] = __uint_as_float((__float_as_uint(S0[r]) & m0) | (negbits & ~m0));
            S1[r] = __uint_as_float((__float_as_uint(S1[r]) & m1) | (negbits & ~m1)); }
    }
    float mr;
    if (ONLINE) {
        float mx = fmaxf(hmax16(S0), hmax16(S1));
        mx = fmaxf(mx, __shfl_xor(mx, 32));
        if (!MASKED && !rowsel) mx = -1e30f;
        const bool grow = mx > mref + ATT_THR;
        if (__ballot(grow) != 0ull) {
            const float mnew = grow ? mx : mref;
            const float alpha = __builtin_amdgcn_exp2f(mref - mnew);
            lsum *= alpha; mref = mnew;
            if (DO_PV) { O0 = O0 * alpha; O1 = O1 * alpha; }
        }
        mr = ((MASKED || rowsel) && mref > -1e29f) ? mref : 1e30f;
    } else {
        mr = mref;
    }
    S0 = S0 - mr; S1 = S1 - mr;
#pragma unroll
    for (int r = 0; r < 16; ++r) { S0[r] = __builtin_amdgcn_exp2f(S0[r]); S1[r] = __builtin_amdgcn_exp2f(S1[r]); }
    if (ONLINE) { float rs = hsum16(S0 + S1); rs += __shfl_xor(rs, 32); lsum += rs; }
    if (DO_IMP) {
#pragma unroll
        for (int kh = 0; kh < 2; ++kh)
#pragma unroll
            for (int q4 = 0; q4 < 4; ++q4) {
                float G, E;
                if (kh == 0) { G = (S0[4 * q4] + S0[4 * q4 + 1]) + (S0[4 * q4 + 2] + S0[4 * q4 + 3]); E = S0[4 * q4 + 3]; }
                else         { G = (S1[4 * q4] + S1[4 * q4 + 1]) + (S1[4 * q4 + 2] + S1[4 * q4 + 3]); E = S1[4 * q4 + 3]; }
                G += __shfl_xor(G, 1); G += __shfl_xor(G, 2); E += __shfl_xor(E, 1); E += __shfl_xor(E, 2);
                const int jj = jbase + 8 * kh + 2 * q4 + (lane >> 5);
                if ((lane & 3) == 0) { impw[jj] += G; if (jj + 1 < 128) impw[jj + 1] += E; }
            }
    }
    __builtin_amdgcn_sched_barrier(0);
    if (DO_PV) {
        bf16x8 Pf[4];
        { u32x4 pk; pk.x = cvt_pk_bf16(S0[0], S0[1]); pk.y = cvt_pk_bf16(S0[2], S0[3]); pk.z = cvt_pk_bf16(S0[4], S0[5]); pk.w = cvt_pk_bf16(S0[6], S0[7]); Pf[0] = __builtin_bit_cast(bf16x8, pk); }
        { u32x4 pk; pk.x = cvt_pk_bf16(S0[8], S0[9]); pk.y = cvt_pk_bf16(S0[10], S0[11]); pk.z = cvt_pk_bf16(S0[12], S0[13]); pk.w = cvt_pk_bf16(S0[14], S0[15]); Pf[1] = __builtin_bit_cast(bf16x8, pk); }
        { u32x4 pk; pk.x = cvt_pk_bf16(S1[0], S1[1]); pk.y = cvt_pk_bf16(S1[2], S1[3]); pk.z = cvt_pk_bf16(S1[4], S1[5]); pk.w = cvt_pk_bf16(S1[6], S1[7]); Pf[2] = __builtin_bit_cast(bf16x8, pk); }
        { u32x4 pk; pk.x = cvt_pk_bf16(S1[8], S1[9]); pk.y = cvt_pk_bf16(S1[10], S1[11]); pk.z = cvt_pk_bf16(S1[12], S1[13]); pk.w = cvt_pk_bf16(S1[14], S1[15]); Pf[3] = __builtin_bit_cast(bf16x8, pk); }
#pragma unroll
        for (int k4 = 0; k4 < 4; ++k4) { const bf16x8 A0 = *(const LAS bf16x8*)(Vb + ro[k4]); const bf16x8 A1 = *(const LAS bf16x8*)(Vb + 4096 + ro[k4]);
            O0 = ATT_MFMA(A0, Pf[k4], O0); O1 = ATT_MFMA(A1, Pf[k4], O1); }
    }
}

template <bool FIRST>
__device__ __forceinline__ void attn_out_acc(bf16_t* orow, const f32x16& O0, const f32x16& O1, const float sc, const int h) {
#pragma unroll
    for (int rq = 0; rq < 4; ++rq) {
        u32x2* p0 = (u32x2*)(orow + 8 * rq + 4 * h); u32x2* p1 = (u32x2*)(orow + 32 + 8 * rq + 4 * h);
        float a0 = 0.f, a1 = 0.f, a2 = 0.f, a3 = 0.f, b0 = 0.f, b1 = 0.f, b2 = 0.f, b3 = 0.f;
        if (!FIRST) { const u32x2 x = *p0, y = *p1; a0 = bf2f(x.x & 0xffffu); a1 = bf2f(x.x >> 16); a2 = bf2f(x.y & 0xffffu); a3 = bf2f(x.y >> 16);
            b0 = bf2f(y.x & 0xffffu); b1 = bf2f(y.x >> 16); b2 = bf2f(y.y & 0xffffu); b3 = bf2f(y.y >> 16); }
        u32x2 o; o.x = cvt_pk_bf16(a0 + sc * O0[4 * rq], a1 + sc * O0[4 * rq + 1]); o.y = cvt_pk_bf16(a2 + sc * O0[4 * rq + 2], a3 + sc * O0[4 * rq + 3]); *p0 = o;
        u32x2 o2; o2.x = cvt_pk_bf16(b0 + sc * O1[4 * rq], b1 + sc * O1[4 * rq + 1]); o2.y = cvt_pk_bf16(b2 + sc * O1[4 * rq + 2], b3 + sc * O1[4 * rq + 3]); *p1 = o2;
    }
}
__device__ __forceinline__ void attn_phase(LAS unsigned char* lds) {
    int tid_ = threadIdx.x; asm volatile("" : "+v"(tid_));
    const int tid = tid_, w = __builtin_amdgcn_readfirstlane(tid >> 6), lane = tid & 63, n = lane & 31, h = lane >> 5;
    LAS float* imp = (LAS float*)(lds + ATT_IMP); LAS unsigned* selm = (LAS unsigned*)(lds + ATT_SELM);
    int ro[4];
#pragma unroll
    for (int ks = 0; ks < 4; ++ks) ro[ks] = n * 128 + (((2 * ks + h) ^ ((n >> 1) & 7)) << 4);
    const int drow = 8 * w + (lane >> 3);
    const unsigned dsrc = (unsigned)(drow * 128 + (((lane & 7) ^ ((drow >> 1) & 7)) << 4));
    for (int it = blockIdx.x; it < 2048; it += gridDim.x) {
        const int cc = it & 255, half = (it >> 8) >> 2, rr = 3 - ((it >> 8) & 3), idx = cc >> 3, bg = (cc & 7) + 8 * half, b = bg >> 2, g = bg & 3;
        const int qb = (rr & 1) ? (32 * rr + 31 - idx) : (32 * rr + idx);
        const int tl = w * 8 + (n >> 2), t = qb * 64 + tl, hd = g * 4 + (n & 3);
        const size_t trow = (size_t)b * SEQ + t;
        bf16x8 Qf[4]; float g0, g1, g2; const char* kcb; const char* ksb;
        { unsigned char* ws = kparams()->ws; const bf16_t* qp = (const bf16_t*)(ws + WS_Q); const float* gp = (const float*)(ws + WS_GATES);
#pragma unroll
          for (int s = 0; s < 4; ++s) Qf[s] = *(const bf16x8*)(qp + trow * 1024 + hd * 64 + 16 * s + 8 * h);
          g0 = gp[trow * 48 + hd * 3 + 0]; g1 = gp[trow * 48 + hd * 3 + 1]; g2 = gp[trow * 48 + hd * 3 + 2];
          kcb = (const char*)(ws + WS_KC + (size_t)bg * 512 * 64 * 2); ksb = (const char*)(ws + WS_KS + (size_t)bg * SEQ * 64 * 2); }
        for (int i = tid; i < 8192; i += 512) imp[i] = 0.f;
        const int nct = (4 * qb + 3 + 63) >> 6, wlo = qb > 8 ? qb - 8 : 0, nwin = qb - wlo + 1;
        const int e0 = nct, e1 = 2 * nct, e2 = 2 * nct + qb + 1, total = e2 + nwin;
        const int limc = (t >= 31) ? ((t - 31) >> 4) : -1;
        static_assert(WS_VCT - WS_KC == (size_t)1 << 20 && WS_KW - WS_KS == (size_t)1 << 24 && WS_VST - WS_KS == (size_t)2 << 24 && WS_VWT - WS_KW == (size_t)2 << 24, "attention tile streams rely on this workspace order");
#define ATT_ISSUE(s_) do { const int s__ = (s_); const char* kp; const char* vp; \
            if (s__ < e1) { const int ct = s__ < e0 ? s__ : s__ - e0; kp = kcb + (size_t)ct * 8192; vp = kp + ((size_t)1 << 20); } \
            else if (s__ < e2) { const int j = s__ - e1; kp = ksb + (size_t)j * 8192; vp = kp + ((size_t)2 << 24); } \
            else { const int kt = wlo + s__ - e2; kp = ksb + ((size_t)1 << 24) + (size_t)kt * 8192; vp = kp + ((size_t)2 << 24); } \
            LAS unsigned char* sl = lds + (s__ % ATT_RING) * ATT_SLOT + w * 1024; \
            __builtin_amdgcn_global_load_lds((const unsigned*)(kp + dsrc), (LAS unsigned*)sl, 16, 0, 0); \
            __builtin_amdgcn_global_load_lds((const unsigned*)(vp + dsrc), (LAS unsigned*)(sl + 8192), 16, 0, 0); } while (0)
#define ATT_SYNC(s_) do { const int rem = total - 2 - (s_); \
            if (rem >= 4) asm volatile("s_waitcnt vmcnt(8) lgkmcnt(0)\n\ts_barrier" ::: "memory"); \
            else if (rem == 3) asm volatile("s_waitcnt vmcnt(6) lgkmcnt(0)\n\ts_barrier" ::: "memory"); \
            else if (rem == 2) asm volatile("s_waitcnt vmcnt(4) lgkmcnt(0)\n\ts_barrier" ::: "memory"); \
            else if (rem == 1) asm volatile("s_waitcnt vmcnt(2) lgkmcnt(0)\n\ts_barrier" ::: "memory"); \
            else asm volatile("s_waitcnt vmcnt(0) lgkmcnt(0)\n\ts_barrier" ::: "memory"); } while (0)
        asm volatile("s_waitcnt vmcnt(0) lgkmcnt(0)\n\ts_barrier" ::: "memory");
        ATT_ISSUE(0); ATT_ISSUE(1); ATT_ISSUE(2); ATT_ISSUE(3); if (total > 4) ATT_ISSUE(4);
        if (total > 4) asm volatile("s_waitcnt vmcnt(8)\n\ts_barrier" ::: "memory"); else asm volatile("s_waitcnt vmcnt(6)\n\ts_barrier" ::: "memory");
        f32x16 O0, O1;
#pragma unroll
        for (int r = 0; r < 16; ++r) { O0[r] = 0.f; O1[r] = 0.f; }
        float mref = -1e30f, lsum = 0.f;
        int s = 0;
        for (; s < e0; ++s) {
            if (s + 5 < total) ATT_ISSUE(s + 5);
            const LAS unsigned char* Kb = lds + (s % ATT_RING) * ATT_SLOT; const int hi = limc - 64 * s;
            if (__ballot(hi >= 0) != 0ull) attn_step<true, true, false, false>(Kb, Kb + 8192, Qf, ro, -4 * h, (hi > 63 ? 63 : hi) - 4 * h, true, O0, O1, mref, lsum, nullptr, 0, lane);
            ATT_SYNC(s);
        }
        float mc2 = (lsum > 0.f) ? mref + __builtin_amdgcn_logf(lsum) : 1e30f;
        for (; s < e1; ++s) {
            if (s + 5 < total) ATT_ISSUE(s + 5);
            const LAS unsigned char* Kb = lds + (s % ATT_RING) * ATT_SLOT; const int ct = s - e0; const int hi = limc - 64 * ct;
            float dummy = 0.f;
            if (__ballot(hi >= 0) != 0ull) attn_step<true, false, true, true>(Kb, Kb + 8192, Qf, ro, -4 * h, (hi > 63 ? 63 : hi) - 4 * h, true, O0, O1, mc2, dummy, imp + tl * 128, 16 * ct, lane);
            ATT_SYNC(s);
        }
        attn_out_acc<true>((bf16_t*)(kparams()->ws + WS_ACT) + trow * 1024 + hd * 64, O0, O1, g0, h);
#pragma unroll
        for (int r = 0; r < 16; ++r) { O0[r] = 0.f; O1[r] = 0.f; }
        mref = -1e30f; lsum = 0.f;
        unsigned mw0, mw1, mw2, mw3;
        {
            for (int tk = 0; tk < 8; ++tk) {
                const int tok = w * 8 + tk; unsigned long long mlo, mhi;
                if (qb < 16) { mlo = (2ull << qb) - 1ull; mhi = 0ull; }
                else {
                    const float c0 = imp[tok * 128 + lane], c1 = imp[tok * 128 + 64 + lane];
                    const unsigned k0 = ((lane >= 1) && (lane <= qb - 2)) ? __float_as_uint(c0) + 1u : 0u;
                    const unsigned k1 = ((64 + lane) <= qb - 2) ? __float_as_uint(c1) + 1u : 0u;
                    unsigned T = 0u;
                    for (int bit = 31; bit >= 0; --bit) { const unsigned cand = T | (1u << bit);
                        const int cnt = __popcll(__ballot(k0 >= cand)) + __popcll(__ballot(k1 >= cand));
                        if (cnt >= 13) T = cand; }
                    unsigned long long gt0 = __ballot(k0 > T), gt1 = __ballot(k1 > T), eq0 = __ballot(k0 == T), eq1 = __ballot(k1 == T);
                    int need = 13 - __popcll(gt0) - __popcll(gt1);
                    while (need > 0 && eq0) { const unsigned long long low = eq0 & (0ull - eq0); gt0 |= low; eq0 ^= low; --need; }
                    while (need > 0 && eq1) { const unsigned long long low = eq1 & (0ull - eq1); gt1 |= low; eq1 ^= low; --need; }
                    mlo = gt0 | 1ull; mhi = gt1;
                    const int f1 = qb, f2 = qb - 1;
                    if (f1 < 64) mlo |= 1ull << f1; else mhi |= 1ull << (f1 - 64);
                    if (f2 < 64) mlo |= 1ull << f2; else mhi |= 1ull << (f2 - 64);
                }
                if (lane == 0) { selm[tok * 4 + 0] = (unsigned)mlo; selm[tok * 4 + 1] = (unsigned)(mlo >> 32); selm[tok * 4 + 2] = (unsigned)mhi; selm[tok * 4 + 3] = (unsigned)(mhi >> 32); }
            }
            mw0 = selm[tl * 4 + 0]; mw1 = selm[tl * 4 + 1]; mw2 = selm[tl * 4 + 2]; mw3 = selm[tl * 4 + 3];
        }
        for (; s < e2 - 1; ++s) {
            if (s + 5 < total) ATT_ISSUE(s + 5);
            const LAS unsigned char* Kb = lds + (s % ATT_RING) * ATT_SLOT; const int j = s - e1;
            const unsigned wsel = (j < 32) ? mw0 : (j < 64) ? mw1 : (j < 96) ? mw2 : mw3;
            const bool sel = (wsel >> (j & 31)) & 1u;
            if (__ballot(sel) != 0ull) attn_step<false, true, true, false>(Kb, Kb + 8192, Qf, ro, 0, 0, sel, O0, O1, mref, lsum, nullptr, 0, lane);
            ATT_SYNC(s);
        }
        {
            if (s + 5 < total) ATT_ISSUE(s + 5);
            const LAS unsigned char* Kb = lds + (s % ATT_RING) * ATT_SLOT;
            attn_step<true, true, true, false>(Kb, Kb + 8192, Qf, ro, -4 * h, tl - 4 * h, true, O0, O1, mref, lsum, nullptr, 0, lane);
            ATT_SYNC(s); ++s;
        }
        attn_out_acc<false>((bf16_t*)(kparams()->ws + WS_ACT) + trow * 1024 + hd * 64, O0, O1, g1 / fmaxf(lsum, 1e-30f), h);
#pragma unroll
        for (int r = 0; r < 16; ++r) { O0[r] = 0.f; O1[r] = 0.f; }
        mref = -1e30f; lsum = 0.f;
        for (; s < total; ++s) {
            if (s + 5 < total) ATT_ISSUE(s + 5);
            const LAS unsigned char* Kb = lds + (s % ATT_RING) * ATT_SLOT; const int kt = wlo + s - e2;
            if (kt == qb) attn_step<true, true, true, false>(Kb, Kb + 8192, Qf, ro, -4 * h, tl - 4 * h, true, O0, O1, mref, lsum, nullptr, 0, lane);
            else if (kt == qb - 8) attn_step<true, true, true, false>(Kb, Kb + 8192, Qf, ro, tl + 1 - 4 * h, 63 - 4 * h, true, O0, O1, mref, lsum, nullptr, 0, lane);
            else attn_step<false, true, true, false>(Kb, Kb + 8192, Qf, ro, 0, 0, true, O0, O1, mref, lsum, nullptr, 0, lane);
            ATT_SYNC(s);
        }
        attn_out_acc<false>((bf16_t*)(kparams()->ws + WS_ACT) + trow * 1024 + hd * 64, O0, O1, g2 / fmaxf(lsum, 1e-30f), h);
#undef ATT_ISSUE
#undef ATT_SYNC
    }
    asm volatile("s_waitcnt vmcnt(0) lgkmcnt(0)\n\ts_barrier" ::: "memory");
}
#ifndef PROBE_PRO
#define PROBE_PRO 1
#endif
#ifndef PROBE_ATT
#define PROBE_ATT 1
#endif
#ifndef PROBE_MOE
#define PROBE_MOE 1
#endif
#ifndef PROBE_QKV
#define PROBE_QKV 1
#endif
#ifndef PROBE_STEN
#define PROBE_STEN 1
#endif
#ifndef PROBE_PLE
#define PROBE_PLE 1
#endif
constexpr int NPHASES = 1 + 8 + 8 + 11 + 9 + 1;


__global__ void __launch_bounds__(512, 2) yoco_fwd(Params p_unused) {
    extern __shared__ __attribute__((aligned(16))) unsigned char smem_[];
    LAS unsigned char* lds = (LAS unsigned char*)smem_;
    int p0, p1; { KParams Q = kparams(); p0 = Q->p0; p1 = Q->p1; }
    const bool multi = (p1 - p0) > 1;
    LAS unsigned* xbw = (LAS unsigned*)(lds + LDS_BYTES - 16);
    unsigned xcc = 0;
    if (multi) {
        if (threadIdx.x == 0) { xbw[0] = 0u; xbw[1] = 0u; xbw[2] = 0u; xbw[3] = 0u; }
        __syncthreads();
        KParams Q = kparams();
        XcdBarrier b0 = xcd_barrier_post((unsigned*)(Q->ws + WS_ZERO), (volatile LAS unsigned*)xbw); xcc = b0.x;
    }
    int pid = 0;
#define PH_BEGIN { const int me_ = pid++; if (p0 <= me_ && me_ < p1) { KParams Q = kparams(); unsigned char* ws = Q->ws; (void)ws;
#define PH_END   } if (p0 <= me_ && me_ + 1 < p1) { KParams Q2 = kparams(); XcdBarrier bar; bar.bar = (unsigned*)(Q2->ws + WS_ZERO); bar.x = xcc; bar.st = (volatile LAS unsigned*)xbw; xcd_barrier(bar); } }
#define WSP(T, off) ((T*)(ws + (off)))

    PH_BEGIN Params pl; pl.ws = ws; pl.out = Q->out; for (int i = 0; i < 34; ++i) pl.in[i] = Q->in[i]; for (int rep_ = 0; rep_ < PROBE_PRO; ++rep_) { prologue_phase(lds, pl); __syncthreads(); } PH_END

    auto layer = [&](auto LC) __attribute__((always_inline)) {
        constexpr int L = decltype(LC)::value;
        if (L < 2) {
            PH_BEGIN for (int rep_ = 0; rep_ < PROBE_STEN; ++rep_) { stencil_phase(lds, (L == 0) ? Q->in[0] : Q->out, Q->in[2] + L * 1024, WSP(bf16_t, WS_ACT)); __syncthreads(); } PH_END
            PH_BEGIN
                g8::DenseSched S; S.init(T_TOK / 256, 4); S.A = (const char*)(ws + WS_ACT); S.a_tile_b = (size_t)256 * 2048; S.a_pn_b = 512;
                S.Bt = (const char*)(ws + WS_WPOOL + (size_t)L * 1024 * 256 * 2); S.b_tile_b = (size_t)256 * 256 * 2;
                EpiResid<1> E; E.L = L;
                g8::gemm_phase<EpiResid<1>, g8::DenseSched, false>(lds, 256, 2048, 128, S, E);
            PH_END
        } else {
            const int J = L - 2;
            PH_BEGIN
                g8::DenseSched S; S.init(T_TOK / 256, J == 0 ? 11 : 5); S.A = (const char*)(ws + WS_HBA); S.a_tile_b = (size_t)256 * 2048;
                S.Bt = (const char*)(ws + (J == 0 ? WS_WKVQ : WS_WQG1)); S.b_tile_b = (size_t)256 * 1024 * 2;
                EpiQkv E; E.tile0 = (J == 0) ? 0 : 6; E.J = J;
                for (int rep_ = 0; rep_ < PROBE_QKV; ++rep_) { g8::gemm_phase<EpiQkv, g8::DenseSched, false>(lds, 1024, 2048, 128, S, E); __syncthreads(); }
            PH_END
            if (J == 0) {
                PH_BEGIN
                    vtrans_phase(lds, WSP(bf16_t, WS_VS), WSP(bf16_t, WS_VW), WSP(bf16_t, WS_VST), WSP(bf16_t, WS_VWT));
                    __syncthreads();
                    g8::DenseSched S; S.init(32, 2); S.A = (const char*)(ws + WS_KVC); S.a_tile_b = 0; S.a_pn_b = 512; S.tab = WSP(unsigned, WS_CMPTAB);
                    S.Bt = (const char*)(ws + WS_WC1); S.b_tile_b = (size_t)256 * 2048 * 2;
                    EpiCmp1 E; E.dummy = 0;
                    g8::gemm_phase<EpiCmp1, g8::DenseSched, true>(lds, 2048, 0, 1024, S, E);
                PH_END
                PH_BEGIN
                    g8::DenseSched S; S.init(32, 2); S.A = (const char*)(ws + WS_CHID); S.a_tile_b = (size_t)256 * 512; S.a_pn_b = (size_t)8192 * 512;
                    S.Bt = (const char*)(ws + WS_WC2); S.b_tile_b = (size_t)256 * 256 * 2;
                    EpiCmp2 E; E.dummy = 0;
                    g8::gemm_phase<EpiCmp2, g8::DenseSched, false>(lds, 256, 512, 128, S, E);
                PH_END
            }
            PH_BEGIN
                for (int rep_ = 0; rep_ < PROBE_ATT; ++rep_) { attn_phase(lds); __syncthreads(); }
            PH_END
            PH_BEGIN
                g8::DenseSched S; S.init(T_TOK / 256, 4); S.A = (const char*)(ws + WS_ACT); S.a_tile_b = (size_t)256 * 2048;
                S.Bt = (const char*)(ws + WS_WO + (size_t)J * 1024 * 1024 * 2); S.b_tile_b = (size_t)256 * 1024 * 2;
                EpiResid<0> E; E.L = L;
                g8::gemm_phase<EpiResid<0>, g8::DenseSched, false>(lds, 1024, 2048, 128, S, E);
            PH_END
        }
        PH_BEGIN
            unsigned* counts = WSP(unsigned, WS_ZERO + ZO_COUNTS) + L * 32;
            LAS unsigned* hist = (LAS unsigned*)(lds + LDS_MISC);
            if (threadIdx.x < 32) hist[threadIdx.x] = 0u;
            __syncthreads();
            g8::DenseSched S; S.init(T_TOK / 256, 1); S.A = (const char*)(ws + WS_HBA); S.a_tile_b = (size_t)256 * 2048;
            S.Bt = (const char*)(ws + WS_WR + (size_t)L * 256 * 1024 * 2); S.b_tile_b = 0;
            EpiRouter E; E.L = L; E.hist = hist;
            g8::gemm_phase<EpiRouter, g8::DenseSched, false>(lds, 1024, 2048, 128, S, E);
            __syncthreads();
            if (threadIdx.x < 32 && hist[threadIdx.x]) __hip_atomic_fetch_add(counts + threadIdx.x, hist[threadIdx.x], __ATOMIC_RELAXED, __HIP_MEMORY_SCOPE_AGENT);
        PH_END
        PH_BEGIN scatter_phase(lds, WSP(unsigned, WS_ZERO + ZO_COUNTS) + L * 32, WSP(unsigned, WS_ZERO + ZO_CURSOR) + L * 32, WSP(int, WS_TOKE), WSP(int, WS_ROWTAB), WSP(unsigned, WS_ROWOFF)); PH_END
        PH_BEGIN
            const int ntiles = moe_tables(lds, WSP(unsigned, WS_ZERO + ZO_COUNTS) + L * 32);
            g8::MoeSched S; S.nunits = ntiles * 4; S.NPN = 4; S.G = gridDim.x; S.c = blockIdx.x; S.A = (const char*)(ws + WS_HBA); S.a_tile_b = 0;
            S.W = (const char*)(ws + WS_W13 + (size_t)L * 32 * 1024 * 1024 * 2); S.w_e_b = (size_t)1024 * 1024 * 2; S.b_tile_b = (size_t)256 * 1024 * 2;
            S.tab = WSP(unsigned, WS_ROWOFF); S.tile_e = lds + LDS_MISC + 256;
            EpiMoe1 E; E.dummy = 0;
            for (int rep_ = 0; rep_ < PROBE_MOE; ++rep_) { g8::gemm_phase<EpiMoe1, g8::MoeSched, true>(lds, 1024, 0, 128, S, E); __syncthreads(); }
        PH_END
        PH_BEGIN
            const int ntiles = moe_tables(lds, WSP(unsigned, WS_ZERO + ZO_COUNTS) + L * 32);
            g8::MoeSched S; S.nunits = ntiles * 4; S.NPN = 4; S.G = gridDim.x; S.c = blockIdx.x; S.A = (const char*)(ws + WS_HBUF); S.a_tile_b = (size_t)256 * 1024;
            S.W = (const char*)(ws + WS_W2 + (size_t)L * 32 * 1024 * 512 * 2); S.w_e_b = (size_t)1024 * 512 * 2; S.b_tile_b = (size_t)256 * 512 * 2;
            S.tab = nullptr; S.tile_e = lds + LDS_MISC + 256;
            EpiMoe2 E; E.dummy = 0;
            for (int rep_ = 0; rep_ < PROBE_MOE; ++rep_) { g8::gemm_phase<EpiMoe2, g8::MoeSched, false>(lds, 512, 1024, 128, S, E); __syncthreads(); }
        PH_END
        PH_BEGIN
            e1_phase(Q->out, WSP(bf16_t, WS_SLOT), WSP(bf16_t, WS_HBB), WSP(float, WS_RSP));
            g8::DenseSched S; S.init(T_TOK / 256, 4); S.A = (const char*)(ws + WS_PB + (size_t)L * T_TOK * 256 * 2); S.a_tile_b = (size_t)256 * 512;
            S.Bt = (const char*)(ws + WS_WPP + (size_t)L * 1024 * 256 * 2); S.b_tile_b = (size_t)256 * 256 * 2;
            EpiBf16 E; E.dummy = 0;
            for (int rep_ = 0; rep_ < PROBE_PLE; ++rep_) { g8::gemm_phase<EpiBf16, g8::DenseSched, false>(lds, 256, 512, 128, S, E); __syncthreads(); }
        PH_END
        PH_BEGIN
            g8::DenseSched S; S.init(T_TOK / 256, 4); S.A = (const char*)(ws + WS_HBB); S.a_tile_b = (size_t)256 * 2048;
            S.Bt = (const char*)(ws + WS_WPG + (size_t)L * 1024 * 1024 * 2); S.b_tile_b = (size_t)256 * 1024 * 2;
            EpiResid<2> E; E.L = L;
            g8::gemm_phase<EpiResid<2>, g8::DenseSched, false>(lds, 1024, 2048, 128, S, E);
        PH_END
    };
    layer(IC<0>{}); layer(IC<1>{}); layer(IC<2>{}); layer(IC<3>{});
    PH_BEGIN final_phase(Q->out, Q->in[33]); PH_END
#undef PH_BEGIN
#undef PH_END
}

#ifndef MK_LAUNCHES
#define MK_LAUNCHES 0
#endif

extern "C" void kernel_launch(void* const* d_in, const int* in_sizes, int n_in, void* d_out, int out_size, void* d_ws, size_t ws_size, hipStream_t stream) {
    static int ready = 0;
    if (!ready) {
        if (n_in != 34 || out_size != T_TOK * DM || ws_size < WS_END) { fprintf(stderr, "kernel_launch: unexpected sizes (n_in %d out %d ws %zu need %zu)\n", n_in, out_size, ws_size, (size_t)WS_END); ready = -1; return; }
        if (hipFuncSetAttribute((const void*)yoco_fwd, hipFuncAttributeMaxDynamicSharedMemorySize, LDS_BYTES) != hipSuccess) { fprintf(stderr, "kernel_launch: hipFuncSetAttribute failed\n"); ready = -1; return; }
        int per_cu = 0;
        if (hipOccupancyMaxActiveBlocksPerMultiprocessor(&per_cu, (const void*)yoco_fwd, 512, LDS_BYTES) != hipSuccess || per_cu < 1) fprintf(stderr, "kernel_launch: occupancy query reports %d\n", per_cu);
        (void)hipGetLastError();
        ready = 1;
    }
    if (ready < 0) return;
    (void)hipMemsetAsync((char*)d_ws + WS_ZERO, 0, ZERO_BYTES, stream);
    Params p{};
    for (int i = 0; i < 34; ++i) p.in[i] = (const float*)d_in[i];
    p.out = (float*)d_out; p.ws = (unsigned char*)d_ws;
#if MK_LAUNCHES == 1
    p.p0 = 0; p.p1 = NPHASES;
    hipLaunchKernelGGL(yoco_fwd, dim3(256), dim3(512), LDS_BYTES, stream, p);
#else
    for (int ph = 0; ph < NPHASES; ++ph) { p.p0 = ph; p.p1 = ph + 1; hipLaunchKernelGGL(yoco_fwd, dim3(256), dim3(512), LDS_BYTES, stream, p); }
#endif
}
```

```cpp
#define MK_LAUNCHES 1
#include <hip/hip_runtime.h>
#include <stdint.h>
#include <stddef.h>
#include <stdio.h>

#define LAS __attribute__((address_space(3)))
typedef unsigned short bf16_t;
typedef short bf16x8 __attribute__((ext_vector_type(8)));
typedef float f32x4 __attribute__((ext_vector_type(4)));
typedef float f32x2 __attribute__((ext_vector_type(2)));
typedef float f32x16 __attribute__((ext_vector_type(16)));
typedef unsigned u32x4 __attribute__((ext_vector_type(4)));
typedef unsigned u32x2 __attribute__((ext_vector_type(2)));

constexpr int T_TOK = 32768, DM = 1024, SEQ = 8192, NBATCH = 4;
constexpr int NEXP = 32, DFF = 512;
constexpr int PMAX = 65536 + 8192;
constexpr float RMS_EPS = 1e-6f;
constexpr float QSCALE = 0.125f * 1.4426950408889634f;

constexpr size_t al256(size_t x) { return (x + 255) & ~(size_t)255; }
constexpr size_t WS_ZERO   = 0;
constexpr size_t ZERO_BYTES = 65536;
constexpr size_t ZO_COUNTS = 16384;
constexpr size_t ZO_CURSOR = 16384 + 1024;
constexpr size_t ZO_ATTQ   = 16384 + 2048;
constexpr size_t WS_ROPE   = WS_ZERO + ZERO_BYTES;
constexpr size_t WS_CMPTAB = WS_ROPE + (size_t)SEQ * 16 * 4;
constexpr size_t WS_CB1    = WS_CMPTAB + 8192 * 4;
constexpr size_t WS_WPOOL  = WS_CB1 + 2 * 256 * 4;
constexpr size_t WS_WKVQ   = WS_WPOOL + (size_t)2 * 1024 * 256 * 2;
constexpr size_t WS_WQG1   = WS_WKVQ + (size_t)2816 * 1024 * 2;
constexpr size_t WS_WC1    = WS_WQG1 + (size_t)1280 * 1024 * 2;
constexpr size_t WS_WC2    = WS_WC1 + (size_t)2 * 256 * 2048 * 2;
constexpr size_t WS_WO     = WS_WC2 + (size_t)2 * 256 * 256 * 2;
constexpr size_t WS_WR     = WS_WO + (size_t)2 * 1024 * 1024 * 2;
constexpr size_t WS_WPP    = WS_WR + (size_t)4 * 256 * 1024 * 2;
constexpr size_t WS_WPG    = WS_WPP + (size_t)4 * 1024 * 256 * 2;
constexpr size_t WS_W13    = WS_WPG + (size_t)4 * 1024 * 1024 * 2;
constexpr size_t WS_W2     = WS_W13 + (size_t)128 * 1024 * 1024 * 2;
constexpr size_t WS_PB     = WS_W2 + (size_t)128 * 1024 * 512 * 2;
constexpr size_t WS_HBA    = WS_PB + (size_t)4 * T_TOK * 256 * 2;
constexpr size_t WS_HBB    = WS_HBA + (size_t)T_TOK * 1024 * 2;
constexpr size_t WS_SSQ    = WS_HBB + (size_t)T_TOK * 1024 * 2;
constexpr size_t WS_RSF    = WS_SSQ + (size_t)T_TOK * 16 * 4;
constexpr size_t WS_RSP    = WS_RSF + (size_t)T_TOK * 4;
constexpr size_t WS_TOKE   = WS_RSP + (size_t)T_TOK * 4;
constexpr size_t WS_TOKW   = WS_TOKE + (size_t)T_TOK * 8;
constexpr size_t WS_ROWTAB = WS_TOKW + (size_t)T_TOK * 8;
constexpr size_t WS_ROWOFF = WS_ROWTAB + (size_t)PMAX * 4;
constexpr size_t WS_GATES  = WS_ROWOFF + (size_t)PMAX * 4;
constexpr size_t WS_KC     = WS_GATES + (size_t)T_TOK * 48 * 4;
constexpr size_t WS_VCT    = WS_KC + (size_t)16 * 512 * 64 * 2;
constexpr size_t WS_CHID   = WS_VCT + (size_t)16 * 512 * 64 * 2;
constexpr size_t WS_KS     = WS_CHID + (size_t)2 * 8192 * 256 * 2;
constexpr size_t WS_KW     = WS_KS + (size_t)T_TOK * 256 * 2;
constexpr size_t WS_VST    = WS_KW + (size_t)T_TOK * 256 * 2;
constexpr size_t WS_VWT    = WS_VST + (size_t)T_TOK * 256 * 2;
constexpr size_t WS_ACT    = WS_VWT + (size_t)T_TOK * 256 * 2;
constexpr size_t WS_HBUF   = WS_ACT + (size_t)T_TOK * 1024 * 2;
constexpr size_t WS_SLOT   = WS_HBUF + (size_t)PMAX * 512 * 2;
constexpr size_t WS_END    = WS_SLOT + (size_t)2 * T_TOK * 1024 * 2;
constexpr size_t WS_Q      = WS_HBUF;
constexpr size_t WS_KVC    = WS_SLOT;
constexpr size_t WS_VS     = WS_KVC + (size_t)T_TOK * 512 * 2;
constexpr size_t WS_VW     = WS_VS + (size_t)T_TOK * 256 * 2;

constexpr int LDS_BYTES = 160 * 1024;
constexpr int LDS_MISC  = 128 * 1024;

struct Params {
    const float* in[34];
    float* out;
    unsigned char* ws;
    int p0, p1;
};

template <int N> struct IC { static constexpr int value = N; };
typedef const __attribute__((address_space(4))) Params* KParams;
__device__ __forceinline__ KParams kparams() { KParams q = (KParams)__builtin_amdgcn_kernarg_segment_ptr(); asm volatile("" : "+s"(q)); return q; }


extern __shared__ __attribute__((aligned(16))) unsigned char smem_[];
constexpr int LDS_WTAB = LDS_BYTES - 96;
__device__ __forceinline__ int hw_wave_slot() { return (int)(__builtin_amdgcn_s_getreg((5 << 11) | 4) & 63u); }
__device__ __forceinline__ int my_tid() {
    const int wv = (int)((LAS unsigned char*)smem_)[LDS_WTAB + hw_wave_slot()];
    return __builtin_amdgcn_readfirstlane(wv) * 64 + (int)__builtin_amdgcn_mbcnt_hi(~0u, __builtin_amdgcn_mbcnt_lo(~0u, 0u));
}

__device__ __forceinline__ unsigned cvt_pk_bf16(float lo, float hi) { unsigned r; asm volatile("v_cvt_pk_bf16_f32 %0, %1, %2" : "=v"(r) : "v"(lo), "v"(hi)); return r; }
__device__ __forceinline__ bf16_t f2bf(float f) { return (bf16_t)(cvt_pk_bf16(f, 0.f) & 0xffffu); }
__device__ __forceinline__ float bf2f(unsigned b) { return __uint_as_float(b << 16); }
__device__ __forceinline__ float wave_sum(float v) {
#pragma unroll
    for (int o = 1; o < 64; o <<= 1) v += __shfl_xor(v, o);
    return v;
}
__device__ __forceinline__ float sigmoidf_(float x) { return __builtin_amdgcn_rcpf(1.f + __builtin_amdgcn_exp2f(-1.4426950408889634f * x)); }
__device__ __forceinline__ int swap23(int k) { return (k & ~12) | ((k & 4) << 1) | ((k & 8) >> 1); }

#define XB_TMO      128
#define XB_XCNT(j)  (256  + 64 * (j))
#define XB_XSUB(j)  (1280 + 64 * (j))
#define XB_XGEN(j)  (2304 + 64 * (j))
#define XB_TOP      3328
#define XB_TOPGEN   3392
#define XCD_BAR_WORDS 3456
#define XB_SPIN_CAP (1u << 21)
__device__ __forceinline__ unsigned xb_ld(unsigned* p)              { return __hip_atomic_load(p, __ATOMIC_RELAXED, __HIP_MEMORY_SCOPE_AGENT); }
__device__ __forceinline__ unsigned xb_add(unsigned* p, unsigned v) { return __hip_atomic_fetch_add(p, v, __ATOMIC_RELAXED, __HIP_MEMORY_SCOPE_AGENT); }
__device__ __forceinline__ unsigned xb_xcc_id() { return (unsigned)__builtin_amdgcn_s_getreg((3 << 11) | 20) & 0xFu; }
#define XB_SPIN(cond, bar) do { unsigned _sp = 0; while (cond) { __builtin_amdgcn_s_sleep(1); \
    if ((++_sp & 255u) == 0u) { if (xb_ld(&(bar)[XB_TMO])) break; if (_sp > XB_SPIN_CAP) { atomicAdd(&(bar)[XB_TMO], 1u); break; } } } } while (0)
struct XcdBarrier { unsigned* bar; unsigned x; volatile LAS unsigned* st; };
__device__ __forceinline__ XcdBarrier xcd_barrier_post(unsigned* bar, volatile LAS unsigned* st) {
    XcdBarrier b; b.bar = bar; b.x = xb_xcc_id(); b.st = st;
    if (my_tid() == 0) (void)xb_add(&bar[XB_XCNT(b.x)], 1u);
    return b;
}
__device__ __forceinline__ void xcd_barrier_complete(unsigned* bar, unsigned x, unsigned& nloc, unsigned& nx) {
    const unsigned G = gridDim.x * gridDim.y * gridDim.z;
    unsigned sum, cnt, mine, sp = 0u;
    for (;;) {
        sum = 0u; cnt = 0u; mine = 0u;
#pragma unroll
        for (unsigned j = 0; j < 16; ++j) { const unsigned c = xb_ld(&bar[XB_XCNT(j)]); sum += c; cnt += (c > 0u) ? 1u : 0u; mine = (j == x) ? c : mine; }
        if (sum == G) break;
        __builtin_amdgcn_s_sleep(1);
        if ((++sp & 255u) == 0u) { if (xb_ld(&bar[XB_TMO])) break; if (sp > XB_SPIN_CAP) { atomicAdd(&bar[XB_TMO], 1u); break; } }
    }
    nloc = mine > 0u ? mine : 1u; nx = cnt > 0u ? cnt : 1u;
}
__device__ __forceinline__ void xcd_barrier(const XcdBarrier& b) {
    asm volatile("s_waitcnt vmcnt(0)" ::: "memory");
    __syncthreads();
    if (my_tid() == 0) {
        unsigned* bar = b.bar;
        __builtin_amdgcn_s_waitcnt(0);
        unsigned nloc = b.st[0], nx = b.st[1];
        if (nloc == 0u) { xcd_barrier_complete(bar, b.x, nloc, nx); b.st[0] = nloc; b.st[1] = nx; }
        const unsigned old = xb_add(&bar[XB_XSUB(b.x)], 1u);
        const unsigned gen = old / nloc;
        if (old + 1u == (gen + 1u) * nloc) {
            __builtin_amdgcn_fence(__ATOMIC_RELEASE, "agent");
            asm volatile("s_waitcnt vmcnt(0)" ::: "memory");
            const unsigned og = xb_add(&bar[XB_TOP], 1u);
            const unsigned tg = og / nx;
            if (og + 1u == (tg + 1u) * nx) xb_add(&bar[XB_TOPGEN], 1u);
            else XB_SPIN(xb_ld(&bar[XB_TOPGEN]) == tg, bar);
            __builtin_amdgcn_fence(__ATOMIC_ACQUIRE, "agent");
            xb_add(&bar[XB_XGEN(b.x)], 1u);
            asm volatile("s_waitcnt vmcnt(0)" ::: "memory");
        } else {
            XB_SPIN(xb_ld(&bar[XB_XGEN(b.x)]) == gen, bar);
            __builtin_amdgcn_fence(__ATOMIC_ACQUIRE, "agent");
            asm volatile("s_waitcnt vmcnt(0)" ::: "memory");
        }
    }
    __syncthreads();
}

namespace g8 {
#ifndef G8_WGM
#define G8_WGM 8
#endif
constexpr int BM = 256, BK = 64, HALF = 128, HTB = HALF * BK * 2, STAGE_BYTES = 8 * HTB, NXCD = 8, WGM = G8_WGM;
__host__ __device__ __forceinline__ int lds_byte(int r, int c) { const int st = (r >> 4) * 2 + (c >> 5), rr = r & 15, cc = c & 31, ob = rr * 64 + cc * 2; return st * 1024 + (ob ^ (((ob >> 9) & 1) << 5)); }
__host__ __device__ __forceinline__ void stage_rc(int b, int& R, int& C) { const int st = b / 1024, sb = b % 1024, swz = sb ^ (((sb >> 9) & 1) << 5); R = (st >> 1) * 16 + swz / 64; C = (st & 1) * 32 + (swz % 64) / 2; }
__host__ __device__ __forceinline__ int perm32(int rho) { const int n = rho >> 4, i = rho & 15; return 8 * (i >> 2) + 4 * n + (i & 3); }
struct Unit { int pm, pn, ord; };

struct DenseSched {
    int nM, nN, nwg, G, c;
    const char* A; const char* Bt; size_t a_tile_b, a_pn_b, b_tile_b; const unsigned* tab;
    __device__ __forceinline__ void init(int nM_, int nN_) { nM = nM_; nN = nN_; nwg = nM * nN; G = gridDim.x; c = blockIdx.x; tab = nullptr; a_pn_b = 0; }
    __device__ __forceinline__ bool next(int i, Unit& u) const {
        const long L = (long)i * G + c; if (L >= nwg) return false;
        int wgid = (int)L; { const int q = nwg / NXCD, r = nwg % NXCD, xcd = wgid % NXCD, off = wgid / NXCD; wgid = (xcd < r ? xcd * (q + 1) : r * (q + 1) + (xcd - r) * q) + off; }
        const int nig = WGM * nN, gid = wgid / nig, fm = gid * WGM, gsz = (nM - fm) < WGM ? (nM - fm) : WGM;
        u.pm = fm + ((wgid % nig) % gsz); u.pn = (wgid % nig) / gsz; return true;
    }
    __device__ __forceinline__ const char* a_base(const Unit& u) const { return A + (size_t)u.pm * a_tile_b + (size_t)u.pn * a_pn_b; }
    __device__ __forceinline__ const char* b_base(const Unit& u) const { return Bt + (size_t)u.pn * b_tile_b; }
    __device__ __forceinline__ const unsigned* row_tab(const Unit& u) const { return tab + u.pm * 256; }
};
struct MoeSched {
    int nunits, NPN, G, c;
    const char* A; const char* W; size_t a_tile_b, w_e_b, b_tile_b; const unsigned* tab; const LAS unsigned char* tile_e;
    __device__ __forceinline__ bool next(int i, Unit& u) const {
        const int ntile = nunits / NPN, per = (ntile + 7) >> 3, x = c & 7, r = c >> 3, W = G >> 3;
        const int uidx = i * W + r, t = x * per + uidx / NPN;
        if (uidx >= per * NPN || t >= ntile) return false;
        u.pm = t; u.pn = uidx % NPN; return true;
    }
    __device__ __forceinline__ const char* a_base(const Unit& u) const { return A + (size_t)u.pm * a_tile_b; }
    __device__ __forceinline__ const char* b_base(const Unit& u) const { return W + (size_t)tile_e[u.pm] * w_e_b + (size_t)u.pn * b_tile_b; }
    __device__ __forceinline__ const unsigned* row_tab(const Unit& u) const { return tab + u.pm * 256; }
};

template <class Epi, class Sched, bool GATHER>
__device__ __forceinline__ void gemm_phase(LAS unsigned char* lds, const int K_, const int lda_b, const int kstepA, const Sched& S, const Epi& E) {
    int K = K_; asm volatile("" : "+s"(K));
    int tid_ = my_tid(); asm volatile("" : "+v"(tid_));
    const int tid = tid_, wid = __builtin_amdgcn_readfirstlane(tid >> 6), lane = tid & 63, wr = wid >> 2, wc = wid & 3, fr = lane & 15, fq = lane >> 4;
    const int nt = K / BK;
    unsigned voffB[2], va[2][2], vn[2][2];
#pragma unroll
    for (int i = 0; i < 2; ++i) { int R, C; stage_rc(tid * 16 + i * 8192, R, C); const int Rb = Epi::PERM ? ((R & ~31) + perm32(R & 31)) : R;
        voffB[i] = (unsigned)(Rb * K + C) * 2u;
        va[0][i] = (unsigned)(R * lda_b + C * 2); va[1][i] = (unsigned)((R + HALF) * lda_b + C * 2); vn[0][i] = va[0][i]; vn[1][i] = va[1][i]; }
    const size_t kstepB = (size_t)(BK * 2);
    const size_t hstepB = (size_t)HALF * K * 2;
    const unsigned ldsw = (unsigned)wid * 1024u;
    const int aoff = lds_byte(wr * 64 + fr, fq * 8), boff = lds_byte(wc * 32 + fr, fq * 8);
#define G8_SA(b, h) (((b) * 2 + (h)) * HTB)
#define G8_SB(b, h) ((4 + (b) * 2 + (h)) * HTB)
#define G8_STAGEB(bufoff, gbase) do { _Pragma("unroll") for (int _i = 0; _i < 2; ++_i) \
        __builtin_amdgcn_global_load_lds((const unsigned*)((const char*)(gbase) + voffB[_i]), (LAS unsigned*)(lds + (bufoff) + ldsw + _i * 8192), 16, 0, 0); } while (0)
#define G8_STAGEA(bufoff, gbase, VA, h) do { _Pragma("unroll") for (int _i = 0; _i < 2; ++_i) \
        __builtin_amdgcn_global_load_lds((const unsigned*)((const char*)(gbase) + (VA)[h][_i]), (LAS unsigned*)(lds + (bufoff) + ldsw + _i * 8192), 16, 0, 0); } while (0)
#define G8_LDA(dst, b, h) do { _Pragma("unroll") for (int m = 0; m < 4; ++m) _Pragma("unroll") for (int k = 0; k < 2; ++k) dst[m][k] = *(const LAS bf16x8*)(lds + G8_SA(b, h) + aoff + m * 2048 + k * 1024); } while (0)
#define G8_LDB(dst, b, h) do { _Pragma("unroll") for (int n = 0; n < 2; ++n) _Pragma("unroll") for (int k = 0; k < 2; ++k) dst[n][k] = *(const LAS bf16x8*)(lds + G8_SB(b, h) + boff + n * 2048 + k * 1024); } while (0)
#define G8_MMA(ai, bj, At, Bt) do { __builtin_amdgcn_s_setprio(1); _Pragma("unroll") for (int m = 0; m < 4; ++m) _Pragma("unroll") for (int n = 0; n < 2; ++n) _Pragma("unroll") for (int k = 0; k < 2; ++k) \
        acc[ai][bj][m][n] = __builtin_amdgcn_mfma_f32_16x16x32_bf16(Bt[n][k], At[m][k], acc[ai][bj][m][n], 0, 0, 0); __builtin_amdgcn_s_setprio(0); } while (0)
#define G8_WAIT_V(n) asm volatile("s_waitcnt vmcnt(" #n ")" ::: "memory")
#define G8_WAIT_L(n) asm volatile("s_waitcnt lgkmcnt(" #n ")" ::: "memory")
#define G8_BAR __builtin_amdgcn_s_barrier()
#define G8_SCHED __builtin_amdgcn_sched_barrier(0)
    Unit cur, nxt; int ui = 0;
    if (!S.next(0, cur)) return;
    cur.ord = 0;
    f32x4 acc[2][2][4][2];
#pragma unroll
    for (int a = 0; a < 2; ++a)
#pragma unroll
        for (int b = 0; b < 2; ++b)
#pragma unroll
            for (int m = 0; m < 4; ++m)
#pragma unroll
                for (int n = 0; n < 2; ++n) acc[a][b][m][n] = (f32x4){0.f, 0.f, 0.f, 0.f};
    bf16x8 At[4][2], B0[2][2], B1[2][2];
    const char* cA = S.a_base(cur); const char* cB = S.b_base(cur);
    if (GATHER) { const unsigned* tb = S.row_tab(cur);
#pragma unroll
        for (int i = 0; i < 2; ++i) { int R, C; stage_rc(tid * 16 + i * 8192, R, C); va[0][i] = tb[R] + (unsigned)(C * 2); va[1][i] = tb[R + HALF] + (unsigned)(C * 2); } }
    G8_STAGEB(G8_SB(0, 0), cB); G8_STAGEA(G8_SA(0, 0), cA, va, 0); G8_STAGEB(G8_SB(0, 1), cB + hstepB); G8_STAGEA(G8_SA(0, 1), cA, va, 1);
    if (wr == 1) G8_BAR;
    G8_WAIT_V(4); G8_BAR;
    G8_STAGEB(G8_SB(1, 0), cB + kstepB); G8_STAGEA(G8_SA(1, 0), cA + kstepA, va, 0); G8_STAGEB(G8_SB(1, 1), cB + hstepB + kstepB);
    G8_WAIT_V(6); G8_BAR;
    for (;;) {
        const bool has_next = S.next(ui + 1, nxt); nxt.ord = ui + 1;
        const char* nA = has_next ? S.a_base(nxt) : cA; const char* nB = has_next ? S.b_base(nxt) : cB;
        if (GATHER) {
            if (has_next) { const unsigned* tb = S.row_tab(nxt);
#pragma unroll
                for (int i = 0; i < 2; ++i) { int R, C; stage_rc(tid * 16 + i * 8192, R, C); vn[0][i] = tb[R] + (unsigned)(C * 2); vn[1][i] = tb[R + HALF] + (unsigned)(C * 2); } }
            else {
#pragma unroll
                for (int i = 0; i < 2; ++i) { vn[0][i] = va[0][i]; vn[1][i] = va[1][i]; } }
        }
        for (int t = 0; t < nt; t += 2) {
            const bool last = (t == nt - 2);
            const char* a1 = cA + (size_t)(t + 1) * kstepA;
            const char* a2 = last ? nA : cA + (size_t)(t + 2) * kstepA; const char* b2 = last ? nB : cB + (size_t)(t + 2) * kstepB;
            const char* a3 = a2 + kstepA; const char* b3 = b2 + kstepB;
            unsigned vx[2][2];
#pragma unroll
            for (int hh = 0; hh < 2; ++hh)
#pragma unroll
                for (int i = 0; i < 2; ++i) vx[hh][i] = (GATHER && last) ? vn[hh][i] : va[hh][i];
            G8_LDB(B0, 0, 0); G8_SCHED; G8_LDA(At, 0, 0); G8_STAGEA(G8_SA(1, 1), a1, va, 1);
            G8_WAIT_L(8); G8_BAR; G8_WAIT_L(0); G8_MMA(0, 0, At, B0); G8_BAR; G8_SCHED;
            G8_LDB(B1, 0, 1); G8_STAGEB(G8_SB(0, 0), b2);
            G8_BAR; G8_WAIT_L(0); G8_MMA(0, 1, At, B1); G8_BAR;
            G8_LDA(At, 0, 1); G8_STAGEA(G8_SA(0, 0), a2, vx, 0);
            G8_BAR; G8_WAIT_L(0); G8_MMA(1, 0, At, B0); G8_BAR; G8_SCHED;
            G8_STAGEB(G8_SB(0, 1), b2 + hstepB);
            G8_WAIT_V(6); G8_BAR; G8_MMA(1, 1, At, B1); G8_BAR;
            G8_LDB(B0, 1, 0); G8_SCHED; G8_LDA(At, 1, 0); G8_STAGEA(G8_SA(0, 1), a2, vx, 1);
            G8_WAIT_L(8); G8_BAR; G8_WAIT_L(0); G8_MMA(0, 0, At, B0); G8_BAR; G8_SCHED;
            G8_LDB(B1, 1, 1); G8_STAGEB(G8_SB(1, 0), b3);
            G8_BAR; G8_WAIT_L(0); G8_MMA(0, 1, At, B1); G8_BAR;
            G8_LDA(At, 1, 1); G8_STAGEA(G8_SA(1, 0), a3, vx, 0);
            G8_BAR; G8_WAIT_L(0); G8_MMA(1, 0, At, B0); G8_BAR; G8_SCHED;
            G8_STAGEB(G8_SB(1, 1), b3 + hstepB);
            G8_WAIT_V(6); G8_BAR; G8_MMA(1, 1, At, B1); G8_BAR;
        }
        E(acc, cur, wr, wc, fr, fq);
#ifdef PROBE_EPI2
        if (Epi::PROBE_DUP) E(acc, cur, wr, wc, fr, fq);
#endif
        if (!has_next) break;
#pragma unroll
        for (int a = 0; a < 2; ++a)
#pragma unroll
            for (int b = 0; b < 2; ++b)
#pragma unroll
                for (int m = 0; m < 4; ++m)
#pragma unroll
                    for (int n = 0; n < 2; ++n) acc[a][b][m][n] = (f32x4){0.f, 0.f, 0.f, 0.f};
        cur = nxt; cA = nA; cB = nB; ++ui;
        if (GATHER) {
#pragma unroll
            for (int i = 0; i < 2; ++i) { va[0][i] = vn[0][i]; va[1][i] = vn[1][i]; } }
    }
    G8_WAIT_V(0);
    if (wr == 0) G8_BAR;
    G8_BAR;
#undef G8_SA
#undef G8_SB
#undef G8_STAGEA
#undef G8_STAGEB
#undef G8_LDA
#undef G8_LDB
#undef G8_MMA
#undef G8_WAIT_V
#undef G8_WAIT_L
#undef G8_BAR
#undef G8_SCHED
}
}
using g8::Unit;

#ifndef PROBE_EPI_SEL
#define PROBE_EPI_SEL 0
#endif
typedef f32x4 AccT[2][2][4][2];

template <int MODE> struct EpiResid {
    static constexpr bool PERM = false; static constexpr bool PROBE_DUP = (PROBE_EPI_SEL == 4 && MODE == 2);
    int L;
    __device__ __forceinline__ void operator()(const AccT& acc, const Unit& u, int wr, int wc, int fr, int fq) const {
        KParams Q = kparams(); unsigned char* ws = Q->ws;
        const bf16_t* hin = (const bf16_t*)(ws + (MODE == 2 ? WS_HBB : WS_HBA)); bf16_t* hb = (bf16_t*)(ws + WS_HBA); float* ssq = (float*)(ws + WS_SSQ);
        const float* bias = (MODE == 1) ? Q->in[6] + L * 1024 : Q->in[32] + L * 1024; const float* scale = Q->in[7] + L * 1024;
        const bf16_t* ple = (const bf16_t*)(ws + WS_ACT); const float* rstd = (const float*)(ws + WS_RSP);
        const int col0 = u.pn * 256 + wc * 32 + 4 * fq;
        f32x4 bv[2][2], sv[2][2];
#pragma unroll
        for (int bj = 0; bj < 2; ++bj)
#pragma unroll
            for (int n = 0; n < 2; ++n) {
                bv[bj][n] = (MODE != 0) ? *(const f32x4*)(bias + col0 + bj * 128 + n * 16) : (f32x4){0.f, 0.f, 0.f, 0.f};
                sv[bj][n] = (MODE == 1) ? *(const f32x4*)(scale + col0 + bj * 128 + n * 16) : (f32x4){1.f, 1.f, 1.f, 1.f}; }
#pragma unroll
        for (int ai = 0; ai < 2; ++ai) {
          u32x2 hws[4][2][2], pws[4][2][2]; float rsv[4];
#pragma unroll
          for (int m = 0; m < 4; ++m) { const int row = u.pm * 256 + ai * 128 + wr * 64 + m * 16 + fr; const size_t off = (size_t)row * DM + col0;
              rsv[m] = (MODE == 2) ? rstd[row] : 1.f;
#pragma unroll
              for (int bj = 0; bj < 2; ++bj)
#pragma unroll
                  for (int n = 0; n < 2; ++n) { hws[m][bj][n] = *(const u32x2*)(hin + off + bj * 128 + n * 16); if (MODE == 2) pws[m][bj][n] = *(const u32x2*)(ple + off + bj * 128 + n * 16); } }
#pragma unroll
            for (int m = 0; m < 4; ++m) {
                const int row = u.pm * 256 + ai * 128 + wr * 64 + m * 16 + fr;
                const size_t off = (size_t)row * DM + col0;
                const float rs = rsv[m];
                float ss = 0.f;
#pragma unroll
                for (int bj = 0; bj < 2; ++bj)
#pragma unroll
                    for (int n = 0; n < 2; ++n) {
                        const size_t o = off + bj * 128 + n * 16;
                        const u32x2 hw = hws[m][bj][n];
                        const f32x4 hv = {bf2f(hw.x & 0xffffu), bf2f(hw.x >> 16), bf2f(hw.y & 0xffffu), bf2f(hw.y >> 16)};
                        f32x4 v = acc[ai][bj][m][n];
                        if (MODE == 1) v = (v + bv[bj][n]) * sv[bj][n];
                        if (MODE == 2) { const u32x2 pw = pws[m][bj][n];
                            f32x4 pl = {bf2f(pw.x & 0xffffu), bf2f(pw.x >> 16), bf2f(pw.y & 0xffffu), bf2f(pw.y >> 16)};
                            f32x4 z = v * rs + bv[bj][n];
                            v = (f32x4){pl.x * sigmoidf_(z.x), pl.y * sigmoidf_(z.y), pl.z * sigmoidf_(z.z), pl.w * sigmoidf_(z.w)}; }
                        v = v + hv;
                        u32x2 w; w.x = cvt_pk_bf16(v.x, v.y); w.y = cvt_pk_bf16(v.z, v.w);
                        *(u32x2*)(hb + o) = w;
                        const float r0 = bf2f(w.x & 0xffffu), r1 = bf2f(w.x >> 16), r2 = bf2f(w.y & 0xffffu), r3 = bf2f(w.y >> 16);
                        ss += r0 * r0 + r1 * r1 + r2 * r2 + r3 * r3;
                    }
                ss += __shfl_xor(ss, 16); ss += __shfl_xor(ss, 32);
                if (fq == 0) ssq[(size_t)row * 16 + u.pn * 4 + wc] = ss;
            }
        }
    }
};

__device__ __forceinline__ float rstd_from_parts(const float* ssq, int row) {
    const f32x4* p = (const f32x4*)(ssq + (size_t)row * 16);
    const f32x4 a = p[0], b = p[1], c = p[2], d = p[3];
    const float s = ((a.x + a.y) + (a.z + a.w)) + ((b.x + b.y) + (b.z + b.w)) + ((c.x + c.y) + (c.z + c.w)) + ((d.x + d.y) + (d.z + d.w));
    return 1.f / sqrtf(s * (1.f / DM) + RMS_EPS);
}


constexpr int LDS_RSTD = LDS_MISC + 4096;
constexpr int LDS_RBIAS = LDS_RSTD + 6 * 1024;
template <class Sched>
__device__ __forceinline__ void rstd_table_fill(LAS unsigned char* lds, const Sched& S, const float* ssq) {
    LAS float* tab = (LAS float*)(lds + LDS_RSTD);
    const int tid = my_tid();
    for (int i0 = 0; i0 < 6; i0 += 2) { Unit u; const int i = i0 + (tid >> 8);
        if (S.next(i, u)) { const int row = u.pm * 256 + (tid & 255); tab[i * 256 + (tid & 255)] = rstd_from_parts(ssq, row); } }
    __syncthreads();
}
struct EpiRouter {
    static constexpr bool PERM = false; static constexpr bool PROBE_DUP = false;
    int L; LAS unsigned* hist;
    __device__ __forceinline__ void operator()(const AccT& acc, const Unit& u, int wr, int wc, int fr, int fq) const {
        if (wc != 0) return;
        KParams Q = kparams(); unsigned char* ws = Q->ws;
        const LAS float* rtab = (const LAS float*)((LAS unsigned char*)smem_ + LDS_RSTD); const LAS float* gb = (const LAS float*)((LAS unsigned char*)smem_ + LDS_RBIAS); const LAS float* eb = gb + 4;
        int* toke = (int*)(ws + WS_TOKE); float* tokw = (float*)(ws + WS_TOKW); float* rsf = (float*)(ws + WS_RSF);
#pragma unroll
        for (int ai = 0; ai < 2; ++ai)
#pragma unroll
            for (int m = 0; m < 4; ++m) {
                const int row = u.pm * 256 + ai * 128 + wr * 64 + m * 16 + fr;
                const float rs = rtab[u.ord * 256 + ai * 128 + wr * 64 + m * 16 + fr];
                float gl[4];
#pragma unroll
                for (int i = 0; i < 4; ++i) gl[i] = __shfl(acc[ai][1][m][0][i], fr) * rs + gb[i];
                int grp = 0; float gm = gl[0];
#pragma unroll
                for (int i = 1; i < 4; ++i) if (gl[i] > gm) { gm = gl[i]; grp = i; }
                float gs = 0.f;
#pragma unroll
                for (int i = 0; i < 4; ++i) gs += __expf(gl[i] - gm);
                const float gprob = 1.f / gs;
                f32x4 mine;
#pragma unroll
                for (int i = 0; i < 4; ++i) { float x0 = acc[ai][0][m][0][i], x1 = acc[ai][0][m][1][i]; asm volatile("" : "+v"(x0), "+v"(x1)); mine[i] = (grp >> 1) ? x1 : x0; }
                const int src0 = fr + 16 * (2 * (grp & 1));
                float el[8];
#pragma unroll
                for (int i = 0; i < 4; ++i) { el[i] = __shfl(mine[i], src0); el[4 + i] = __shfl(mine[i], src0 + 16); }
#pragma unroll
                for (int j = 0; j < 8; ++j) el[j] = el[j] * rs + eb[grp * 8 + j];
                int i1 = 0; float v1 = el[0];
#pragma unroll
                for (int j = 1; j < 8; ++j) if (el[j] > v1) { v1 = el[j]; i1 = j; }
                int i2 = -1; float v2 = -3.0e38f;
#pragma unroll
                for (int j = 0; j < 8; ++j) if (j != i1 && el[j] > v2) { v2 = el[j]; i2 = j; }
                const float e2 = __expf(v2 - v1), inv = 1.f / (1.f + e2);
                if (fq == 0) {
                    const int e1g = grp * 8 + i1, e2g = grp * 8 + i2;
                    *(int2*)(toke + (size_t)row * 2) = make_int2(e1g, e2g);
                    *(float2*)(tokw + (size_t)row * 2) = make_float2(gprob * inv, gprob * e2 * inv);
                    rsf[row] = rs;
                    atomicAdd((unsigned*)&hist[e1g], 1u); atomicAdd((unsigned*)&hist[e2g], 1u);
                }
            }
    }
};

struct EpiMoe1 {
    static constexpr bool PERM = true; static constexpr bool PROBE_DUP = (PROBE_EPI_SEL == 2);
    int dummy;
    __device__ __forceinline__ void operator()(const AccT& acc, const Unit& u, int wr, int wc, int fr, int fq) const {
        KParams Q = kparams(); unsigned char* ws = Q->ws;
        const int* rowtab = (const int*)(ws + WS_ROWTAB); const float* rsf = (const float*)(ws + WS_RSF); bf16_t* hbuf = (bf16_t*)(ws + WS_HBUF);
        const int hc0 = u.pn * 128 + wc * 16 + 4 * fq;
        int av[8]; float rsv[8];
#pragma unroll
        for (int i8 = 0; i8 < 8; ++i8) av[i8] = rowtab[u.pm * 256 + (i8 >> 2) * 128 + wr * 64 + (i8 & 3) * 16 + fr];
#pragma unroll
        for (int i8 = 0; i8 < 8; ++i8) rsv[i8] = rsf[av[i8] < 0 ? 0 : (av[i8] >> 1)];
#pragma unroll
        for (int ai = 0; ai < 2; ++ai)
#pragma unroll
            for (int m = 0; m < 4; ++m) {
                const int pos = u.pm * 256 + ai * 128 + wr * 64 + m * 16 + fr;
                const int a = av[ai * 4 + m];
                if (a < 0) continue;
                const float rs = rsv[ai * 4 + m];
#pragma unroll
                for (int bj = 0; bj < 2; ++bj) {
                    const f32x4 g = acc[ai][bj][m][0] * rs, uu = acc[ai][bj][m][1] * rs;
                    f32x4 o;
#pragma unroll
                    for (int i = 0; i < 4; ++i) o[i] = g[i] * sigmoidf_(g[i]) * uu[i];
                    u32x2 w; w.x = cvt_pk_bf16(o.x, o.y); w.y = cvt_pk_bf16(o.z, o.w);
                    *(u32x2*)(hbuf + (size_t)pos * DFF + hc0 + bj * 64) = w;
                }
            }
    }
};
struct EpiMoe2 {
    static constexpr bool PERM = true; static constexpr bool PROBE_DUP = (PROBE_EPI_SEL == 3);
    int dummy;
    __device__ __forceinline__ void operator()(const AccT& acc, const Unit& u, int wr, int wc, int fr, int fq) const {
        KParams Q = kparams(); unsigned char* ws = Q->ws;
        const int* rowtab = (const int*)(ws + WS_ROWTAB); const float* tokw = (const float*)(ws + WS_TOKW); bf16_t* slot = (bf16_t*)(ws + WS_SLOT);
        const int col0 = u.pn * 256 + wc * 32 + 8 * fq;
        int av[8]; float wv[8];
#pragma unroll
        for (int i8 = 0; i8 < 8; ++i8) av[i8] = rowtab[u.pm * 256 + (i8 >> 2) * 128 + wr * 64 + (i8 & 3) * 16 + fr];
#pragma unroll
        for (int i8 = 0; i8 < 8; ++i8) wv[i8] = tokw[av[i8] < 0 ? 0 : av[i8]];
#pragma unroll
        for (int ai = 0; ai < 2; ++ai)
#pragma unroll
            for (int m = 0; m < 4; ++m) {
                const int a = av[ai * 4 + m];
                if (a < 0) continue;
                const float w = wv[ai * 4 + m];
#pragma unroll
                for (int bj = 0; bj < 2; ++bj) {
                    const f32x4 v0 = acc[ai][bj][m][0] * w, v1 = acc[ai][bj][m][1] * w;
                    u32x4 o; o.x = cvt_pk_bf16(v0.x, v0.y); o.y = cvt_pk_bf16(v0.z, v0.w); o.z = cvt_pk_bf16(v1.x, v1.y); o.w = cvt_pk_bf16(v1.z, v1.w);
                    *(u32x4*)(slot + (size_t)a * DM + col0 + bj * 128) = o;
                }
            }
    }
};
struct EpiBf16 {
    static constexpr bool PERM = true; static constexpr bool PROBE_DUP = false;
    int dummy;
    __device__ __forceinline__ void operator()(const AccT& acc, const Unit& u, int wr, int wc, int fr, int fq) const {
        KParams Q = kparams(); bf16_t* O = (bf16_t*)(Q->ws + WS_ACT); constexpr int ldc = 1024;
        const int col0 = u.pn * 256 + wc * 32 + 8 * fq;
#pragma unroll
        for (int ai = 0; ai < 2; ++ai)
#pragma unroll
            for (int m = 0; m < 4; ++m) {
                const int row = u.pm * 256 + ai * 128 + wr * 64 + m * 16 + fr;
#pragma unroll
                for (int bj = 0; bj < 2; ++bj) {
                    const f32x4 v0 = acc[ai][bj][m][0], v1 = acc[ai][bj][m][1];
                    u32x4 o; o.x = cvt_pk_bf16(v0.x, v0.y); o.y = cvt_pk_bf16(v0.z, v0.w); o.z = cvt_pk_bf16(v1.x, v1.y); o.w = cvt_pk_bf16(v1.z, v1.w);
                    *(u32x4*)(O + (size_t)row * ldc + col0 + bj * 128) = o;
                }
            }
    }
};
struct EpiQkv {
    static constexpr bool PERM = true; static constexpr bool PROBE_DUP = (PROBE_EPI_SEL == 1);
    int tile0; int J;
    __device__ __forceinline__ void operator()(const AccT& acc, const Unit& u, int wr, int wc, int fr, int fq) const {
        KParams Q = kparams(); unsigned char* ws = Q->ws;
        const float* ssq = (const float*)(ws + WS_SSQ); const float* rope = (const float*)(ws + WS_ROPE); const float* bgate = Q->in[21] + J * 48;
        bf16_t* kvc = (bf16_t*)(ws + WS_KVC); bf16_t* ks = (bf16_t*)(ws + WS_KS); bf16_t* vs = (bf16_t*)(ws + WS_VS); bf16_t* kw = (bf16_t*)(ws + WS_KW); bf16_t* vw = (bf16_t*)(ws + WS_VW);
        bf16_t* q = (bf16_t*)(ws + WS_Q); float* gates = (float*)(ws + WS_GATES);
        const int ty = u.pn + tile0;
        const int cu0 = wc * 32 + 8 * fq;
        const bool roped = (ty == 2 || ty == 4 || ty >= 6) && ty != 10;
        const bool dorope = roped && ((wc & 1) == 0);
        bf16_t* dst; int ldc; int cbase;
        if (ty < 2)       { dst = kvc; ldc = 512;  cbase = ty * 256; }
        else if (ty == 2) { dst = ks;  ldc = 256;  cbase = 0; }
        else if (ty == 3) { dst = vs;  ldc = 256;  cbase = 0; }
        else if (ty == 4) { dst = kw;  ldc = 256;  cbase = 0; }
        else if (ty == 5) { dst = vw;  ldc = 256;  cbase = 0; }
        else              { dst = q;   ldc = 1024; cbase = (ty - 6) * 256; }
        const LAS float* rtab = (const LAS float*)((LAS unsigned char*)smem_ + LDS_RSTD);
#pragma unroll
        for (int ai = 0; ai < 2; ++ai)
#pragma unroll
            for (int m = 0; m < 4; ++m) {
                const int row = u.pm * 256 + ai * 128 + wr * 64 + m * 16 + fr;
                const float rs = rtab[u.ord * 256 + ai * 128 + wr * 64 + m * 16 + fr];
                if (ty == 10) {
                    if (wc < 2) {
#pragma unroll
                        for (int n = 0; n < 2; ++n) {
                            const int c = cu0 + 4 * n;
                            if (c < 48) { f32x4 z = acc[ai][0][m][n] * rs + *(const f32x4*)(bgate + c);
                                f32x4 o = {sigmoidf_(z.x), sigmoidf_(z.y), sigmoidf_(z.z), sigmoidf_(z.w)};
                                *(f32x4*)(gates + (size_t)row * 48 + c) = o; }
                        }
                    }
                    continue;
                }
                f32x4 cs[2], sn[2];
                if (dorope) {
                    const float pf = (float)(row & (SEQ - 1));
                    constexpr float RV[8] = {0.15915494309189535f, 0.03086376340470123f, 0.005985185712713705f, 0.001160663641240061f, 0.00022507907903927653f, 4.364795279280289e-05f, 8.464330808241401e-06f, 1.6414262627950345e-06f};
#pragma unroll
                    for (int n2 = 0; n2 < 2; ++n2)
#pragma unroll
                        for (int i = 0; i < 4; ++i) { const float rv = __builtin_amdgcn_fractf(pf * RV[4 * n2 + i]); cs[n2][i] = __builtin_amdgcn_cosf(rv); sn[n2][i] = __builtin_amdgcn_sinf(rv); }
                }
#pragma unroll
                for (int bj = 0; bj < 2; ++bj) {
                    f32x4 v[2];
#pragma unroll
                    for (int n = 0; n < 2; ++n) {
                        v[n] = acc[ai][bj][m][n] * rs;
                        if (dorope) {
                            f32x4 ot;
#pragma unroll
                            for (int i = 0; i < 4; ++i) ot[i] = __shfl_xor(v[n][i], 16);
                            if (fq == 0) v[n] = v[n] * cs[n] - ot * sn[n];
                            else if (fq == 1) v[n] = v[n] * cs[n] + ot * sn[n];
                        }
                        if (ty >= 6) v[n] = v[n] * QSCALE;
                    }
                    u32x4 o; o.x = cvt_pk_bf16(v[0].x, v[0].y); o.y = cvt_pk_bf16(v[0].z, v[0].w); o.z = cvt_pk_bf16(v[1].x, v[1].y); o.w = cvt_pk_bf16(v[1].z, v[1].w);
                    if (ty == 2 || ty == 4) *(u32x4*)(dst + (((size_t)((row >> 13) * 4 + 2 * bj + (wc >> 1))) * SEQ + (row & (SEQ - 1))) * 64 + (wc & 1) * 32 + 8 * fq) = o;
                    else *(u32x4*)(dst + (size_t)row * ldc + cbase + cu0 + bj * 128) = o;
                }
            }
    }
};
__device__ __forceinline__ float gelu_tanh(float x) {
    const float u = 0.7978845608028654f * (x + 0.044715f * x * x * x);
    const float t = 1.f - 2.f * __builtin_amdgcn_rcpf(1.f + __builtin_amdgcn_exp2f(2.8853900817779268f * u));
    return 0.5f * x * (1.f + t);
}
struct EpiCmp1 {
    static constexpr bool PERM = true; static constexpr bool PROBE_DUP = false;
    int dummy;
    __device__ __forceinline__ void operator()(const AccT& acc, const Unit& u, int wr, int wc, int fr, int fq) const {
        KParams Q = kparams(); unsigned char* ws = Q->ws; const float* cb1 = (const float*)(ws + WS_CB1); bf16_t* chid = (bf16_t*)(ws + WS_CHID);
        const int col0 = wc * 32 + 8 * fq;
        bf16_t* O = chid + (size_t)u.pn * 8192 * 256;
#pragma unroll
        for (int ai = 0; ai < 2; ++ai)
#pragma unroll
            for (int m = 0; m < 4; ++m) {
                const int row = u.pm * 256 + ai * 128 + wr * 64 + m * 16 + fr;
#pragma unroll
                for (int bj = 0; bj < 2; ++bj) {
                    const int c = col0 + bj * 128;
                    const f32x4 b0 = *(const f32x4*)(cb1 + u.pn * 256 + c), b1 = *(const f32x4*)(cb1 + u.pn * 256 + c + 4);
                    const f32x4 v0 = acc[ai][bj][m][0] + b0, v1 = acc[ai][bj][m][1] + b1;
                    u32x4 o; o.x = cvt_pk_bf16(gelu_tanh(v0.x), gelu_tanh(v0.y)); o.y = cvt_pk_bf16(gelu_tanh(v0.z), gelu_tanh(v0.w));
                    o.z = cvt_pk_bf16(gelu_tanh(v1.x), gelu_tanh(v1.y)); o.w = cvt_pk_bf16(gelu_tanh(v1.z), gelu_tanh(v1.w));
                    *(u32x4*)(O + (size_t)row * 256 + c) = o;
                }
            }
    }
};
struct EpiCmp2 {
    static constexpr bool PERM = true; static constexpr bool PROBE_DUP = false;
    int dummy;
    __device__ __forceinline__ void operator()(const AccT& acc, const Unit& u, int wr, int wc, int fr, int fq) const {
        if (wc >= 2) return;
        KParams Q = kparams(); unsigned char* ws = Q->ws; const float* b2k = Q->in[14]; const float* b2v = Q->in[19]; const float* rope = (const float*)(ws + WS_ROPE);
        bf16_t* kc = (bf16_t*)(ws + WS_KC); bf16_t* vct = (bf16_t*)(ws + WS_VCT);
        const int c0 = wc * 32 + 8 * fq;
        const float* b2 = u.pn ? b2v : b2k;
        const f32x4 bb0 = *(const f32x4*)(b2 + c0), bb1 = *(const f32x4*)(b2 + c0 + 4);
#pragma unroll
        for (int ai = 0; ai < 2; ++ai)
#pragma unroll
            for (int m = 0; m < 4; ++m) {
                const int row = u.pm * 256 + ai * 128 + wr * 64 + m * 16 + fr;
                const int bg = row >> 9, n = row & 511;
                f32x4 v[2]; v[0] = acc[ai][0][m][0] + bb0; v[1] = acc[ai][0][m][1] + bb1;
                if (u.pn == 0) {
#ifdef DBG_NOROPE_KC
                    if (false) {
#else
                    if (wc == 0) {
#endif
                        const int pos = (16 * n + 31) & (SEQ - 1);
                        const float* rp = rope + (size_t)pos * 16;
#pragma unroll
                        for (int nn = 0; nn < 2; ++nn) {
                            const f32x4 cs = *(const f32x4*)(rp + 4 * nn), sn = *(const f32x4*)(rp + 8 + 4 * nn);
                            f32x4 ot;
#pragma unroll
                            for (int i = 0; i < 4; ++i) ot[i] = __shfl_xor(v[nn][i], 16);
                            if (fq == 0) v[nn] = v[nn] * cs - ot * sn; else if (fq == 1) v[nn] = v[nn] * cs + ot * sn;
                        }
                    }
                    if (n == 511) { v[0] = (f32x4){0.f, 0.f, 0.f, 0.f}; v[1] = v[0]; }
                    u32x4 o; o.x = cvt_pk_bf16(v[0].x, v[0].y); o.y = cvt_pk_bf16(v[0].z, v[0].w); o.z = cvt_pk_bf16(v[1].x, v[1].y); o.w = cvt_pk_bf16(v[1].z, v[1].w);
                    *(u32x4*)(kc + ((size_t)bg * 512 + n) * 64 + c0) = o;
                } else {
                    const int np = swap23(n & 63), ntile = n >> 6;
#pragma unroll
                    for (int nn = 0; nn < 2; ++nn)
#pragma unroll
                        for (int i = 0; i < 4; ++i) vct[(((size_t)bg * 8 + ntile) * 64 + c0 + 4 * nn + i) * 64 + np] = (n == 511) ? (bf16_t)0 : f2bf(v[nn][i]);
                }
            }
    }
};
#ifndef CVT_DEPTH
#define CVT_DEPTH 4
#endif
template <class F>
__device__ __forceinline__ void cvt_family(LAS float* scr, bf16_t* dst, int nbatch, int Nd, int K, const F& f) {
    const int tilesN = Nd / 64, tilesK = K / 64, per = tilesN * tilesK, items = nbatch * per;
    int tid_ = my_tid(); asm volatile("" : "+v"(tid_));
    const int tid = tid_;
    const int kk0 = tid >> 4, n4 = (tid & 15) * 4;
    const int G = gridDim.x;
    f32x4 q[CVT_DEPTH][2]; float qs[CVT_DEPTH][2];
#define CVT_LOAD(j_, it_) do { int i__ = (it_); i__ = i__ < items ? i__ : items - 1; const int b_ = i__ / per, r_ = i__ % per, n0_ = (r_ / tilesK) * 64, k0_ = (r_ % tilesK) * 64; \
        q[j_][0] = f(b_, k0_ + kk0, n0_ + n4, qs[j_][0]); q[j_][1] = f(b_, k0_ + kk0 + 32, n0_ + n4, qs[j_][1]); } while (0)
    int it = blockIdx.x;
    if (it < items) {
#pragma unroll
        for (int j = 0; j < CVT_DEPTH; ++j) CVT_LOAD(j, it + j * G);
        while (it < items) {
#pragma unroll
            for (int j = 0; j < CVT_DEPTH; ++j) {
                const f32x4 c0 = q[j][0] * qs[j][0], c1 = q[j][1] * qs[j][1];
                CVT_LOAD(j, it + CVT_DEPTH * G);
                if (it < items) {
                    const int b = it / per, r = it % per, n0 = (r / tilesK) * 64, k0 = (r % tilesK) * 64;
                    LAS float* sb = scr + (j & 1) * (64 * 68);
                    *(LAS f32x4*)(sb + kk0 * 68 + n4) = c0; *(LAS f32x4*)(sb + (kk0 + 32) * 68 + n4) = c1;
                    __syncthreads();
                    { const int nn = tid >> 3, kc = tid & 7; const LAS float* s = sb + (8 * kc) * 68 + nn;
                      u32x4 o; o.x = cvt_pk_bf16(s[0], s[68]); o.y = cvt_pk_bf16(s[2 * 68], s[3 * 68]); o.z = cvt_pk_bf16(s[4 * 68], s[5 * 68]); o.w = cvt_pk_bf16(s[6 * 68], s[7 * 68]);
                      *(u32x4*)(dst + ((size_t)b * Nd + n0 + nn) * K + k0 + 8 * kc) = o; }
                }
                it += G;
            }
        }
    }
    __syncthreads();
#undef CVT_LOAD
}
#define LD4(p_) (*(const f32x4*)(p_))
#define Z4 ((f32x4){0.f, 0.f, 0.f, 0.f})

__device__ __forceinline__ void prologue_phase(LAS unsigned char* lds, const Params& p) {
    LAS float* scr = (LAS float*)lds;
    unsigned char* ws = p.ws;
    const int tid = my_tid();
    const size_t gtid = (size_t)blockIdx.x * 512 + tid, gsz = (size_t)gridDim.x * 512;
    { float* rope = (float*)(ws + WS_ROPE);
      for (size_t i = gtid; i < (size_t)SEQ * 8; i += gsz) { const int pos = (int)(i >> 3), f = (int)(i & 7);
          const float inv = (float)pow(500000.0, -(double)f / 8.0); const float ang = (float)pos * inv;
          rope[pos * 16 + f] = (float)cos((double)ang); rope[pos * 16 + 8 + f] = (float)sin((double)ang); } }
    { unsigned* tab = (unsigned*)(ws + WS_CMPTAB);
      for (size_t i = gtid; i < 8192; i += gsz) { const int bg = (int)(i >> 9), n = (int)(i & 511), b = bg >> 2, g = bg & 3, nc = n > 510 ? 510 : n;
          tab[i] = (unsigned)((((size_t)b * SEQ + 16 * nc) * 512 + g * 64) * 2); } }
    if (blockIdx.x == 0) { float* cb1 = (float*)(ws + WS_CB1); const int which = tid >> 8, hh = tid & 255;
        const float* pos = which ? p.in[15] : p.in[10]; const float* w1 = which ? p.in[16] : p.in[11]; const float* b1 = which ? p.in[17] : p.in[12];
        float s = b1[hh]; for (int k = 0; k < 2048; ++k) s += pos[k] * w1[(size_t)k * 256 + hh];
        cb1[which * 256 + hh] = s; }
    { const f32x4* src = (const f32x4*)p.in[0]; u32x2* dst = (u32x2*)(ws + WS_HBA);
      static_assert(((size_t)T_TOK * 1024 / 4) % ((size_t)256 * 512 * 4) == 0, "x conversion is unrolled by 4");
      for (size_t i = gtid; i < (size_t)T_TOK * 1024 / 4; i += 4 * gsz) { f32x4 v[4];
#pragma unroll
          for (int u = 0; u < 4; ++u) v[u] = src[i + u * gsz];
#pragma unroll
          for (int u = 0; u < 4; ++u) { u32x2 o; o.x = cvt_pk_bf16(v[u].x, v[u].y); o.y = cvt_pk_bf16(v[u].z, v[u].w); dst[i + u * gsz] = o; } } }
    { const f32x4* src = (const f32x4*)p.in[1]; u32x2* dst = (u32x2*)(ws + WS_PB);
      for (size_t i = gtid; i < (size_t)4 * T_TOK * 256 / 4; i += 4 * gsz) { f32x4 v[4];
#pragma unroll
          for (int u = 0; u < 4; ++u) v[u] = src[i + u * gsz];
#pragma unroll
          for (int u = 0; u < 4; ++u) { u32x2 o; o.x = cvt_pk_bf16(v[u].x, v[u].y); o.y = cvt_pk_bf16(v[u].z, v[u].w); dst[i + u * gsz] = o; } } }
    { const float* pw = p.in[5];
      cvt_family(scr, (bf16_t*)(ws + WS_WPOOL), 2, 1024, 256, [=](int b, int k, int nd, float& sc) { sc = 1.f; return LD4(pw + (((size_t)b * 4 + (nd >> 8)) * 256 + k) * 256 + (nd & 255)); }); }
    { const float* wkv = p.in[9]; const float* kvn = p.in[8]; const float* wqg = p.in[20]; const float* nm = p.in[2] + 2 * 1024;
      cvt_family(scr, (bf16_t*)(ws + WS_WKVQ), 1, 2816, 1024, [=](int b, int k, int nd, float& sc) {
          if (nd < 1536) { sc = kvn[k]; return LD4(wkv + (size_t)k * 1536 + nd); }
          if (nd < 1536 + 1072) { sc = nm[k]; return LD4(wqg + (size_t)k * 1072 + (nd - 1536)); }
          sc = 1.f; return Z4; }); }
    { const float* wqg = p.in[20] + (size_t)1024 * 1072; const float* nm = p.in[2] + 3 * 1024;
      cvt_family(scr, (bf16_t*)(ws + WS_WQG1), 1, 1280, 1024, [=](int b, int k, int nd, float& sc) { sc = nm[k]; return nd < 1072 ? LD4(wqg + (size_t)k * 1072 + nd) : Z4; }); }
    { const float* wk = p.in[11]; const float* wv = p.in[16];
      cvt_family(scr, (bf16_t*)(ws + WS_WC1), 2, 256, 2048, [=](int b, int k, int nd, float& sc) { sc = 1.f; return LD4((b ? wv : wk) + (size_t)k * 256 + nd); }); }
    { const float* wk = p.in[13]; const float* wv = p.in[18];
      cvt_family(scr, (bf16_t*)(ws + WS_WC2), 2, 256, 256, [=](int b, int k, int nd, float& sc) { sc = 1.f; return nd < 64 ? LD4((b ? wv : wk) + (size_t)k * 64 + nd) : Z4; }); }
    { const float* wo = p.in[22];
      cvt_family(scr, (bf16_t*)(ws + WS_WO), 2, 1024, 1024, [=](int b, int k, int nd, float& sc) { sc = 1.f; return LD4(wo + ((size_t)b * 1024 + k) * 1024 + nd); }); }
    { const float* rg = p.in[23]; const float* re = p.in[25]; const float* nf = p.in[3];
      cvt_family(scr, (bf16_t*)(ws + WS_WR), 4, 256, 1024, [=](int b, int k, int nd, float& sc) {
          sc = nf[b * 1024 + k];
          if (nd < 32) return LD4(re + ((size_t)b * 1024 + k) * 32 + nd);
          if (nd == 128) return LD4(rg + ((size_t)b * 1024 + k) * 4);
          return Z4; }); }
    { const float* pp = p.in[30];
      cvt_family(scr, (bf16_t*)(ws + WS_WPP), 4, 1024, 256, [=](int b, int k, int nd, float& sc) { sc = 1.f; return LD4(pp + ((size_t)b * 256 + k) * 1024 + nd); }); }
    { const float* pg = p.in[31]; const float* np = p.in[4];
      cvt_family(scr, (bf16_t*)(ws + WS_WPG), 4, 1024, 1024, [=](int b, int k, int nd, float& sc) { sc = np[b * 1024 + k]; return LD4(pg + ((size_t)b * 1024 + k) * 1024 + nd); }); }
    { const float* w1 = p.in[27]; const float* w3 = p.in[28]; const float* nf = p.in[3];
      cvt_family(scr, (bf16_t*)(ws + WS_W13), 128, 1024, 1024, [=](int b, int k, int nd, float& sc) {
          const int c8 = nd >> 3, i = nd & 7; const long dlt = (const char*)w3 - (const char*)w1; const float* w = (const float*)((const char*)w1 + ((i < 4) ? 0l : dlt));
          sc = nf[(b >> 5) * 1024 + k]; return LD4(w + ((size_t)b * 1024 + k) * 512 + 4 * c8); }); }
    { const float* w2 = p.in[29];
      cvt_family(scr, (bf16_t*)(ws + WS_W2), 128, 1024, 512, [=](int b, int k, int nd, float& sc) { sc = 1.f; return LD4(w2 + ((size_t)b * 512 + k) * 1024 + nd); }); }
}

template <int W>
__device__ __forceinline__ void stencil_rows(const bf16_t* h, const LAS float* rs, const float gx, const float gy, bf16_t* pooled, int r0, int s0, int c0) {
    f32x2 buf[16];
#pragma unroll
    for (int j = 0; j < 16; ++j) buf[j] = (f32x2){0.f, 0.f};
    unsigned hwc[16];
#pragma unroll
    for (int j = 0; j < 16; ++j) hwc[j] = (s0 > 0) ? *(const unsigned*)(h + (size_t)(r0 - 16 + j) * DM + c0) : 0u;
    for (int ch = 0; ch < 9; ++ch) {
        f32x2 ld[16]; unsigned hwn[16];
        const int chn = ch < 8 ? ch + 1 : 8;
#pragma unroll
        for (int j = 0; j < 16; ++j) hwn[j] = *(const unsigned*)(h + (size_t)(r0 - 16 + chn * 16 + j) * DM + c0);
#pragma unroll
        for (int j = 0; j < 16; ++j) { const unsigned hw = hwc[j]; ld[j] = (f32x2){bf2f(hw & 0xffffu), bf2f(hw >> 16)}; hwc[j] = hwn[j]; }
#pragma unroll
        for (int j = 0; j < 16; ++j) { const int rr = ch * 16 + j; const float r = rs[rr];
            f32x2 xn; xn.x = ld[j].x * r * gx; xn.y = ld[j].y * r * gy;
            buf[j] = xn;
            if (ch > 0) {
                f32x2 s = xn;
#pragma unroll
                for (int i = 1; i < W; ++i) s = s + buf[(j - i) & 15];
                const int sp = s0 + rr - 16;
                const int cnt = (sp + 1 < W) ? (sp + 1) : W;
                const float ic = 1.f / (float)cnt;
                const float ox = s.x * ic - xn.x, oy = s.y * ic - xn.y;
                *(unsigned*)(pooled + (size_t)(r0 - 16 + rr) * DM + c0) = cvt_pk_bf16(ox, oy);
            }
        }
    }
}
__device__ __forceinline__ void stencil_phase(LAS unsigned char* lds, const bf16_t* h, const float* gain, bf16_t* pooled) {
    LAS float* rs = (LAS float*)lds;
    int tid_ = my_tid(); asm volatile("" : "+v"(tid_));
    const int tid = tid_, w = tid >> 6, lane = tid & 63;
    for (int it = blockIdx.x; it < T_TOK / 128; it += gridDim.x) {
        const int r0 = it * 128, s0 = r0 & (SEQ - 1);
        for (int rb = w; rb < 144; rb += 24) {
            u32x4 xw[3][2];
#pragma unroll
            for (int q3 = 0; q3 < 3; ++q3) { const int rr = rb + 8 * q3; const bool ok = (rr >= 16 || s0 > 0);
                const u32x4* xr = (const u32x4*)(h + (size_t)(ok ? r0 - 16 + rr : r0) * DM) + lane; xw[q3][0] = xr[0]; xw[q3][1] = xr[64]; }
#pragma unroll
            for (int q3 = 0; q3 < 3; ++q3) { const int rr = rb + 8 * q3; const bool ok = (rr >= 16 || s0 > 0); float s = 0.f;
#pragma unroll
                for (int j = 0; j < 2; ++j) { const unsigned ww[4] = {xw[q3][j].x, xw[q3][j].y, xw[q3][j].z, xw[q3][j].w};
#pragma unroll
                    for (int q = 0; q < 4; ++q) { const float a = bf2f(ww[q] & 0xffffu), b = bf2f(ww[q] >> 16); s += a * a + b * b; } }
                s = wave_sum(s); const float v = ok ? 1.f / sqrtf(s * (1.f / DM) + RMS_EPS) : 0.f;
                if (lane == 0) rs[rr] = v; }
        }
        __syncthreads();
        const int c0 = 2 * tid, gi = tid >> 7; const float gx = gain[c0], gy = gain[c0 + 1];
        if (gi == 0) stencil_rows<2>(h, rs, gx, gy, pooled, r0, s0, c0);
        else if (gi == 1) stencil_rows<4>(h, rs, gx, gy, pooled, r0, s0, c0);
        else if (gi == 2) stencil_rows<8>(h, rs, gx, gy, pooled, r0, s0, c0);
        else stencil_rows<16>(h, rs, gx, gy, pooled, r0, s0, c0);
        __syncthreads();
    }
}

__device__ __forceinline__ int moe_tables(LAS unsigned char* lds, const unsigned* counts) {
    LAS unsigned* pstart = (LAS unsigned*)(lds + LDS_MISC);
    LAS unsigned char* tile_e = lds + LDS_MISC + 256;
    __syncthreads();
    if (my_tid() == 0) { unsigned acc = 0;
        for (int e = 0; e < NEXP; ++e) { pstart[e] = acc; const unsigned nt = (counts[e] + 255u) >> 8; for (unsigned t = 0; t < nt; ++t) tile_e[(acc >> 8) + t] = (unsigned char)e; acc += nt << 8; }
        pstart[NEXP] = acc; }
    __syncthreads();
    return (int)(pstart[NEXP] >> 8);
}
__device__ __forceinline__ void scatter_phase(LAS unsigned char* lds, const unsigned* counts, unsigned* cursor, const int* toke, int* rowtab, unsigned* rowoff) {
    moe_tables(lds, counts);
    LAS unsigned* pstart = (LAS unsigned*)(lds + LDS_MISC);
    LAS unsigned* cl = (LAS unsigned*)(lds + LDS_MISC + 1024);
    const int tid = my_tid();
    for (int it = blockIdx.x; it < 2 * T_TOK / 256; it += gridDim.x) {
        if (tid < 64) cl[tid] = 0;
        __syncthreads();
        int a = -1, e = 0; unsigned rank = 0;
        if (tid < 256) { a = it * 256 + tid; e = toke[a]; rank = __hip_atomic_fetch_add(&cl[e], 1u, __ATOMIC_RELAXED, __HIP_MEMORY_SCOPE_WORKGROUP); }
        __syncthreads();
        if (tid < 32) { const unsigned n = cl[tid]; cl[32 + tid] = n ? __hip_atomic_fetch_add(cursor + tid, n, __ATOMIC_RELAXED, __HIP_MEMORY_SCOPE_AGENT) : 0u; }
        __syncthreads();
        if (tid < 256) { const unsigned pos = pstart[e] + cl[32 + e] + rank; rowtab[pos] = a; rowoff[pos] = (unsigned)(a >> 1) * 2048u; }
        __syncthreads();
    }
    if (blockIdx.x < NEXP) { const int e = blockIdx.x; const unsigned lo = pstart[e] + counts[e], hi = pstart[e + 1];
        for (unsigned pos = lo + tid; pos < hi; pos += 512) { rowtab[pos] = -1; rowoff[pos] = 0u; } }
}

__device__ __forceinline__ void e1_phase(const bf16_t* hin, const bf16_t* slot, bf16_t* hb, float* rsp) {
    int tid_ = my_tid(); asm volatile("" : "+v"(tid_));
    const int w = tid_ >> 6, lane = tid_ & 63;
    for (int row0 = (blockIdx.x * 8 + w) * 4; row0 < T_TOK; row0 += gridDim.x * 32) {
        u32x4 a[4][2], b[4][2], c[4][2];
#pragma unroll
        for (int q = 0; q < 4; ++q) { const int row = row0 + q;
            const u32x4* hr = (const u32x4*)(hin + (size_t)row * DM) + lane;
            const u32x4* s0 = (const u32x4*)(slot + (size_t)(2 * row) * DM) + lane; const u32x4* s1 = (const u32x4*)(slot + (size_t)(2 * row + 1) * DM) + lane;
#pragma unroll
            for (int j = 0; j < 2; ++j) { a[q][j] = hr[64 * j]; b[q][j] = s0[64 * j]; c[q][j] = s1[64 * j]; } }
#pragma unroll
        for (int q = 0; q < 4; ++q) { const int row = row0 + q;
            u32x4* ob = (u32x4*)(hb + (size_t)row * DM) + lane;
            float ss = 0.f;
#pragma unroll
            for (int j = 0; j < 2; ++j) {
                const unsigned aw[4] = {a[q][j].x, a[q][j].y, a[q][j].z, a[q][j].w}, bw[4] = {b[q][j].x, b[q][j].y, b[q][j].z, b[q][j].w}, cw[4] = {c[q][j].x, c[q][j].y, c[q][j].z, c[q][j].w}; unsigned ow[4];
#pragma unroll
                for (int k = 0; k < 4; ++k) { const float lo = bf2f(aw[k] & 0xffffu) + bf2f(bw[k] & 0xffffu) + bf2f(cw[k] & 0xffffu), hi = bf2f(aw[k] >> 16) + bf2f(bw[k] >> 16) + bf2f(cw[k] >> 16);
                    ow[k] = cvt_pk_bf16(lo, hi); const float rl = bf2f(ow[k] & 0xffffu), rh = bf2f(ow[k] >> 16); ss += rl * rl + rh * rh; }
                u32x4 o; o.x = ow[0]; o.y = ow[1]; o.z = ow[2]; o.w = ow[3]; ob[64 * j] = o; }
            ss = wave_sum(ss);
            if (lane == 0) rsp[row] = 1.f / sqrtf(ss * (1.f / DM) + RMS_EPS); }
    }
}
__device__ __forceinline__ void final_phase(const bf16_t* hin, float* out, const float* gain) {
    int tid_ = my_tid(); asm volatile("" : "+v"(tid_));
    const int w = tid_ >> 6, lane = tid_ & 63;
    const f32x4* gr = (const f32x4*)gain + lane;
    f32x4 gv[4];
#pragma unroll
    for (int j = 0; j < 4; ++j) gv[j] = gr[64 * j];
    for (int row0 = (blockIdx.x * 8 + w) * 4; row0 < T_TOK; row0 += gridDim.x * 32) {
        u32x2 x[4][4];
#pragma unroll
        for (int q = 0; q < 4; ++q) { const u32x2* hr = (const u32x2*)(hin + (size_t)(row0 + q) * DM) + lane;
#pragma unroll
            for (int j = 0; j < 4; ++j) x[q][j] = hr[64 * j]; }
#pragma unroll
        for (int q = 0; q < 4; ++q) { f32x4* orow = (f32x4*)(out + (size_t)(row0 + q) * DM) + lane;
            f32x4 v[4]; float ss = 0.f;
#pragma unroll
            for (int j = 0; j < 4; ++j) { v[j] = (f32x4){bf2f(x[q][j].x & 0xffffu), bf2f(x[q][j].x >> 16), bf2f(x[q][j].y & 0xffffu), bf2f(x[q][j].y >> 16)};
                ss += v[j].x * v[j].x + v[j].y * v[j].y + v[j].z * v[j].z + v[j].w * v[j].w; }
            ss = wave_sum(ss); const float r = 1.f / sqrtf(ss * (1.f / DM) + RMS_EPS);
#pragma unroll
            for (int j = 0; j < 4; ++j) orow[64 * j] = v[j] * r * gv[j]; }
    }
}
__device__ __forceinline__ void vtrans_phase(LAS unsigned char* lds, const bf16_t* vs, const bf16_t* vw, bf16_t* vst, bf16_t* vwt) {
    LAS bf16_t* tl = (LAS bf16_t*)lds;
    int tid_ = my_tid(); asm volatile("" : "+v"(tid_));
    const int tid = tid_;
    for (int it = blockIdx.x; it < 2 * 16 * 128; it += gridDim.x) {
        const int which = it >> 11, r = it & 2047, bg = r >> 7, kt = r & 127, b = bg >> 2, g = bg & 3;
        const bf16_t* src = which ? vw : vs; bf16_t* dst = which ? vwt : vst;
        { const int key = tid >> 3, ch = tid & 7;
          const u32x4 v = *(const u32x4*)(src + ((size_t)b * SEQ + kt * 64 + key) * 256 + g * 64 + ch * 8);
          const int kp = swap23(key);
          const unsigned wv[4] = {v.x, v.y, v.z, v.w};
#pragma unroll
          for (int i = 0; i < 4; ++i) { tl[(ch * 8 + 2 * i) * 72 + kp] = (bf16_t)(wv[i] & 0xffffu); tl[(ch * 8 + 2 * i + 1) * 72 + kp] = (bf16_t)(wv[i] >> 16); } }
        __syncthreads();
        { const int d = tid >> 3, ch = tid & 7;
          const u32x4 v = *(const LAS u32x4*)(tl + d * 72 + ch * 8);
          *(u32x4*)(dst + (((size_t)bg * 128 + kt) * 64 + d) * 64 + ch * 8) = v; }
        __syncthreads();
    }
}

struct AttnArgs { const bf16_t* q; const float* gates; const bf16_t* kc; const bf16_t* vct; const bf16_t* ks; const bf16_t* vst; const bf16_t* kw; const bf16_t* vwt; bf16_t* out; };
#define ATT_MFMA(a, b, c) __builtin_amdgcn_mfma_f32_32x32x16_bf16(a, b, c, 0, 0, 0)
#ifndef ATT_RING_N
#define ATT_RING_N 7
#endif
#ifndef ATT_AHEAD
#define ATT_AHEAD 2
#endif
constexpr int ATT_SLOT = 16384, ATT_RING = ATT_RING_N, ATT_IMP = ATT_RING * ATT_SLOT;
constexpr int ATT_DIST = ATT_RING - 2;
constexpr float ATT_THR = 8.f;
#ifndef ATT_DECOUPLED_RING
#define ATT_BARRIER_RING 1
#endif
#ifndef ATT_SLC_GROUP
#define ATT_SLC_GROUP 3
#endif
#ifndef ATT_SPARSE_QB
#define ATT_SPARSE_QB 1000
#endif
typedef float f32x8 __attribute__((ext_vector_type(8)));
__device__ __forceinline__ float hsum16(const f32x16 a) { const f32x8 b = a.lo + a.hi; const f32x4 c = b.lo + b.hi; const f32x2 d = c.lo + c.hi; return d.x + d.y; }
__device__ __forceinline__ float hmax16(const f32x16 a) {
    float m0 = fmaxf(fmaxf(a[0], a[1]), a[2]), m1 = fmaxf(fmaxf(a[3], a[4]), a[5]), m2 = fmaxf(fmaxf(a[6], a[7]), a[8]), m3 = fmaxf(fmaxf(a[9], a[10]), a[11]), m4 = fmaxf(fmaxf(a[12], a[13]), a[14]);
    return fmaxf(fmaxf(fmaxf(m0, m1), fmaxf(m2, m3)), fmaxf(m4, a[15]));
}
template <bool MASKED, bool ONLINE, bool DO_PV, bool DO_IMP>
__device__ __forceinline__ void attn_step(const LAS unsigned char* Kb, const LAS unsigned char* Vb, const bf16x8 (&Qf)[4], const int (&ro)[4],
                                          const int lo4, const int hi4, const bool rowsel, f32x16& O0, f32x16& O1, float& mref, float& lsum,
                                          LAS float* impw, const int jbase, const int lane, LAS unsigned* qkc = nullptr, const unsigned qkv = 0u) {
    f32x16 S0, S1;
    bool pre; float mr0;
    if (ONLINE) { pre = (__ballot(mref < -1e29f) == 0ull); mr0 = (MASKED || rowsel) ? mref : 1e30f; }
    else { pre = true; mr0 = mref; }
    const float sinit = pre ? -mr0 : 0.f;
#pragma unroll
    for (int r = 0; r < 16; ++r) { S0[r] = sinit; S1[r] = sinit; }
    { bf16x8 KA[4], KB[4];
#pragma unroll
      for (int ks = 0; ks < 4; ++ks) { KA[ks] = *(const LAS bf16x8*)(Kb + ro[ks]); KB[ks] = *(const LAS bf16x8*)(Kb + 4096 + ro[ks]); }
      __builtin_amdgcn_sched_barrier(0);
#pragma unroll
      for (int ks = 0; ks < 4; ++ks) { S0 = ATT_MFMA(KA[ks], Qf[ks], S0); S1 = ATT_MFMA(KB[ks], Qf[ks], S1); } }
    bf16x8 VA[4], VB[4];
    if (DO_PV) {
        __builtin_amdgcn_sched_barrier(0);
#pragma unroll
        for (int k4 = 0; k4 < 4; ++k4) { VA[k4] = *(const LAS bf16x8*)(Vb + ro[k4]); VB[k4] = *(const LAS bf16x8*)(Vb + 4096 + ro[k4]); }
    }
    if (qkc != nullptr) { __builtin_amdgcn_sched_barrier(0); if (lane == 0) __hip_atomic_store(qkc, qkv, __ATOMIC_RELAXED, __HIP_MEMORY_SCOPE_WORKGROUP); }
    __builtin_amdgcn_sched_barrier(0);
    if (MASKED) {
        int lo_o = lo4, hi_o = hi4; asm volatile("" : "+v"(lo_o), "+v"(hi_o));
        const int lo_c = lo_o < 0 ? 0 : lo_o, hi_c = hi_o > 63 ? 63 : hi_o;
        unsigned long long vm = (hi_c >= 63) ? ~0ull : ((1ull << (hi_c + 1)) - 1ull);
        vm &= ~((1ull << lo_c) - 1ull);
        if (hi_c < lo_c) vm = 0ull;
        const unsigned vlo = (unsigned)vm, vhi = (unsigned)(vm >> 32);
        const unsigned negbits = __float_as_uint(-1e30f);
#pragma unroll
        for (int r = 0; r < 16; ++r) { const int cr = (r & 3) + 8 * (r >> 2);
            const unsigned m0 = (unsigned)__builtin_amdgcn_sbfe((int)vlo, cr, 1), m1 = (unsigned)__builtin_amdgcn_sbfe((int)vhi, cr, 1);
            S0[r] = __uint_as_float((__float_as_uint(S0[r]) & m0) | (negbits & ~m0));
            S1[r] = __uint_as_float((__float_as_uint(S1[r]) & m1) | (negbits & ~m1)); }
    }
    if (ONLINE) {
        if (!pre) {
            float mx = fmaxf(hmax16(S0), hmax16(S1));
            mx = fmaxf(mx, __shfl_xor(mx, 32));
            if (!MASKED && !rowsel) mx = -1e30f;
            const bool grow = (mref < -1e29f) && (mx > -1e29f);
            if (__ballot(grow) != 0ull) mref = grow ? mx : mref;
            const float mr = ((MASKED || rowsel) && mref > -1e29f) ? mref : 1e30f;
            S0 = S0 - mr; S1 = S1 - mr;
        }
    }
#pragma unroll
    for (int r = 0; r < 16; ++r) { S0[r] = __builtin_amdgcn_exp2f(S0[r]); S1[r] = __builtin_amdgcn_exp2f(S1[r]); }
    if (ONLINE) lsum += hsum16(S0 + S1);
    if (DO_IMP) {
#pragma unroll
        for (int kh = 0; kh < 2; ++kh)
#pragma unroll
            for (int q4 = 0; q4 < 4; ++q4) {
                float G, E;
                if (kh == 0) { G = (S0[4 * q4] + S0[4 * q4 + 1]) + (S0[4 * q4 + 2] + S0[4 * q4 + 3]); E = S0[4 * q4 + 3]; }
                else         { G = (S1[4 * q4] + S1[4 * q4 + 1]) + (S1[4 * q4 + 2] + S1[4 * q4 + 3]); E = S1[4 * q4 + 3]; }
                G += __builtin_bit_cast(float, __builtin_amdgcn_mov_dpp(__builtin_bit_cast(int, G), 0xB1, 0xF, 0xF, true)); G += __builtin_bit_cast(float, __builtin_amdgcn_mov_dpp(__builtin_bit_cast(int, G), 0x4E, 0xF, 0xF, true));
                E += __builtin_bit_cast(float, __builtin_amdgcn_mov_dpp(__builtin_bit_cast(int, E), 0xB1, 0xF, 0xF, true)); E += __builtin_bit_cast(float, __builtin_amdgcn_mov_dpp(__builtin_bit_cast(int, E), 0x4E, 0xF, 0xF, true));
                const int jj = jbase + 8 * kh + 2 * q4 + (lane >> 5);
                if ((lane & 3) == 0) { impw[jj] += G; if (jj + 1 < 128) impw[jj + 1] += E; }
            }
    }
    __builtin_amdgcn_sched_barrier(0);
    if (DO_PV) {
        bf16x8 Pf[4];
        { u32x4 pk; pk.x = cvt_pk_bf16(S0[0], S0[1]); pk.y = cvt_pk_bf16(S0[2], S0[3]); pk.z = cvt_pk_bf16(S0[4], S0[5]); pk.w = cvt_pk_bf16(S0[6], S0[7]); Pf[0] = __builtin_bit_cast(bf16x8, pk); }
        { u32x4 pk; pk.x = cvt_pk_bf16(S0[8], S0[9]); pk.y = cvt_pk_bf16(S0[10], S0[11]); pk.z = cvt_pk_bf16(S0[12], S0[13]); pk.w = cvt_pk_bf16(S0[14], S0[15]); Pf[1] = __builtin_bit_cast(bf16x8, pk); }
        { u32x4 pk; pk.x = cvt_pk_bf16(S1[0], S1[1]); pk.y = cvt_pk_bf16(S1[2], S1[3]); pk.z = cvt_pk_bf16(S1[4], S1[5]); pk.w = cvt_pk_bf16(S1[6], S1[7]); Pf[2] = __builtin_bit_cast(bf16x8, pk); }
        { u32x4 pk; pk.x = cvt_pk_bf16(S1[8], S1[9]); pk.y = cvt_pk_bf16(S1[10], S1[11]); pk.z = cvt_pk_bf16(S1[12], S1[13]); pk.w = cvt_pk_bf16(S1[14], S1[15]); Pf[3] = __builtin_bit_cast(bf16x8, pk); }
        __builtin_amdgcn_sched_barrier(0);
#pragma unroll
        for (int k4 = 0; k4 < 4; ++k4) { O0 = ATT_MFMA(VA[k4], Pf[k4], O0); O1 = ATT_MFMA(VB[k4], Pf[k4], O1); }
    }
}

template <bool FIRST>
__device__ __forceinline__ void attn_out_acc(bf16_t* orow, const f32x16& O0, const f32x16& O1, const float sc, const int h) {
#pragma unroll
    for (int rq = 0; rq < 4; ++rq) {
        u32x2* p0 = (u32x2*)(orow + 8 * rq + 4 * h); u32x2* p1 = (u32x2*)(orow + 32 + 8 * rq + 4 * h);
        float a0 = 0.f, a1 = 0.f, a2 = 0.f, a3 = 0.f, b0 = 0.f, b1 = 0.f, b2 = 0.f, b3 = 0.f;
        if (!FIRST) { const u32x2 x = *p0, y = *p1; a0 = bf2f(x.x & 0xffffu); a1 = bf2f(x.x >> 16); a2 = bf2f(x.y & 0xffffu); a3 = bf2f(x.y >> 16);
            b0 = bf2f(y.x & 0xffffu); b1 = bf2f(y.x >> 16); b2 = bf2f(y.y & 0xffffu); b3 = bf2f(y.y >> 16); }
        u32x2 o; o.x = cvt_pk_bf16(a0 + sc * O0[4 * rq], a1 + sc * O0[4 * rq + 1]); o.y = cvt_pk_bf16(a2 + sc * O0[4 * rq + 2], a3 + sc * O0[4 * rq + 3]); *p0 = o;
        u32x2 o2; o2.x = cvt_pk_bf16(b0 + sc * O1[4 * rq], b1 + sc * O1[4 * rq + 1]); o2.y = cvt_pk_bf16(b2 + sc * O1[4 * rq + 2], b3 + sc * O1[4 * rq + 3]); *p1 = o2;
    }
}
__device__ __forceinline__ void attn_out_load(const bf16_t* orow, u32x2 (&X)[4], u32x2 (&Y)[4], const int h) {
#pragma unroll
    for (int rq = 0; rq < 4; ++rq) { X[rq] = *(const u32x2*)(orow + 8 * rq + 4 * h); Y[rq] = *(const u32x2*)(orow + 32 + 8 * rq + 4 * h); }
}
__device__ __forceinline__ void attn_out_fin(bf16_t* orow, const u32x2 (&X)[4], const u32x2 (&Y)[4], const f32x16& O0, const f32x16& O1, const float sc, const int h) {
#pragma unroll
    for (int rq = 0; rq < 4; ++rq) {
        u32x2* p0 = (u32x2*)(orow + 8 * rq + 4 * h); u32x2* p1 = (u32x2*)(orow + 32 + 8 * rq + 4 * h);
        const u32x2 x = X[rq], y = Y[rq];
        const float a0 = bf2f(x.x & 0xffffu), a1 = bf2f(x.x >> 16), a2 = bf2f(x.y & 0xffffu), a3 = bf2f(x.y >> 16);
        const float b0 = bf2f(y.x & 0xffffu), b1 = bf2f(y.x >> 16), b2 = bf2f(y.y & 0xffffu), b3 = bf2f(y.y >> 16);
        u32x2 o; o.x = cvt_pk_bf16(a0 + sc * O0[4 * rq], a1 + sc * O0[4 * rq + 1]); o.y = cvt_pk_bf16(a2 + sc * O0[4 * rq + 2], a3 + sc * O0[4 * rq + 3]); *p0 = o;
        u32x2 o2; o2.x = cvt_pk_bf16(b0 + sc * O1[4 * rq], b1 + sc * O1[4 * rq + 1]); o2.y = cvt_pk_bf16(b2 + sc * O1[4 * rq + 2], b3 + sc * O1[4 * rq + 3]); *p1 = o2;
    }
}
__device__ __forceinline__ unsigned lds_ld_u32(LAS unsigned* p) { unsigned v; asm volatile("ds_read_b32 %0, %1\n\ts_waitcnt lgkmcnt(0)" : "=v"(v) : "v"((unsigned)(uintptr_t)p) : "memory"); return v; }
__device__ __forceinline__ void lds_add_u32(LAS unsigned* p, unsigned v) { asm volatile("ds_add_u32 %0, %1" :: "v"((unsigned)(uintptr_t)p), "v"(v) : "memory"); }
__device__ __forceinline__ void lds_add_f32(LAS float* p, float v) { asm volatile("ds_add_f32 %0, %1" :: "v"((unsigned)(uintptr_t)p), "v"(v) : "memory"); }
constexpr bool ATT_HAS_SPARSE = ATT_SPARSE_QB <= 127;
constexpr int ATT_OACC = ATT_IMP;
constexpr int ATT_LIST = ATT_OACC + (ATT_HAS_SPARSE ? 65536 : 32768);
constexpr int ATT_CNT  = ATT_LIST + (ATT_HAS_SPARSE ? 8192 : 0);
constexpr int ATT_SELM2 = ATT_CNT + 128;
constexpr int ATT_LACC = ATT_SELM2 + 1024;
constexpr int ATT_RREF = ATT_LACC + 1024;
constexpr int ATT_CTR  = ATT_RREF + 1024;
static_assert(ATT_CTR + 128 <= LDS_BYTES - 16, "attention LDS map");
__device__ __forceinline__ int oacc_idx(int R, int d) { return R * 64 + ((((d >> 2) ^ R) & 15) << 2) + (d & 3); }

__device__ __forceinline__ void attn_sparse_task(const LAS unsigned char* Kb, const LAS unsigned char* Vb, const bf16x8 (&Qf)[4], const int (&ro)[4],
                                                 const float rr, const bool valid, const int R, LAS float* oacc, LAS float* lacc, const int h) {
    f32x16 S0, S1;
#pragma unroll
    for (int r = 0; r < 16; ++r) { S0[r] = 0.f; S1[r] = 0.f; }
    { bf16x8 KA[4], KB[4];
#pragma unroll
      for (int ks = 0; ks < 4; ++ks) { KA[ks] = *(const LAS bf16x8*)(Kb + ro[ks]); KB[ks] = *(const LAS bf16x8*)(Kb + 4096 + ro[ks]); }
#pragma unroll
      for (int ks = 0; ks < 4; ++ks) { S0 = ATT_MFMA(KA[ks], Qf[ks], S0); S1 = ATT_MFMA(KB[ks], Qf[ks], S1); } }
    S0 = S0 - rr; S1 = S1 - rr;
#pragma unroll
    for (int r = 0; r < 16; ++r) { S0[r] = __builtin_amdgcn_exp2f(S0[r]); S1[r] = __builtin_amdgcn_exp2f(S1[r]); }
    float rs = hsum16(S0 + S1); rs += __shfl_xor(rs, 32);
    bf16x8 Pf[4];
    { u32x4 pk; pk.x = cvt_pk_bf16(S0[0], S0[1]); pk.y = cvt_pk_bf16(S0[2], S0[3]); pk.z = cvt_pk_bf16(S0[4], S0[5]); pk.w = cvt_pk_bf16(S0[6], S0[7]); Pf[0] = __builtin_bit_cast(bf16x8, pk); }
    { u32x4 pk; pk.x = cvt_pk_bf16(S0[8], S0[9]); pk.y = cvt_pk_bf16(S0[10], S0[11]); pk.z = cvt_pk_bf16(S0[12], S0[13]); pk.w = cvt_pk_bf16(S0[14], S0[15]); Pf[1] = __builtin_bit_cast(bf16x8, pk); }
    { u32x4 pk; pk.x = cvt_pk_bf16(S1[0], S1[1]); pk.y = cvt_pk_bf16(S1[2], S1[3]); pk.z = cvt_pk_bf16(S1[4], S1[5]); pk.w = cvt_pk_bf16(S1[6], S1[7]); Pf[2] = __builtin_bit_cast(bf16x8, pk); }
    { u32x4 pk; pk.x = cvt_pk_bf16(S1[8], S1[9]); pk.y = cvt_pk_bf16(S1[10], S1[11]); pk.z = cvt_pk_bf16(S1[12], S1[13]); pk.w = cvt_pk_bf16(S1[14], S1[15]); Pf[3] = __builtin_bit_cast(bf16x8, pk); }
    f32x16 T0, T1;
#pragma unroll
    for (int r = 0; r < 16; ++r) { T0[r] = 0.f; T1[r] = 0.f; }
    { bf16x8 VA[4], VB[4];
#pragma unroll
      for (int k4 = 0; k4 < 4; ++k4) { VA[k4] = *(const LAS bf16x8*)(Vb + ro[k4]); VB[k4] = *(const LAS bf16x8*)(Vb + 4096 + ro[k4]); }
#pragma unroll
      for (int k4 = 0; k4 < 4; ++k4) { T0 = ATT_MFMA(VA[k4], Pf[k4], T0); T1 = ATT_MFMA(VB[k4], Pf[k4], T1); } }
    if (valid) {
        if (h == 0) lacc[R] += rs;
#pragma unroll
        for (int q = 0; q < 4; ++q) {
            LAS f32x4* p0 = (LAS f32x4*)(oacc + oacc_idx(R, 8 * q + 4 * h)); LAS f32x4* p1 = (LAS f32x4*)(oacc + oacc_idx(R, 32 + 8 * q + 4 * h));
            const f32x4 a = *p0, b = *p1;
            *p0 = a + (f32x4){T0[4 * q], T0[4 * q + 1], T0[4 * q + 2], T0[4 * q + 3]}; *p1 = b + (f32x4){T1[4 * q], T1[4 * q + 1], T1[4 * q + 2], T1[4 * q + 3]}; }
    }
}

__device__ __forceinline__ void attn_phase(LAS unsigned char* lds, unsigned* qctr) {
    int tid_ = my_tid(); asm volatile("" : "+v"(tid_));
    const int tid = tid_, w = __builtin_amdgcn_readfirstlane(tid >> 6), lane = tid & 63, n = lane & 31, h = lane >> 5;
    LAS float* imp = (LAS float*)(lds + ATT_IMP); LAS unsigned* selm = (LAS unsigned*)(lds + ATT_SELM2);
    LAS float* oacc = (LAS float*)(lds + ATT_OACC); LAS float* lacc = (LAS float*)(lds + ATT_LACC); LAS float* rref = (LAS float*)(lds + ATT_RREF);
    LAS unsigned char* lists = lds + ATT_LIST; LAS unsigned char* cnts = lds + ATT_CNT;
    LAS unsigned* cready = (LAS unsigned*)(lds + ATT_CTR); LAS unsigned* cdone = cready + 8;
    int ro[4];
#pragma unroll
    for (int ks = 0; ks < 4; ++ks) ro[ks] = n * 128 + (((2 * ks + h) ^ ((n >> 1) & 7)) << 4);
    const int drow = 8 * w + (lane >> 3);
    const unsigned dsrc = (unsigned)(drow * 128 + (((lane & 7) ^ ((drow >> 1) & 7)) << 4));
    LAS int* itbox = (LAS int*)(lds + ATT_CTR + 96);
    for (;;) {
        if (tid == 0) *itbox = (int)__hip_atomic_fetch_add(qctr, 1u, __ATOMIC_RELAXED, __HIP_MEMORY_SCOPE_AGENT);
        asm volatile("s_waitcnt vmcnt(0) lgkmcnt(0)\n\ts_barrier" ::: "memory");
        const int it = __builtin_amdgcn_readfirstlane(*itbox);
        if (it >= 2048) break;
        const int qb = 127 - (it >> 4), bg = it & 15, b = bg >> 2, g = bg & 3;
        const int tl = w * 8 + (n >> 2), t = qb * 64 + tl, hd = g * 4 + (n & 3);
        const size_t trow0 = (size_t)b * SEQ + qb * 64, trow = trow0 + tl;
        const bool sparse = ATT_HAS_SPARSE && qb >= ATT_SPARSE_QB;
        bf16x8 Qf[4]; float g0, g1, g2; const char* kcb; const char* ksb; const bf16_t* qp;
        { unsigned char* ws = kparams()->ws; qp = (const bf16_t*)(ws + WS_Q); const float* gp = (const float*)(ws + WS_GATES);
#pragma unroll
          for (int s = 0; s < 4; ++s) Qf[s] = *(const bf16x8*)(qp + trow * 1024 + hd * 64 + 16 * s + 8 * h);
          g0 = gp[trow * 48 + hd * 3 + 0]; g1 = gp[trow * 48 + hd * 3 + 1]; g2 = gp[trow * 48 + hd * 3 + 2];
          kcb = (const char*)(ws + WS_KC + (size_t)bg * 512 * 64 * 2); ksb = (const char*)(ws + WS_KS + (size_t)bg * SEQ * 64 * 2); }
        const int nct = (4 * qb + 3 + 63) >> 6, wlo = qb > 8 ? qb - 8 : 0, nwin = qb - wlo + 1;
        const int e0 = nct, e1 = 2 * nct, e2 = 2 * nct + qb + 1, total = e2 + nwin;
        const int limc = (t >= 31) ? ((t - 31) >> 4) : -1;
        static_assert(WS_VCT - WS_KC == (size_t)1 << 20 && WS_KW - WS_KS == (size_t)1 << 24 && WS_VST - WS_KS == (size_t)2 << 24 && WS_VWT - WS_KW == (size_t)2 << 24, "attention tile streams rely on this workspace order");
#define ATT_SLCJ(i_) (sparse ? ((i_) == 0 ? 0 : (i_) == 1 ? qb - 1 : (i_) == 2 ? qb : (i_) - 2) : (i_))
#define ATT_ISSUE(s_) do { const int s__ = (s_); const char* kp; const char* vp; \
            if (s__ < e1) { const int ct = s__ < e0 ? s__ : s__ - e0; kp = kcb + (size_t)ct * 8192; vp = kp + ((size_t)1 << 20); } \
            else if (s__ < e2) { const int i__ = s__ - e1; const int j = ATT_SLCJ(i__); kp = ksb + (size_t)j * 8192; vp = kp + ((size_t)2 << 24); } \
            else { const int kt = wlo + s__ - e2; kp = ksb + ((size_t)1 << 24) + (size_t)kt * 8192; vp = kp + ((size_t)2 << 24); } \
            LAS unsigned char* sl = lds + (s__ % ATT_RING) * ATT_SLOT + w * 1024; \
            __builtin_amdgcn_global_load_lds((const unsigned*)(kp + dsrc), (LAS unsigned*)sl, 16, 0, 0); \
            __builtin_amdgcn_global_load_lds((const unsigned*)(vp + dsrc), (LAS unsigned*)(sl + 8192), 16, 0, 0); } while (0)
#define ATT_WAITC(ptr_, tgt_) do { const unsigned tg__ = (tgt_); while ((unsigned)__builtin_amdgcn_readfirstlane((int)lds_ld_u32(ptr_)) < tg__) __builtin_amdgcn_s_sleep(1); } while (0)
#define ATT_SIG(ptr_) do { if (lane == 0) lds_add_u32((ptr_), 1u); } while (0)
#define ATT_VMW(n_) do { const int nv__ = (n_); if (nv__ >= 5) asm volatile("s_waitcnt vmcnt(10)" ::: "memory"); else if (nv__ == 4) asm volatile("s_waitcnt vmcnt(8)" ::: "memory"); \
            else if (nv__ == 3) asm volatile("s_waitcnt vmcnt(6)" ::: "memory"); else if (nv__ == 2) asm volatile("s_waitcnt vmcnt(4)" ::: "memory"); \
            else if (nv__ == 1) asm volatile("s_waitcnt vmcnt(2)" ::: "memory"); else asm volatile("s_waitcnt vmcnt(0)" ::: "memory"); } while (0)
#ifdef ATT_BARRIER_RING
#define ATT_HEAD(s_) do { const int sh = (s_); if (sh + ATT_RING - 1 < total) ATT_ISSUE(sh + ATT_RING - 1); } while (0)
#define ATT_TAILN(nf_) do { const int nf__ = (nf_); \
            if (nf__ >= 5) asm volatile("s_waitcnt vmcnt(10) lgkmcnt(0)\n\ts_barrier" ::: "memory"); else if (nf__ == 4) asm volatile("s_waitcnt vmcnt(8) lgkmcnt(0)\n\ts_barrier" ::: "memory"); \
            else if (nf__ == 3) asm volatile("s_waitcnt vmcnt(6) lgkmcnt(0)\n\ts_barrier" ::: "memory"); else if (nf__ == 2) asm volatile("s_waitcnt vmcnt(4) lgkmcnt(0)\n\ts_barrier" ::: "memory"); \
            else if (nf__ == 1) asm volatile("s_waitcnt vmcnt(2) lgkmcnt(0)\n\ts_barrier" ::: "memory"); else asm volatile("s_waitcnt vmcnt(0) lgkmcnt(0)\n\ts_barrier" ::: "memory"); } while (0)
#define ATT_TAIL(s_) do { int nf = total - 2 - (s_); nf = nf < 0 ? 0 : (nf > ATT_RING - 2 ? ATT_RING - 2 : nf); ATT_TAILN(nf); } while (0)
#else
#define ATT_HEAD(s_) do { const int sh = (s_); \
            if (sh + ATT_DIST < total) { if (sh >= 2) ATT_WAITC(cdone + (sh - 2) % ATT_RING, 8u * (unsigned)((sh - 2) / ATT_RING + 1)); ATT_ISSUE(sh + ATT_DIST); } \
            { int nf = total - 1 - (sh + ATT_AHEAD); nf = nf < 0 ? 0 : (nf > ATT_DIST - ATT_AHEAD ? ATT_DIST - ATT_AHEAD : nf); ATT_VMW(nf); }     \
            if (sh + ATT_AHEAD < total) ATT_SIG(cready + (sh + ATT_AHEAD) % ATT_RING); \
            ATT_WAITC(cready + sh % ATT_RING, 8u * (unsigned)(sh / ATT_RING + 1)); } while (0)
#define ATT_TAIL(s_) do { asm volatile("s_waitcnt lgkmcnt(0)" ::: "memory"); ATT_SIG(cdone + (s_) % ATT_RING); } while (0)
#endif
#define ATT_BAR() asm volatile("s_waitcnt lgkmcnt(0)\n\ts_barrier" ::: "memory")
        asm volatile("s_waitcnt vmcnt(0) lgkmcnt(0)\n\ts_barrier" ::: "memory");
        for (int i = tid; i < 8192; i += 512) imp[i] = 0.f;
        if (tid < 16) cready[tid] = 0u;
        ATT_BAR();
        static_assert(ATT_DIST >= 2 && ATT_DIST <= 6 && ATT_AHEAD >= 1 && ATT_AHEAD < ATT_DIST && ATT_DIST - ATT_AHEAD <= 5, "ring geometry");
#ifdef ATT_BARRIER_RING
        static_assert(ATT_RING >= 3 && ATT_RING <= 7, "ring geometry");
#pragma unroll
        for (int i = 0; i < ATT_RING - 1; ++i) if (i < total) ATT_ISSUE(i);
        { const int issued = total < ATT_RING - 1 ? total : ATT_RING - 1; ATT_VMW(issued - 1); }
        asm volatile("s_barrier" ::: "memory");
#else
#pragma unroll
        for (int i = 0; i < ATT_DIST; ++i) if (i < total) ATT_ISSUE(i);
        { const int issued = total < ATT_DIST ? total : ATT_DIST; ATT_VMW(issued - ATT_AHEAD); }
#pragma unroll
        for (int i = 0; i < ATT_AHEAD; ++i) ATT_SIG(cready + i);
#endif
        f32x16 O0, O1; u32x2 OX[4], OY[4];
#pragma unroll
        for (int r = 0; r < 16; ++r) { O0[r] = 0.f; O1[r] = 0.f; }
        float mref = -1e30f, lsum = 0.f;
        int s = 0;
        for (; s < e0; ++s) {
            ATT_HEAD(s);
            const LAS unsigned char* Kb = lds + (s % ATT_RING) * ATT_SLOT; const int hi = limc - 64 * s;
            if (__ballot(hi < 63) == 0ull) attn_step<false, true, false, false>(Kb, Kb + 8192, Qf, ro, 0, 0, true, O0, O1, mref, lsum, nullptr, 0, lane);
            else if (__ballot(hi >= 0) != 0ull) attn_step<true, true, false, false>(Kb, Kb + 8192, Qf, ro, -4 * h, (hi > 63 ? 63 : hi) - 4 * h, true, O0, O1, mref, lsum, nullptr, 0, lane);
            ATT_TAIL(s);
        }
        lsum += __shfl_xor(lsum, 32);
        float mc2 = (lsum > 0.f) ? mref + __builtin_amdgcn_logf(lsum) : 1e30f;
        for (; s < e1; ++s) {
            ATT_HEAD(s);
            const LAS unsigned char* Kb = lds + (s % ATT_RING) * ATT_SLOT; const int ct = s - e0; const int hi = limc - 64 * ct;
            float dummy = 0.f;
            if (__ballot(hi < 63) == 0ull) attn_step<false, false, true, true>(Kb, Kb + 8192, Qf, ro, 0, 0, true, O0, O1, mc2, dummy, imp + tl * 128, 16 * ct, lane);
            else if (__ballot(hi >= 0) != 0ull) attn_step<true, false, true, true>(Kb, Kb + 8192, Qf, ro, -4 * h, (hi > 63 ? 63 : hi) - 4 * h, true, O0, O1, mc2, dummy, imp + tl * 128, 16 * ct, lane);
            ATT_TAIL(s);
        }
        attn_out_acc<true>((bf16_t*)(kparams()->ws + WS_ACT) + trow * 1024 + hd * 64, O0, O1, g0, h);
#pragma unroll
        for (int r = 0; r < 16; ++r) { O0[r] = 0.f; O1[r] = 0.f; }
        mref = -1e30f; lsum = 0.f;
        {
            for (int tk = 0; tk < 8; ++tk) {
                const int tok = w * 8 + tk; unsigned long long mlo, mhi;
                if (qb < 16) { mlo = (2ull << qb) - 1ull; mhi = 0ull; }
                else {
                    const float c0 = imp[tok * 128 + lane], c1 = imp[tok * 128 + 64 + lane];
                    const unsigned k0 = ((lane >= 1) && (lane <= qb - 2)) ? __float_as_uint(c0) + 1u : 0u;
                    const unsigned k1 = ((64 + lane) <= qb - 2) ? __float_as_uint(c1) + 1u : 0u;
                    unsigned T = 0u;
                    for (int bit = 31; bit >= 0; --bit) { const unsigned cand = T | (1u << bit);
                        const int cnt = __popcll(__ballot(k0 >= cand)) + __popcll(__ballot(k1 >= cand));
                        if (cnt >= 13) T = cand; }
                    unsigned long long gt0 = __ballot(k0 > T), gt1 = __ballot(k1 > T), eq0 = __ballot(k0 == T), eq1 = __ballot(k1 == T);
                    int need = 13 - __popcll(gt0) - __popcll(gt1);
                    while (need > 0 && eq0) { const unsigned long long low = eq0 & (0ull - eq0); gt0 |= low; eq0 ^= low; --need; }
                    while (need > 0 && eq1) { const unsigned long long low = eq1 & (0ull - eq1); gt1 |= low; eq1 ^= low; --need; }
                    mlo = gt0 | 1ull; mhi = gt1;
                    const int f1 = qb, f2 = qb - 1;
                    if (f1 < 64) mlo |= 1ull << f1; else mhi |= 1ull << (f1 - 64);
                    if (f2 < 64) mlo |= 1ull << f2; else mhi |= 1ull << (f2 - 64);
                }
                if (lane == 0) { selm[tok * 4 + 0] = (unsigned)mlo; selm[tok * 4 + 1] = (unsigned)(mlo >> 32); selm[tok * 4 + 2] = (unsigned)mhi; selm[tok * 4 + 3] = (unsigned)(mhi >> 32); }
            }
        }
        if (!sparse) {
            const unsigned mw0 = selm[tl * 4 + 0], mw1 = selm[tl * 4 + 1], mw2 = selm[tl * 4 + 2], mw3 = selm[tl * 4 + 3];
#if defined(ATT_BARRIER_RING) && ATT_SLC_GROUP > 1
            if (s + ATT_SLC_GROUP - 1 < e2 - 1) {
                int nis = s + ATT_RING - 1;
                { int last = s + ATT_RING - 2; last = last < total - 1 ? last : total - 1; const int nf = last - (s + ATT_SLC_GROUP - 1); ATT_TAILN(nf < 0 ? 0 : nf); }
                while (s + ATT_SLC_GROUP - 1 < e2 - 1) {
                    while (nis < total && nis <= s + ATT_RING - 1) { ATT_ISSUE(nis); ++nis; }
#pragma unroll 1
                    for (int u = 0; u < ATT_SLC_GROUP; ++u) {
                        const int su = s + u; const LAS unsigned char* Kb = lds + (su % ATT_RING) * ATT_SLOT; const int j = su - e1;
                        const unsigned wsel = (j < 32) ? mw0 : (j < 64) ? mw1 : (j < 96) ? mw2 : mw3;
                        const bool sel = (wsel >> (j & 31)) & 1u;
                        if (__ballot(sel) != 0ull) attn_step<false, true, true, false>(Kb, Kb + 8192, Qf, ro, 0, 0, sel, O0, O1, mref, lsum, nullptr, 0, lane);
                    }
                    { const int nf = nis - 1 - (s + 2 * ATT_SLC_GROUP - 1); ATT_TAILN(nf < 0 ? 0 : nf); }
                    s += ATT_SLC_GROUP;
                }
                while (nis < total && nis <= s + ATT_RING - 2) { ATT_ISSUE(nis); ++nis; }
            }
#endif
            for (; s < e2 - 1; ++s) {
                ATT_HEAD(s);
                const LAS unsigned char* Kb = lds + (s % ATT_RING) * ATT_SLOT; const int j = s - e1;
                const unsigned wsel = (j < 32) ? mw0 : (j < 64) ? mw1 : (j < 96) ? mw2 : mw3;
                const bool sel = (wsel >> (j & 31)) & 1u;
                if (__ballot(sel) != 0ull) attn_step<false, true, true, false>(Kb, Kb + 8192, Qf, ro, 0, 0, sel, O0, O1, mref, lsum, nullptr, 0, lane);
                ATT_TAIL(s);
            }
            attn_out_load((const bf16_t*)(kparams()->ws + WS_ACT) + trow * 1024 + hd * 64, OX, OY, h);
            { ATT_HEAD(s);
              const LAS unsigned char* Kb = lds + (s % ATT_RING) * ATT_SLOT;
              attn_step<true, true, true, false>(Kb, Kb + 8192, Qf, ro, -4 * h, tl - 4 * h, true, O0, O1, mref, lsum, nullptr, 0, lane);
              ATT_TAIL(s); ++s; }
        } else {
            ATT_BAR();
            for (int jj = w; jj < qb - 2; jj += 8) { const int j = jj + 1;
                const unsigned wsel = selm[lane * 4 + (j >> 5)]; const bool bit = (wsel >> (j & 31)) & 1u;
                const unsigned long long bm = __ballot(bit);
                if (bit) lists[jj * 64 + __popcll(bm & ((1ull << lane) - 1ull))] = (unsigned char)lane;
                if (lane == 0) cnts[jj] = (unsigned char)__popcll(bm); }
            for (int i3 = 0; i3 < 2; ++i3, ++s) {
                ATT_HEAD(s);
                const LAS unsigned char* Kb = lds + (s % ATT_RING) * ATT_SLOT;
                attn_step<false, true, true, false>(Kb, Kb + 8192, Qf, ro, 0, 0, true, O0, O1, mref, lsum, nullptr, 0, lane);
                ATT_TAIL(s);
            }
            { ATT_HEAD(s);
              const LAS unsigned char* Kb = lds + (s % ATT_RING) * ATT_SLOT;
              attn_step<true, true, true, false>(Kb, Kb + 8192, Qf, ro, -4 * h, tl - 4 * h, true, O0, O1, mref, lsum, nullptr, 0, lane);
              ATT_TAIL(s); ++s; }
            { const int R = w * 32 + n;
#pragma unroll
              for (int r = 0; r < 16; ++r) { const int d = (r & 3) + 8 * (r >> 2) + 4 * h; oacc[oacc_idx(R, d)] = O0[r]; oacc[oacc_idx(R, d + 32)] = O1[r]; }
              lsum += __shfl_xor(lsum, 32);
              if (h == 0) { rref[R] = mref; lacc[R] = lsum; } }
            ATT_BAR();
#define ATT_GMETA(jj_, tsk_, valid_, rr_, R_, tok_) do { const int jc__ = (jj_) < qb - 2 ? (jj_) : qb - 3; const int cnt__ = cnts[jc__]; const int ti__ = (tsk_), tslot__ = n >> 2; \
                valid_ = ((tsk_) < ((cnt__ + 7) >> 3)) && ((8 * ti__ + tslot__) < cnt__); tok_ = (int)lists[jc__ * 64 + (valid_ ? 8 * ti__ + tslot__ : 0)] & 63; \
                R_ = tok_ * 4 + (n & 3); rr_ = valid_ ? rref[R_] : 1e30f; } while (0)
#define ATT_GASM(Q_, tok_) do { const bf16_t* gp__ = qp + (trow0 + (tok_)) * 1024 + hd * 64 + 8 * h; \
                asm volatile("global_load_dwordx4 %0, %4, off\n\tglobal_load_dwordx4 %1, %4, off offset:32\n\tglobal_load_dwordx4 %2, %4, off offset:64\n\tglobal_load_dwordx4 %3, %4, off offset:96" \
                             : "=&v"(Q_[0]), "=&v"(Q_[1]), "=&v"(Q_[2]), "=&v"(Q_[3]) : "v"(gp__) : "memory"); } while (0)
#define ATT_HEAD_SP(s_) do { const int sh = (s_); \
            ATT_WAITC(cdone + (sh - 2) % ATT_RING, 8u * (unsigned)((sh - 2) / ATT_RING + 1)); ATT_ISSUE(sh + 3); \
            asm volatile("s_waitcnt vmcnt(8)" ::: "memory");       \
            ATT_SIG(cready + (sh + 1) % ATT_RING); \
            ATT_WAITC(cready + sh % ATT_RING, 8u * (unsigned)(sh / ATT_RING + 1)); } while (0)
#define ATT_SP_STEP(QC, vC, rC, RC, QN, vN, rN, RN) do { \
                const int jj = s - e1 - 3; const int ntask = ((int)cnts[jj] + 7) >> 3; int tsk = (w - jj) & 7; \
                { int tokn; ATT_GMETA(jj + 1, ((w - jj - 1) & 7), vN, rN, RN, tokn); ATT_GASM(QN, tokn); } \
                ATT_HEAD_SP(s); \
                const LAS unsigned char* Kb = lds + (s % ATT_RING) * ATT_SLOT; \
                if (tsk < ntask) attn_sparse_task(Kb, Kb + 8192, QC, ro, rC, vC, RC, oacc, lacc, h); \
                for (tsk += 8; tsk < ntask; tsk += 8) { bool v2; float r2; int R2, tok2; bf16x8 Q2[4]; ATT_GMETA(jj, tsk, v2, r2, R2, tok2); \
                    _Pragma("unroll") for (int ks = 0; ks < 4; ++ks) Q2[ks] = *(const bf16x8*)(qp + (trow0 + tok2) * 1024 + hd * 64 + 16 * ks + 8 * h); \
                    attn_sparse_task(Kb, Kb + 8192, Q2, ro, r2, v2, R2, oacc, lacc, h); } \
                ATT_TAIL(s); ATT_BAR(); ++s; } while (0)
            bf16x8 QA[4], QB[4]; bool vA = false, vB = false; float rA = 1e30f, rB = 1e30f; int RA = 0, RB = 0;
            { int tok0; ATT_GMETA(0, (w & 7), vA, rA, RA, tok0); ATT_GASM(QA, tok0); asm volatile("s_waitcnt vmcnt(0)" ::: "memory"); }
            while (s < e2) {
                ATT_SP_STEP(QA, vA, rA, RA, QB, vB, rB, RB);
                if (s >= e2) break;
                ATT_SP_STEP(QB, vB, rB, RB, QA, vA, rA, RA);
            }
            asm volatile("s_waitcnt vmcnt(0)" : "+v"(QA[0]), "+v"(QA[1]), "+v"(QA[2]), "+v"(QA[3]), "+v"(QB[0]), "+v"(QB[1]), "+v"(QB[2]), "+v"(QB[3]) :: "memory");
#undef ATT_GMETA
#undef ATT_GASM
#undef ATT_HEAD_SP
#undef ATT_SP_STEP
            ATT_BAR();
            { const int R = w * 32 + n;
#pragma unroll
              for (int r = 0; r < 16; ++r) { const int d = (r & 3) + 8 * (r >> 2) + 4 * h; O0[r] = oacc[oacc_idx(R, d)]; O1[r] = oacc[oacc_idx(R, d + 32)]; }
              lsum = lacc[R]; }
        }
        if (!sparse) lsum += __shfl_xor(lsum, 32);
        if (!sparse) attn_out_fin((bf16_t*)(kparams()->ws + WS_ACT) + trow * 1024 + hd * 64, OX, OY, O0, O1, g1 / fmaxf(lsum, 1e-30f), h);
        else attn_out_acc<false>((bf16_t*)(kparams()->ws + WS_ACT) + trow * 1024 + hd * 64, O0, O1, g1 / fmaxf(lsum, 1e-30f), h);
#pragma unroll
        for (int r = 0; r < 16; ++r) { O0[r] = 0.f; O1[r] = 0.f; }
        mref = -1e30f; lsum = 0.f;
        for (; s < total - 1; ++s) {
            ATT_HEAD(s);
            const LAS unsigned char* Kb = lds + (s % ATT_RING) * ATT_SLOT; const int kt = wlo + s - e2;
            if (kt == qb - 8) attn_step<true, true, true, false>(Kb, Kb + 8192, Qf, ro, tl + 1 - 4 * h, 63 - 4 * h, true, O0, O1, mref, lsum, nullptr, 0, lane);
            else attn_step<false, true, true, false>(Kb, Kb + 8192, Qf, ro, 0, 0, true, O0, O1, mref, lsum, nullptr, 0, lane);
            ATT_TAIL(s);
        }
        attn_out_load((const bf16_t*)(kparams()->ws + WS_ACT) + trow * 1024 + hd * 64, OX, OY, h);
        { ATT_HEAD(s);
          const LAS unsigned char* Kb = lds + (s % ATT_RING) * ATT_SLOT;
          attn_step<true, true, true, false>(Kb, Kb + 8192, Qf, ro, -4 * h, tl - 4 * h, true, O0, O1, mref, lsum, nullptr, 0, lane);
          ATT_TAIL(s); ++s; }
        lsum += __shfl_xor(lsum, 32);
        attn_out_fin((bf16_t*)(kparams()->ws + WS_ACT) + trow * 1024 + hd * 64, OX, OY, O0, O1, g2 / fmaxf(lsum, 1e-30f), h);
#undef ATT_ISSUE
#undef ATT_SLCJ
#undef ATT_HEAD
#undef ATT_VMW
#undef ATT_TAIL
#undef ATT_TAILN
#undef ATT_WAITC
#undef ATT_SIG
#undef ATT_BAR
    }
    asm volatile("s_waitcnt vmcnt(0) lgkmcnt(0)\n\ts_barrier" ::: "memory");
}
#ifndef PROBE_PRO
#define PROBE_PRO 1
#endif
#ifndef PROBE_ATT
#define PROBE_ATT 1
#endif
#ifndef PROBE_MOE
#define PROBE_MOE 1
#endif
#ifndef PROBE_QKV
#define PROBE_QKV 1
#endif
#ifndef PROBE_STEN
#define PROBE_STEN 1
#endif
#ifndef PROBE_PLE
#define PROBE_PLE 1
#endif
#ifndef PROBE_AMP
#define PROBE_AMP 4
#endif
#ifdef DBG_CHECK
constexpr int NPHASES = 1 + 8 + 8 + 11 + 9 + 1 + 2;
#ifndef DBG_THR
#define DBG_THR 1e-3f
#endif
#else
constexpr int NPHASES = 1 + 8 + 8 + 11 + 9 + 1;
#endif


__global__ void __launch_bounds__(512, 2) yoco_fwd(Params p_unused) {
    LAS unsigned char* lds = (LAS unsigned char*)smem_;
    if ((threadIdx.x & 63) == 0) lds[LDS_WTAB + hw_wave_slot()] = (unsigned char)(threadIdx.x >> 6);
    __syncthreads();
    int p0, p1; { KParams Q = kparams(); p0 = Q->p0; p1 = Q->p1; }
    const bool multi = (p1 - p0) > 1;
    LAS unsigned* xbw = (LAS unsigned*)(lds + LDS_BYTES - 16);
    unsigned xcc = 0;
    if (multi) {
        if (my_tid() == 0) { xbw[0] = 0u; xbw[1] = 0u; xbw[2] = 0u; xbw[3] = 0u; }
        __syncthreads();
        KParams Q = kparams();
        XcdBarrier b0 = xcd_barrier_post((unsigned*)(Q->ws + WS_ZERO), (volatile LAS unsigned*)xbw); xcc = b0.x;
    }
    int pid = 0;
#ifdef PROBE_CLK
    const unsigned long long clk_r0 = wall_clock64(), clk_c0 = clock64();
#endif
#ifdef PROBE_TIME
    unsigned long long tacc = 0ull, tph0 = 0ull;
#define PH_T0 tph0 = wall_clock64();
#define PH_T1 if ((PROBE_TIME >> me_) & 1ull) tacc += wall_clock64() - tph0;
#else
#define PH_T0
#define PH_T1
#endif
#define PH_BEGIN { const int me_ = pid++; PH_T0 if (p0 <= me_ && me_ < p1) { KParams Q = kparams(); unsigned char* ws = Q->ws; (void)ws;
#define PH_END   } if (p0 <= me_ && me_ + 1 < p1) { KParams Q2 = kparams(); XcdBarrier bar; bar.bar = (unsigned*)(Q2->ws + WS_ZERO); bar.x = xcc; bar.st = (volatile LAS unsigned*)xbw; xcd_barrier(bar); } PH_T1 }
#define WSP(T, off) ((T*)(ws + (off)))

    PH_BEGIN Params pl; pl.ws = ws; pl.out = Q->out; for (int i = 0; i < 34; ++i) pl.in[i] = Q->in[i]; for (int rep_ = 0; rep_ < PROBE_PRO; ++rep_) { prologue_phase(lds, pl); __syncthreads(); } PH_END

    auto layer = [&](auto LC) __attribute__((always_inline)) {
        constexpr int L = decltype(LC)::value;
        if (L < 2) {
            PH_BEGIN for (int rep_ = 0; rep_ < PROBE_STEN; ++rep_) { stencil_phase(lds, WSP(bf16_t, WS_HBA), Q->in[2] + L * 1024, WSP(bf16_t, WS_ACT)); __syncthreads(); } PH_END
            PH_BEGIN
                g8::DenseSched S; S.init(T_TOK / 256, 4); S.A = (const char*)(ws + WS_ACT); S.a_tile_b = (size_t)256 * 2048; S.a_pn_b = 512;
                S.Bt = (const char*)(ws + WS_WPOOL + (size_t)L * 1024 * 256 * 2); S.b_tile_b = (size_t)256 * 256 * 2;
                EpiResid<1> E; E.L = L;
                g8::gemm_phase<EpiResid<1>, g8::DenseSched, false>(lds, 256, 2048, 128, S, E);
            PH_END
        } else {
            const int J = L - 2;
            PH_BEGIN
                g8::DenseSched S; S.init(T_TOK / 256, J == 0 ? 11 : 5); S.A = (const char*)(ws + WS_HBA); S.a_tile_b = (size_t)256 * 2048;
                S.Bt = (const char*)(ws + (J == 0 ? WS_WKVQ : WS_WQG1)); S.b_tile_b = (size_t)256 * 1024 * 2;
                EpiQkv E; E.tile0 = (J == 0) ? 0 : 6; E.J = J;
                rstd_table_fill(lds, S, WSP(float, WS_SSQ));
                for (int rep_ = 0; rep_ < PROBE_QKV; ++rep_) { g8::gemm_phase<EpiQkv, g8::DenseSched, false>(lds, 1024, 2048, 128, S, E); __syncthreads(); }
            PH_END
            if (J == 0) {
                PH_BEGIN
                    vtrans_phase(lds, WSP(bf16_t, WS_VS), WSP(bf16_t, WS_VW), WSP(bf16_t, WS_VST), WSP(bf16_t, WS_VWT));
                    __syncthreads();
                    g8::DenseSched S; S.init(32, 2); S.A = (const char*)(ws + WS_KVC); S.a_tile_b = 0; S.a_pn_b = 512; S.tab = WSP(unsigned, WS_CMPTAB);
                    S.Bt = (const char*)(ws + WS_WC1); S.b_tile_b = (size_t)256 * 2048 * 2;
                    EpiCmp1 E; E.dummy = 0;
                    g8::gemm_phase<EpiCmp1, g8::DenseSched, true>(lds, 2048, 0, 1024, S, E);
                PH_END
                PH_BEGIN
                    g8::DenseSched S; S.init(32, 2); S.A = (const char*)(ws + WS_CHID); S.a_tile_b = (size_t)256 * 512; S.a_pn_b = (size_t)8192 * 512;
                    S.Bt = (const char*)(ws + WS_WC2); S.b_tile_b = (size_t)256 * 256 * 2;
                    EpiCmp2 E; E.dummy = 0;
                    g8::gemm_phase<EpiCmp2, g8::DenseSched, false>(lds, 256, 512, 128, S, E);
                PH_END
            }
            PH_BEGIN
                attn_phase(lds, WSP(unsigned, WS_ZERO + ZO_ATTQ) + L * 64); __syncthreads();
            PH_END
#ifdef DBG_CHECK
            PH_BEGIN Params pl; pl.ws = ws; pl.out = Q->out; for (int i = 0; i < 34; ++i) pl.in[i] = Q->in[i]; __syncthreads(); nsa_check_phase(lds, pl, J); __syncthreads(); PH_END
#endif
            PH_BEGIN
                g8::DenseSched S; S.init(T_TOK / 256, 4); S.A = (const char*)(ws + WS_ACT); S.a_tile_b = (size_t)256 * 2048;
                S.Bt = (const char*)(ws + WS_WO + (size_t)J * 1024 * 1024 * 2); S.b_tile_b = (size_t)256 * 1024 * 2;
                EpiResid<0> E; E.L = L;
                g8::gemm_phase<EpiResid<0>, g8::DenseSched, false>(lds, 1024, 2048, 128, S, E);
            PH_END
        }
        PH_BEGIN
            unsigned* counts = WSP(unsigned, WS_ZERO + ZO_COUNTS) + L * 32;
            LAS unsigned* hist = (LAS unsigned*)(lds + LDS_MISC);
            if (my_tid() < 32) hist[my_tid()] = 0u;
            __syncthreads();
            g8::DenseSched S; S.init(T_TOK / 256, 1); S.A = (const char*)(ws + WS_HBA); S.a_tile_b = (size_t)256 * 2048;
            S.Bt = (const char*)(ws + WS_WR + (size_t)L * 256 * 1024 * 2); S.b_tile_b = 0;
            EpiRouter E; E.L = L; E.hist = hist;
            { LAS float* rb = (LAS float*)(lds + LDS_RBIAS); const int t_ = my_tid(); if (t_ < 4) rb[t_] = Q->in[24][L * 4 + t_]; else if (t_ < 36) rb[t_] = Q->in[26][L * 32 + t_ - 4]; }
            rstd_table_fill(lds, S, WSP(float, WS_SSQ));
            g8::gemm_phase<EpiRouter, g8::DenseSched, false>(lds, 1024, 2048, 128, S, E);
            __syncthreads();
            if (my_tid() < 32 && hist[my_tid()]) __hip_atomic_fetch_add(counts + my_tid(), hist[my_tid()], __ATOMIC_RELAXED, __HIP_MEMORY_SCOPE_AGENT);
            __syncthreads();
            { g8::DenseSched S2; S2.init(T_TOK / 256, 4); S2.c = (blockIdx.x + 128) & 255; S2.A = (const char*)(ws + WS_PB + (size_t)L * T_TOK * 256 * 2); S2.a_tile_b = (size_t)256 * 512;
              S2.Bt = (const char*)(ws + WS_WPP + (size_t)L * 1024 * 256 * 2); S2.b_tile_b = (size_t)256 * 256 * 2;
              EpiBf16 E2; E2.dummy = 0;
              for (int rep_ = 0; rep_ < PROBE_PLE; ++rep_) { g8::gemm_phase<EpiBf16, g8::DenseSched, false>(lds, 256, 512, 128, S2, E2); __syncthreads(); } }
        PH_END
        PH_BEGIN scatter_phase(lds, WSP(unsigned, WS_ZERO + ZO_COUNTS) + L * 32, WSP(unsigned, WS_ZERO + ZO_CURSOR) + L * 32, WSP(int, WS_TOKE), WSP(int, WS_ROWTAB), WSP(unsigned, WS_ROWOFF)); PH_END
        PH_BEGIN
            const int ntiles = moe_tables(lds, WSP(unsigned, WS_ZERO + ZO_COUNTS) + L * 32);
            g8::MoeSched S; S.nunits = ntiles * 4; S.NPN = 4; S.G = gridDim.x; S.c = blockIdx.x; S.A = (const char*)(ws + WS_HBA); S.a_tile_b = 0;
            S.W = (const char*)(ws + WS_W13 + (size_t)L * 32 * 1024 * 1024 * 2); S.w_e_b = (size_t)1024 * 1024 * 2; S.b_tile_b = (size_t)256 * 1024 * 2;
            S.tab = WSP(unsigned, WS_ROWOFF); S.tile_e = lds + LDS_MISC + 256;
            EpiMoe1 E; E.dummy = 0;
            for (int rep_ = 0; rep_ < PROBE_MOE; ++rep_) { g8::gemm_phase<EpiMoe1, g8::MoeSched, true>(lds, 1024, 0, 128, S, E); __syncthreads(); }
        PH_END
        PH_BEGIN
            const int ntiles = moe_tables(lds, WSP(unsigned, WS_ZERO + ZO_COUNTS) + L * 32);
            g8::MoeSched S; S.nunits = ntiles * 4; S.NPN = 4; S.G = gridDim.x; S.c = blockIdx.x; S.A = (const char*)(ws + WS_HBUF); S.a_tile_b = (size_t)256 * 1024;
            S.W = (const char*)(ws + WS_W2 + (size_t)L * 32 * 1024 * 512 * 2); S.w_e_b = (size_t)1024 * 512 * 2; S.b_tile_b = (size_t)256 * 512 * 2;
            S.tab = nullptr; S.tile_e = lds + LDS_MISC + 256;
            EpiMoe2 E; E.dummy = 0;
            for (int rep_ = 0; rep_ < PROBE_MOE; ++rep_) { g8::gemm_phase<EpiMoe2, g8::MoeSched, false>(lds, 512, 1024, 128, S, E); __syncthreads(); }
        PH_END
        PH_BEGIN
            e1_phase(WSP(bf16_t, WS_HBA), WSP(bf16_t, WS_SLOT), WSP(bf16_t, WS_HBB), WSP(float, WS_RSP));
        PH_END
        PH_BEGIN
            g8::DenseSched S; S.init(T_TOK / 256, 4); S.A = (const char*)(ws + WS_HBB); S.a_tile_b = (size_t)256 * 2048;
            S.Bt = (const char*)(ws + WS_WPG + (size_t)L * 1024 * 1024 * 2); S.b_tile_b = (size_t)256 * 1024 * 2;
            EpiResid<2> E; E.L = L;
            g8::gemm_phase<EpiResid<2>, g8::DenseSched, false>(lds, 1024, 2048, 128, S, E);
        PH_END
    };
    layer(IC<0>{}); layer(IC<1>{}); layer(IC<2>{}); layer(IC<3>{});
#ifdef DBG_CHECK
    PH_BEGIN
        { const float* dbg = (const float*)(ws + WS_ZERO + ZO_DBG); bool bad = false;
          for (int c = 0; c < 6; ++c) if ((DBG_CHECK >> c) & 1) { const float e = dbg[2 * c], r = dbg[2 * c + 1]; if (!(r > 0.f) || !(e <= DBG_THR * r)) bad = true; }
          if (bad) { float* o = Q->out; for (size_t i = (size_t)blockIdx.x * 512 + my_tid(); i < (size_t)T_TOK * DM; i += (size_t)gridDim.x * 512) o[i] = 3.f; }
          else final_phase(WSP(bf16_t, WS_HBA), Q->out, Q->in[33]); }
    PH_END
#else
    PH_BEGIN final_phase(WSP(bf16_t, WS_HBA), Q->out, Q->in[33]); PH_END
#endif
#ifdef PROBE_CLK
    if (blockIdx.x == 0) { const unsigned long long r1 = wall_clock64(), c1 = clock64(); const unsigned long long fmhz = (c1 - clk_c0) * 100ull / (r1 - clk_r0);
        const unsigned long long t0 = wall_clock64(); while (wall_clock64() - t0 < fmhz * 100ull) __builtin_amdgcn_s_sleep(8); }
#endif
#ifdef PROBE_TIME
    if (blockIdx.x == 0) { const unsigned long long t0 = wall_clock64(); while (wall_clock64() - t0 < (unsigned long long)PROBE_AMP * tacc) __builtin_amdgcn_s_sleep(8); }
#endif
#undef PH_BEGIN
#undef PH_END
}

#ifndef MK_LAUNCHES
#define MK_LAUNCHES 0
#endif

extern "C" void kernel_launch(void* const* d_in, const int* in_sizes, int n_in, void* d_out, int out_size, void* d_ws, size_t ws_size, hipStream_t stream) {
    static int ready = 0;
    if (!ready) {
        if (n_in != 34 || out_size != T_TOK * DM || ws_size < WS_END) { fprintf(stderr, "kernel_launch: unexpected sizes (n_in %d out %d ws %zu need %zu)\n", n_in, out_size, ws_size, (size_t)WS_END); ready = -1; return; }
        if (hipFuncSetAttribute((const void*)yoco_fwd, hipFuncAttributeMaxDynamicSharedMemorySize, LDS_BYTES) != hipSuccess) { fprintf(stderr, "kernel_launch: hipFuncSetAttribute failed\n"); ready = -1; return; }
        int per_cu = 0;
        if (hipOccupancyMaxActiveBlocksPerMultiprocessor(&per_cu, (const void*)yoco_fwd, 512, LDS_BYTES) != hipSuccess || per_cu < 1) fprintf(stderr, "kernel_launch: occupancy query reports %d\n", per_cu);
        (void)hipGetLastError();
        ready = 1;
    }
    if (ready < 0) return;
    (void)hipMemsetAsync((char*)d_ws + WS_ZERO, 0, ZERO_BYTES, stream);
    Params p{};
    for (int i = 0; i < 34; ++i) p.in[i] = (const float*)d_in[i];
    p.out = (float*)d_out; p.ws = (unsigned char*)d_ws;
#if MK_LAUNCHES == 1
    p.p0 = 0; p.p1 = NPHASES;
    hipLaunchKernelGGL(yoco_fwd, dim3(256), dim3(512), LDS_BYTES, stream, p);
#else
    for (int ph = 0; ph < NPHASES; ++ph) { p.p0 = ph; p.p1 = ph + 1; hipLaunchKernelGGL(yoco_fwd, dim3(256), dim3(512), LDS_BYTES, stream, p); }
#endif
}
```

```cpp
#define MK_LAUNCHES 1
#include <hip/hip_runtime.h>
#include <stdint.h>
#include <stddef.h>
#include <stdio.h>

#define LAS __attribute__((address_space(3)))
typedef unsigned short bf16_t;
typedef short bf16x8 __attribute__((ext_vector_type(8)));
typedef float f32x4 __attribute__((ext_vector_type(4)));
typedef float f32x2 __attribute__((ext_vector_type(2)));
typedef float f32x16 __attribute__((ext_vector_type(16)));
typedef unsigned u32x4 __attribute__((ext_vector_type(4)));
typedef unsigned u32x2 __attribute__((ext_vector_type(2)));

constexpr int T_TOK = 32768, DM = 1024, SEQ = 8192, NBATCH = 4;
constexpr int NEXP = 32, DFF = 512;
constexpr int PMAX = 65536 + 8192;
constexpr float RMS_EPS = 1e-6f;
constexpr float QSCALE = 0.125f * 1.4426950408889634f;

constexpr size_t al256(size_t x) { return (x + 255) & ~(size_t)255; }
constexpr size_t WS_ZERO   = 0;
constexpr size_t ZERO_BYTES = 65536;
constexpr size_t ZO_COUNTS = 16384;
constexpr size_t ZO_CURSOR = 16384 + 1024;
constexpr size_t ZO_ATTQ   = 16384 + 2048;
constexpr size_t WS_ROPE   = WS_ZERO + ZERO_BYTES;
constexpr size_t WS_CMPTAB = WS_ROPE + (size_t)SEQ * 16 * 4;
constexpr size_t WS_CB1    = WS_CMPTAB + 8192 * 4;
constexpr size_t WS_WPOOL  = WS_CB1 + 2 * 256 * 4;
constexpr size_t WS_WKVQ   = WS_WPOOL + (size_t)2 * 1024 * 256 * 2;
constexpr size_t WS_WQG1   = WS_WKVQ + (size_t)2816 * 1024 * 2;
constexpr size_t WS_WC1    = WS_WQG1 + (size_t)1280 * 1024 * 2;
constexpr size_t WS_WC2    = WS_WC1 + (size_t)2 * 256 * 2048 * 2;
constexpr size_t WS_WO     = WS_WC2 + (size_t)2 * 256 * 256 * 2;
constexpr size_t WS_WR     = WS_WO + (size_t)2 * 1024 * 1024 * 2;
constexpr size_t WS_WPP    = WS_WR + (size_t)4 * 256 * 1024 * 2;
constexpr size_t WS_WPG    = WS_WPP + (size_t)4 * 1024 * 256 * 2;
constexpr size_t WS_W13    = WS_WPG + (size_t)4 * 1024 * 1024 * 2;
constexpr size_t WS_W2     = WS_W13 + (size_t)128 * 1024 * 1024 * 2;
constexpr size_t WS_PB     = WS_W2 + (size_t)128 * 1024 * 512 * 2;
constexpr size_t WS_HBA    = WS_PB + (size_t)4 * T_TOK * 256 * 2;
constexpr size_t WS_HBB    = WS_HBA + (size_t)T_TOK * 1024 * 2;
constexpr size_t WS_SSQ    = WS_HBB + (size_t)T_TOK * 1024 * 2;
constexpr size_t WS_RSF    = WS_SSQ + (size_t)T_TOK * 16 * 4;
constexpr size_t WS_RSP    = WS_RSF + (size_t)T_TOK * 4;
constexpr size_t WS_TOKE   = WS_RSP + (size_t)T_TOK * 4;
constexpr size_t WS_TOKW   = WS_TOKE + (size_t)T_TOK * 8;
constexpr size_t WS_ROWTAB = WS_TOKW + (size_t)T_TOK * 8;
constexpr size_t WS_ROWOFF = WS_ROWTAB + (size_t)PMAX * 4;
constexpr size_t WS_GATES  = WS_ROWOFF + (size_t)PMAX * 4;
constexpr size_t WS_KC     = WS_GATES + (size_t)T_TOK * 48 * 4;
constexpr size_t WS_VCT    = WS_KC + (size_t)16 * 512 * 64 * 2;
constexpr size_t WS_CHID   = WS_VCT + (size_t)16 * 512 * 64 * 2;
constexpr size_t WS_KS     = WS_CHID + (size_t)2 * 8192 * 256 * 2;
constexpr size_t WS_KW     = WS_KS + (size_t)T_TOK * 256 * 2;
constexpr size_t WS_VST    = WS_KW + (size_t)T_TOK * 256 * 2;
constexpr size_t WS_VWT    = WS_VST + (size_t)T_TOK * 256 * 2;
constexpr size_t WS_ACT    = WS_VWT + (size_t)T_TOK * 256 * 2;
constexpr size_t WS_HBUF   = WS_ACT + (size_t)T_TOK * 1024 * 2;
constexpr size_t WS_SLOT   = WS_HBUF + (size_t)PMAX * 512 * 2;
constexpr size_t WS_END    = WS_SLOT + (size_t)2 * T_TOK * 1024 * 2;
constexpr size_t WS_Q      = WS_HBUF;
constexpr size_t WS_KVC    = WS_SLOT;
constexpr size_t WS_VS     = WS_KVC + (size_t)T_TOK * 512 * 2;
constexpr size_t WS_VW     = WS_VS + (size_t)T_TOK * 256 * 2;

constexpr int LDS_BYTES = 160 * 1024;
constexpr int LDS_MISC  = 128 * 1024;

struct Params {
    const float* in[34];
    float* out;
    unsigned char* ws;
    int p0, p1;
};

template <int N> struct IC { static constexpr int value = N; };
typedef const __attribute__((address_space(4))) Params* KParams;
__device__ __forceinline__ KParams kparams() { KParams q = (KParams)__builtin_amdgcn_kernarg_segment_ptr(); asm volatile("" : "+s"(q)); return q; }


extern __shared__ __attribute__((aligned(16))) unsigned char smem_[];
constexpr int LDS_WTAB = LDS_BYTES - 96;
__device__ __forceinline__ int hw_wave_slot() { return (int)(__builtin_amdgcn_s_getreg((5 << 11) | 4) & 63u); }
__device__ __forceinline__ int my_tid() {
    const int wv = (int)((LAS unsigned char*)smem_)[LDS_WTAB + hw_wave_slot()];
    return __builtin_amdgcn_readfirstlane(wv) * 64 + (int)__builtin_amdgcn_mbcnt_hi(~0u, __builtin_amdgcn_mbcnt_lo(~0u, 0u));
}

__device__ __forceinline__ unsigned cvt_pk_bf16(float lo, float hi) { unsigned r; asm volatile("v_cvt_pk_bf16_f32 %0, %1, %2" : "=v"(r) : "v"(lo), "v"(hi)); return r; }
__device__ __forceinline__ bf16_t f2bf(float f) { return (bf16_t)(cvt_pk_bf16(f, 0.f) & 0xffffu); }
__device__ __forceinline__ float bf2f(unsigned b) { return __uint_as_float(b << 16); }
__device__ __forceinline__ float wave_sum(float v) {
#pragma unroll
    for (int o = 1; o < 64; o <<= 1) v += __shfl_xor(v, o);
    return v;
}
__device__ __forceinline__ float sigmoidf_(float x) { return __builtin_amdgcn_rcpf(1.f + __builtin_amdgcn_exp2f(-1.4426950408889634f * x)); }
__device__ __forceinline__ int swap23(int k) { return (k & ~12) | ((k & 4) << 1) | ((k & 8) >> 1); }

#define XB_TMO      128
#define XB_XCNT(j)  (256  + 64 * (j))
#define XB_XSUB(j)  (1280 + 64 * (j))
#define XB_XGEN(j)  (2304 + 64 * (j))
#define XB_TOP      3328
#define XB_TOPGEN   3392
#define XCD_BAR_WORDS 3456
#define XB_SPIN_CAP (1u << 21)
__device__ __forceinline__ unsigned xb_ld(unsigned* p)              { return __hip_atomic_load(p, __ATOMIC_RELAXED, __HIP_MEMORY_SCOPE_AGENT); }
__device__ __forceinline__ unsigned xb_add(unsigned* p, unsigned v) { return __hip_atomic_fetch_add(p, v, __ATOMIC_RELAXED, __HIP_MEMORY_SCOPE_AGENT); }
__device__ __forceinline__ unsigned xb_xcc_id() { return (unsigned)__builtin_amdgcn_s_getreg((3 << 11) | 20) & 0xFu; }
#define XB_SPIN(cond, bar) do { unsigned _sp = 0; while (cond) { __builtin_amdgcn_s_sleep(1); \
    if ((++_sp & 255u) == 0u) { if (xb_ld(&(bar)[XB_TMO])) break; if (_sp > XB_SPIN_CAP) { atomicAdd(&(bar)[XB_TMO], 1u); break; } } } } while (0)
struct XcdBarrier { unsigned* bar; unsigned x; volatile LAS unsigned* st; };
__device__ __forceinline__ XcdBarrier xcd_barrier_post(unsigned* bar, volatile LAS unsigned* st) {
    XcdBarrier b; b.bar = bar; b.x = xb_xcc_id(); b.st = st;
    if (my_tid() == 0) (void)xb_add(&bar[XB_XCNT(b.x)], 1u);
    return b;
}
__device__ __forceinline__ void xcd_barrier_complete(unsigned* bar, unsigned x, unsigned& nloc, unsigned& nx) {
    const unsigned G = gridDim.x * gridDim.y * gridDim.z;
    unsigned sum, cnt, mine, sp = 0u;
    for (;;) {
        sum = 0u; cnt = 0u; mine = 0u;
#pragma unroll
        for (unsigned j = 0; j < 16; ++j) { const unsigned c = xb_ld(&bar[XB_XCNT(j)]); sum += c; cnt += (c > 0u) ? 1u : 0u; mine = (j == x) ? c : mine; }
        if (sum == G) break;
        __builtin_amdgcn_s_sleep(1);
        if ((++sp & 255u) == 0u) { if (xb_ld(&bar[XB_TMO])) break; if (sp > XB_SPIN_CAP) { atomicAdd(&bar[XB_TMO], 1u); break; } }
    }
    nloc = mine > 0u ? mine : 1u; nx = cnt > 0u ? cnt : 1u;
}
__device__ __forceinline__ void xcd_barrier(const XcdBarrier& b) {
    asm volatile("s_waitcnt vmcnt(0)" ::: "memory");
    __syncthreads();
    if (my_tid() == 0) {
        unsigned* bar = b.bar;
        __builtin_amdgcn_s_waitcnt(0);
        unsigned nloc = b.st[0], nx = b.st[1];
        if (nloc == 0u) { xcd_barrier_complete(bar, b.x, nloc, nx); b.st[0] = nloc; b.st[1] = nx; }
        const unsigned old = xb_add(&bar[XB_XSUB(b.x)], 1u);
        const unsigned gen = old / nloc;
        if (old + 1u == (gen + 1u) * nloc) {
            __builtin_amdgcn_fence(__ATOMIC_RELEASE, "agent");
            asm volatile("s_waitcnt vmcnt(0)" ::: "memory");
            const unsigned og = xb_add(&bar[XB_TOP], 1u);
            const unsigned tg = og / nx;
            if (og + 1u == (tg + 1u) * nx) xb_add(&bar[XB_TOPGEN], 1u);
            else XB_SPIN(xb_ld(&bar[XB_TOPGEN]) == tg, bar);
            __builtin_amdgcn_fence(__ATOMIC_ACQUIRE, "agent");
            xb_add(&bar[XB_XGEN(b.x)], 1u);
            asm volatile("s_waitcnt vmcnt(0)" ::: "memory");
        } else {
            XB_SPIN(xb_ld(&bar[XB_XGEN(b.x)]) == gen, bar);
            __builtin_amdgcn_fence(__ATOMIC_ACQUIRE, "agent");
            asm volatile("s_waitcnt vmcnt(0)" ::: "memory");
        }
    }
    __syncthreads();
}

namespace g8 {
#ifndef G8_WGM
#define G8_WGM 8
#endif
constexpr int BM = 256, BK = 64, HALF = 128, HTB = HALF * BK * 2, STAGE_BYTES = 8 * HTB, NXCD = 8, WGM = G8_WGM;
__host__ __device__ __forceinline__ int lds_byte(int r, int c) { const int st = (r >> 4) * 2 + (c >> 5), rr = r & 15, cc = c & 31, ob = rr * 64 + cc * 2; return st * 1024 + (ob ^ (((ob >> 9) & 1) << 5)); }
__host__ __device__ __forceinline__ void stage_rc(int b, int& R, int& C) { const int st = b / 1024, sb = b % 1024, swz = sb ^ (((sb >> 9) & 1) << 5); R = (st >> 1) * 16 + swz / 64; C = (st & 1) * 32 + (swz % 64) / 2; }
__host__ __device__ __forceinline__ int perm32(int rho) { const int n = rho >> 4, i = rho & 15; return 8 * (i >> 2) + 4 * n + (i & 3); }
struct Unit { int pm, pn, ord; };

struct DenseSched {
    int nM, nN, nwg, G, c;
    const char* A; const char* Bt; size_t a_tile_b, a_pn_b, b_tile_b; const unsigned* tab;
    __device__ __forceinline__ void init(int nM_, int nN_) { nM = nM_; nN = nN_; nwg = nM * nN; G = gridDim.x; c = blockIdx.x; tab = nullptr; a_pn_b = 0; }
    __device__ __forceinline__ bool next(int i, Unit& u) const {
        const long L = (long)i * G + c; if (L >= nwg) return false;
        int wgid = (int)L; { const int q = nwg / NXCD, r = nwg % NXCD, xcd = wgid % NXCD, off = wgid / NXCD; wgid = (xcd < r ? xcd * (q + 1) : r * (q + 1) + (xcd - r) * q) + off; }
        const int nig = WGM * nN, gid = wgid / nig, fm = gid * WGM, gsz = (nM - fm) < WGM ? (nM - fm) : WGM;
        u.pm = fm + ((wgid % nig) % gsz); u.pn = (wgid % nig) / gsz; return true;
    }
    __device__ __forceinline__ const char* a_base(const Unit& u) const { return A + (size_t)u.pm * a_tile_b + (size_t)u.pn * a_pn_b; }
    __device__ __forceinline__ const char* b_base(const Unit& u) const { return Bt + (size_t)u.pn * b_tile_b; }
    __device__ __forceinline__ const unsigned* row_tab(const Unit& u) const { return tab + u.pm * 256; }
};
struct MoeSched {
    int nunits, NPN, G, c;
    const char* A; const char* W; size_t a_tile_b, w_e_b, b_tile_b; const unsigned* tab; const LAS unsigned char* tile_e;
    __device__ __forceinline__ bool next(int i, Unit& u) const {
        const int ntile = nunits / NPN, per = (ntile + 7) >> 3, x = c & 7, r = c >> 3, W = G >> 3;
        const int uidx = i * W + r, t = x * per + uidx / NPN;
        if (uidx >= per * NPN || t >= ntile) return false;
        u.pm = t; u.pn = uidx % NPN; return true;
    }
    __device__ __forceinline__ const char* a_base(const Unit& u) const { return A + (size_t)u.pm * a_tile_b; }
    __device__ __forceinline__ const char* b_base(const Unit& u) const { return W + (size_t)tile_e[u.pm] * w_e_b + (size_t)u.pn * b_tile_b; }
    __device__ __forceinline__ const unsigned* row_tab(const Unit& u) const { return tab + u.pm * 256; }
};

template <class Epi, class Sched, bool GATHER>
__device__ __forceinline__ void gemm_phase(LAS unsigned char* lds, const int K_, const int lda_b, const int kstepA, const Sched& S, const Epi& E) {
    int K = K_; asm volatile("" : "+s"(K));
    int tid_ = my_tid(); asm volatile("" : "+v"(tid_));
    const int tid = tid_, wid = __builtin_amdgcn_readfirstlane(tid >> 6), lane = tid & 63, wr = wid >> 2, wc = wid & 3, fr = lane & 15, fq = lane >> 4;
    const int nt = K / BK;
    unsigned voffB[2], va[2][2], vn[2][2];
#pragma unroll
    for (int i = 0; i < 2; ++i) { int R, C; stage_rc(tid * 16 + i * 8192, R, C); const int Rb = Epi::PERM ? ((R & ~31) + perm32(R & 31)) : R;
        voffB[i] = (unsigned)(Rb * K + C) * 2u;
        va[0][i] = (unsigned)(R * lda_b + C * 2); va[1][i] = (unsigned)((R + HALF) * lda_b + C * 2); vn[0][i] = va[0][i]; vn[1][i] = va[1][i]; }
    const size_t kstepB = (size_t)(BK * 2);
    const size_t hstepB = (size_t)HALF * K * 2;
    const unsigned ldsw = (unsigned)wid * 1024u;
    const int aoff = lds_byte(wr * 64 + fr, fq * 8), boff = lds_byte(wc * 32 + fr, fq * 8);
#define G8_SA(b, h) (((b) * 2 + (h)) * HTB)
#define G8_SB(b, h) ((4 + (b) * 2 + (h)) * HTB)
#define G8_STAGEB(bufoff, gbase) do { _Pragma("unroll") for (int _i = 0; _i < 2; ++_i) \
        __builtin_amdgcn_global_load_lds((const unsigned*)((const char*)(gbase) + voffB[_i]), (LAS unsigned*)(lds + (bufoff) + ldsw + _i * 8192), 16, 0, 0); } while (0)
#define G8_STAGEA(bufoff, gbase, VA, h) do { _Pragma("unroll") for (int _i = 0; _i < 2; ++_i) \
        __builtin_amdgcn_global_load_lds((const unsigned*)((const char*)(gbase) + (VA)[h][_i]), (LAS unsigned*)(lds + (bufoff) + ldsw + _i * 8192), 16, 0, 0); } while (0)
#define G8_LDA(dst, b, h) do { _Pragma("unroll") for (int m = 0; m < 4; ++m) _Pragma("unroll") for (int k = 0; k < 2; ++k) dst[m][k] = *(const LAS bf16x8*)(lds + G8_SA(b, h) + aoff + m * 2048 + k * 1024); } while (0)
#define G8_LDB(dst, b, h) do { _Pragma("unroll") for (int n = 0; n < 2; ++n) _Pragma("unroll") for (int k = 0; k < 2; ++k) dst[n][k] = *(const LAS bf16x8*)(lds + G8_SB(b, h) + boff + n * 2048 + k * 1024); } while (0)
#define G8_MMA(ai, bj, At, Bt) do { __builtin_amdgcn_s_setprio(1); _Pragma("unroll") for (int m = 0; m < 4; ++m) _Pragma("unroll") for (int n = 0; n < 2; ++n) _Pragma("unroll") for (int k = 0; k < 2; ++k) \
        acc[ai][bj][m][n] = __builtin_amdgcn_mfma_f32_16x16x32_bf16(Bt[n][k], At[m][k], acc[ai][bj][m][n], 0, 0, 0); __builtin_amdgcn_s_setprio(0); } while (0)
#define G8_WAIT_V(n) asm volatile("s_waitcnt vmcnt(" #n ")" ::: "memory")
#define G8_WAIT_L(n) asm volatile("s_waitcnt lgkmcnt(" #n ")" ::: "memory")
#define G8_BAR __builtin_amdgcn_s_barrier()
#define G8_SCHED __builtin_amdgcn_sched_barrier(0)
    Unit cur, nxt; int ui = 0;
    if (!S.next(0, cur)) return;
    cur.ord = 0;
    f32x4 acc[2][2][4][2];
#pragma unroll
    for (int a = 0; a < 2; ++a)
#pragma unroll
        for (int b = 0; b < 2; ++b)
#pragma unroll
            for (int m = 0; m < 4; ++m)
#pragma unroll
                for (int n = 0; n < 2; ++n) acc[a][b][m][n] = (f32x4){0.f, 0.f, 0.f, 0.f};
    bf16x8 At[4][2], B0[2][2], B1[2][2];
    const char* cA = S.a_base(cur); const char* cB = S.b_base(cur);
    if (GATHER) { const unsigned* tb = S.row_tab(cur);
#pragma unroll
        for (int i = 0; i < 2; ++i) { int R, C; stage_rc(tid * 16 + i * 8192, R, C); va[0][i] = tb[R] + (unsigned)(C * 2); va[1][i] = tb[R + HALF] + (unsigned)(C * 2); } }
    G8_STAGEB(G8_SB(0, 0), cB); G8_STAGEA(G8_SA(0, 0), cA, va, 0); G8_STAGEB(G8_SB(0, 1), cB + hstepB); G8_STAGEA(G8_SA(0, 1), cA, va, 1);
    if (wr == 1) G8_BAR;
    G8_WAIT_V(4); G8_BAR;
    G8_STAGEB(G8_SB(1, 0), cB + kstepB); G8_STAGEA(G8_SA(1, 0), cA + kstepA, va, 0); G8_STAGEB(G8_SB(1, 1), cB + hstepB + kstepB);
    G8_WAIT_V(6); G8_BAR;
    for (;;) {
        const bool has_next = S.next(ui + 1, nxt); nxt.ord = ui + 1;
        const char* nA = has_next ? S.a_base(nxt) : cA; const char* nB = has_next ? S.b_base(nxt) : cB;
        if (GATHER) {
            if (has_next) { const unsigned* tb = S.row_tab(nxt);
#pragma unroll
                for (int i = 0; i < 2; ++i) { int R, C; stage_rc(tid * 16 + i * 8192, R, C); vn[0][i] = tb[R] + (unsigned)(C * 2); vn[1][i] = tb[R + HALF] + (unsigned)(C * 2); } }
            else {
#pragma unroll
                for (int i = 0; i < 2; ++i) { vn[0][i] = va[0][i]; vn[1][i] = va[1][i]; } }
        }
        for (int t = 0; t < nt; t += 2) {
            const bool last = (t == nt - 2);
            const char* a1 = cA + (size_t)(t + 1) * kstepA;
            const char* a2 = last ? nA : cA + (size_t)(t + 2) * kstepA; const char* b2 = last ? nB : cB + (size_t)(t + 2) * kstepB;
            const char* a3 = a2 + kstepA; const char* b3 = b2 + kstepB;
            unsigned vx[2][2];
#pragma unroll
            for (int hh = 0; hh < 2; ++hh)
#pragma unroll
                for (int i = 0; i < 2; ++i) vx[hh][i] = (GATHER && last) ? vn[hh][i] : va[hh][i];
            G8_LDB(B0, 0, 0); G8_SCHED; G8_LDA(At, 0, 0); G8_STAGEA(G8_SA(1, 1), a1, va, 1);
            G8_WAIT_L(8); G8_BAR; G8_WAIT_L(0); G8_MMA(0, 0, At, B0); G8_BAR; G8_SCHED;
            G8_LDB(B1, 0, 1); G8_STAGEB(G8_SB(0, 0), b2);
            G8_BAR; G8_WAIT_L(0); G8_MMA(0, 1, At, B1); G8_BAR;
            G8_LDA(At, 0, 1); G8_STAGEA(G8_SA(0, 0), a2, vx, 0);
            G8_BAR; G8_WAIT_L(0); G8_MMA(1, 0, At, B0); G8_BAR; G8_SCHED;
            G8_STAGEB(G8_SB(0, 1), b2 + hstepB);
            G8_WAIT_V(6); G8_BAR; G8_MMA(1, 1, At, B1); G8_BAR;
            G8_LDB(B0, 1, 0); G8_SCHED; G8_LDA(At, 1, 0); G8_STAGEA(G8_SA(0, 1), a2, vx, 1);
            G8_WAIT_L(8); G8_BAR; G8_WAIT_L(0); G8_MMA(0, 0, At, B0); G8_BAR; G8_SCHED;
            G8_LDB(B1, 1, 1); G8_STAGEB(G8_SB(1, 0), b3);
            G8_BAR; G8_WAIT_L(0); G8_MMA(0, 1, At, B1); G8_BAR;
            G8_LDA(At, 1, 1); G8_STAGEA(G8_SA(1, 0), a3, vx, 0);
            G8_BAR; G8_WAIT_L(0); G8_MMA(1, 0, At, B0); G8_BAR; G8_SCHED;
            G8_STAGEB(G8_SB(1, 1), b3 + hstepB);
            G8_WAIT_V(6); G8_BAR; G8_MMA(1, 1, At, B1); G8_BAR;
        }
        E(acc, cur, wr, wc, fr, fq);
#ifdef PROBE_EPI2
        if (Epi::PROBE_DUP) E(acc, cur, wr, wc, fr, fq);
#endif
        if (!has_next) break;
#pragma unroll
        for (int a = 0; a < 2; ++a)
#pragma unroll
            for (int b = 0; b < 2; ++b)
#pragma unroll
                for (int m = 0; m < 4; ++m)
#pragma unroll
                    for (int n = 0; n < 2; ++n) acc[a][b][m][n] = (f32x4){0.f, 0.f, 0.f, 0.f};
        cur = nxt; cA = nA; cB = nB; ++ui;
        if (GATHER) {
#pragma unroll
            for (int i = 0; i < 2; ++i) { va[0][i] = vn[0][i]; va[1][i] = vn[1][i]; } }
    }
    G8_WAIT_V(0);
    if (wr == 0) G8_BAR;
    G8_BAR;
#undef G8_SA
#undef G8_SB
#undef G8_STAGEA
#undef G8_STAGEB
#undef G8_LDA
#undef G8_LDB
#undef G8_MMA
#undef G8_WAIT_V
#undef G8_WAIT_L
#undef G8_BAR
#undef G8_SCHED
}
}
using g8::Unit;

#ifndef PROBE_EPI_SEL
#define PROBE_EPI_SEL 0
#endif
typedef f32x4 AccT[2][2][4][2];

template <int MODE> struct EpiResid {
    static constexpr bool PERM = false; static constexpr bool PROBE_DUP = (PROBE_EPI_SEL == 4 && MODE == 2);
    int L;
    __device__ __forceinline__ void operator()(const AccT& acc, const Unit& u, int wr, int wc, int fr, int fq) const {
        KParams Q = kparams(); unsigned char* ws = Q->ws;
        const bf16_t* hin = (const bf16_t*)(ws + (MODE == 2 ? WS_HBB : WS_HBA)); bf16_t* hb = (bf16_t*)(ws + WS_HBA); float* ssq = (float*)(ws + WS_SSQ);
        const float* bias = (MODE == 1) ? Q->in[6] + L * 1024 : Q->in[32] + L * 1024; const float* scale = Q->in[7] + L * 1024;
        const bf16_t* ple = (const bf16_t*)(ws + WS_ACT); const float* rstd = (const float*)(ws + WS_RSP);
        const int col0 = u.pn * 256 + wc * 32 + 4 * fq;
        f32x4 bv[2][2], sv[2][2];
#pragma unroll
        for (int bj = 0; bj < 2; ++bj)
#pragma unroll
            for (int n = 0; n < 2; ++n) {
                bv[bj][n] = (MODE != 0) ? *(const f32x4*)(bias + col0 + bj * 128 + n * 16) : (f32x4){0.f, 0.f, 0.f, 0.f};
                sv[bj][n] = (MODE == 1) ? *(const f32x4*)(scale + col0 + bj * 128 + n * 16) : (f32x4){1.f, 1.f, 1.f, 1.f}; }
#pragma unroll
        for (int ai = 0; ai < 2; ++ai) {
          u32x2 hws[4][2][2], pws[4][2][2]; float rsv[4];
#pragma unroll
          for (int m = 0; m < 4; ++m) { const int row = u.pm * 256 + ai * 128 + wr * 64 + m * 16 + fr; const size_t off = (size_t)row * DM + col0;
              rsv[m] = (MODE == 2) ? rstd[row] : 1.f;
#pragma unroll
              for (int bj = 0; bj < 2; ++bj)
#pragma unroll
                  for (int n = 0; n < 2; ++n) { hws[m][bj][n] = *(const u32x2*)(hin + off + bj * 128 + n * 16); if (MODE == 2) pws[m][bj][n] = *(const u32x2*)(ple + off + bj * 128 + n * 16); } }
#pragma unroll
            for (int m = 0; m < 4; ++m) {
                const int row = u.pm * 256 + ai * 128 + wr * 64 + m * 16 + fr;
                const size_t off = (size_t)row * DM + col0;
                const float rs = rsv[m];
                float ss = 0.f;
#pragma unroll
                for (int bj = 0; bj < 2; ++bj)
#pragma unroll
                    for (int n = 0; n < 2; ++n) {
                        const size_t o = off + bj * 128 + n * 16;
                        const u32x2 hw = hws[m][bj][n];
                        const f32x4 hv = {bf2f(hw.x & 0xffffu), bf2f(hw.x >> 16), bf2f(hw.y & 0xffffu), bf2f(hw.y >> 16)};
                        f32x4 v = acc[ai][bj][m][n];
                        if (MODE == 1) v = (v + bv[bj][n]) * sv[bj][n];
                        if (MODE == 2) { const u32x2 pw = pws[m][bj][n];
                            f32x4 pl = {bf2f(pw.x & 0xffffu), bf2f(pw.x >> 16), bf2f(pw.y & 0xffffu), bf2f(pw.y >> 16)};
                            f32x4 z = v * rs + bv[bj][n];
                            v = (f32x4){pl.x * sigmoidf_(z.x), pl.y * sigmoidf_(z.y), pl.z * sigmoidf_(z.z), pl.w * sigmoidf_(z.w)}; }
                        v = v + hv;
                        u32x2 w; w.x = cvt_pk_bf16(v.x, v.y); w.y = cvt_pk_bf16(v.z, v.w);
                        *(u32x2*)(hb + o) = w;
                        const float r0 = bf2f(w.x & 0xffffu), r1 = bf2f(w.x >> 16), r2 = bf2f(w.y & 0xffffu), r3 = bf2f(w.y >> 16);
                        ss += r0 * r0 + r1 * r1 + r2 * r2 + r3 * r3;
                    }
                ss += __shfl_xor(ss, 16); ss += __shfl_xor(ss, 32);
                if (fq == 0) ssq[(size_t)row * 16 + u.pn * 4 + wc] = ss;
            }
        }
    }
};

__device__ __forceinline__ float rstd_from_parts(const float* ssq, int row) {
    const f32x4* p = (const f32x4*)(ssq + (size_t)row * 16);
    const f32x4 a = p[0], b = p[1], c = p[2], d = p[3];
    const float s = ((a.x + a.y) + (a.z + a.w)) + ((b.x + b.y) + (b.z + b.w)) + ((c.x + c.y) + (c.z + c.w)) + ((d.x + d.y) + (d.z + d.w));
    return 1.f / sqrtf(s * (1.f / DM) + RMS_EPS);
}


constexpr int LDS_RSTD = LDS_MISC + 4096;
constexpr int LDS_RBIAS = LDS_RSTD + 6 * 1024;
template <class Sched>
__device__ __forceinline__ void rstd_table_fill(LAS unsigned char* lds, const Sched& S, const float* ssq) {
    LAS float* tab = (LAS float*)(lds + LDS_RSTD);
    const int tid = my_tid();
    for (int i0 = 0; i0 < 6; i0 += 2) { Unit u; const int i = i0 + (tid >> 8);
        if (S.next(i, u)) { const int row = u.pm * 256 + (tid & 255); tab[i * 256 + (tid & 255)] = rstd_from_parts(ssq, row); } }
    __syncthreads();
}
struct EpiRouter {
    static constexpr bool PERM = false; static constexpr bool PROBE_DUP = false;
    int L; LAS unsigned* hist;
    __device__ __forceinline__ void operator()(const AccT& acc, const Unit& u, int wr, int wc, int fr, int fq) const {
        if (wc != 0) return;
        KParams Q = kparams(); unsigned char* ws = Q->ws;
        const LAS float* rtab = (const LAS float*)((LAS unsigned char*)smem_ + LDS_RSTD); const LAS float* gb = (const LAS float*)((LAS unsigned char*)smem_ + LDS_RBIAS); const LAS float* eb = gb + 4;
        int* toke = (int*)(ws + WS_TOKE); float* tokw = (float*)(ws + WS_TOKW); float* rsf = (float*)(ws + WS_RSF);
#pragma unroll
        for (int ai = 0; ai < 2; ++ai)
#pragma unroll
            for (int m = 0; m < 4; ++m) {
                const int row = u.pm * 256 + ai * 128 + wr * 64 + m * 16 + fr;
                const float rs = rtab[u.ord * 256 + ai * 128 + wr * 64 + m * 16 + fr];
                float gl[4];
#pragma unroll
                for (int i = 0; i < 4; ++i) gl[i] = __shfl(acc[ai][1][m][0][i], fr) * rs + gb[i];
                int grp = 0; float gm = gl[0];
#pragma unroll
                for (int i = 1; i < 4; ++i) if (gl[i] > gm) { gm = gl[i]; grp = i; }
                float gs = 0.f;
#pragma unroll
                for (int i = 0; i < 4; ++i) gs += __expf(gl[i] - gm);
                const float gprob = 1.f / gs;
                f32x4 mine;
#pragma unroll
                for (int i = 0; i < 4; ++i) { float x0 = acc[ai][0][m][0][i], x1 = acc[ai][0][m][1][i]; asm volatile("" : "+v"(x0), "+v"(x1)); mine[i] = (grp >> 1) ? x1 : x0; }
                const int src0 = fr + 16 * (2 * (grp & 1));
                float el[8];
#pragma unroll
                for (int i = 0; i < 4; ++i) { el[i] = __shfl(mine[i], src0); el[4 + i] = __shfl(mine[i], src0 + 16); }
#pragma unroll
                for (int j = 0; j < 8; ++j) el[j] = el[j] * rs + eb[grp * 8 + j];
                int i1 = 0; float v1 = el[0];
#pragma unroll
                for (int j = 1; j < 8; ++j) if (el[j] > v1) { v1 = el[j]; i1 = j; }
                int i2 = -1; float v2 = -3.0e38f;
#pragma unroll
                for (int j = 0; j < 8; ++j) if (j != i1 && el[j] > v2) { v2 = el[j]; i2 = j; }
                const float e2 = __expf(v2 - v1), inv = 1.f / (1.f + e2);
                if (fq == 0) {
                    const int e1g = grp * 8 + i1, e2g = grp * 8 + i2;
                    *(int2*)(toke + (size_t)row * 2) = make_int2(e1g, e2g);
                    *(float2*)(tokw + (size_t)row * 2) = make_float2(gprob * inv, gprob * e2 * inv);
                    rsf[row] = rs;
                    atomicAdd((unsigned*)&hist[e1g], 1u); atomicAdd((unsigned*)&hist[e2g], 1u);
                }
            }
    }
};

struct EpiMoe1 {
    static constexpr bool PERM = true; static constexpr bool PROBE_DUP = (PROBE_EPI_SEL == 2);
    int dummy;
    __device__ __forceinline__ void operator()(const AccT& acc, const Unit& u, int wr, int wc, int fr, int fq) const {
        KParams Q = kparams(); unsigned char* ws = Q->ws;
        const int* rowtab = (const int*)(ws + WS_ROWTAB); const float* rsf = (const float*)(ws + WS_RSF); bf16_t* hbuf = (bf16_t*)(ws + WS_HBUF);
        const int hc0 = u.pn * 128 + wc * 16 + 4 * fq;
        int av[8]; float rsv[8];
#pragma unroll
        for (int i8 = 0; i8 < 8; ++i8) av[i8] = rowtab[u.pm * 256 + (i8 >> 2) * 128 + wr * 64 + (i8 & 3) * 16 + fr];
#pragma unroll
        for (int i8 = 0; i8 < 8; ++i8) rsv[i8] = rsf[av[i8] < 0 ? 0 : (av[i8] >> 1)];
#pragma unroll
        for (int ai = 0; ai < 2; ++ai)
#pragma unroll
            for (int m = 0; m < 4; ++m) {
                const int pos = u.pm * 256 + ai * 128 + wr * 64 + m * 16 + fr;
                const int a = av[ai * 4 + m];
                if (a < 0) continue;
                const float rs = rsv[ai * 4 + m];
#pragma unroll
                for (int bj = 0; bj < 2; ++bj) {
                    const f32x4 g = acc[ai][bj][m][0] * rs, uu = acc[ai][bj][m][1] * rs;
                    f32x4 o;
#pragma unroll
                    for (int i = 0; i < 4; ++i) o[i] = g[i] * sigmoidf_(g[i]) * uu[i];
                    u32x2 w; w.x = cvt_pk_bf16(o.x, o.y); w.y = cvt_pk_bf16(o.z, o.w);
                    *(u32x2*)(hbuf + (size_t)pos * DFF + hc0 + bj * 64) = w;
                }
            }
    }
};
struct EpiMoe2 {
    static constexpr bool PERM = true; static constexpr bool PROBE_DUP = (PROBE_EPI_SEL == 3);
    int dummy;
    __device__ __forceinline__ void operator()(const AccT& acc, const Unit& u, int wr, int wc, int fr, int fq) const {
        KParams Q = kparams(); unsigned char* ws = Q->ws;
        const int* rowtab = (const int*)(ws + WS_ROWTAB); const float* tokw = (const float*)(ws + WS_TOKW); bf16_t* slot = (bf16_t*)(ws + WS_SLOT);
        const int col0 = u.pn * 256 + wc * 32 + 8 * fq;
        int av[8]; float wv[8];
#pragma unroll
        for (int i8 = 0; i8 < 8; ++i8) av[i8] = rowtab[u.pm * 256 + (i8 >> 2) * 128 + wr * 64 + (i8 & 3) * 16 + fr];
#pragma unroll
        for (int i8 = 0; i8 < 8; ++i8) wv[i8] = tokw[av[i8] < 0 ? 0 : av[i8]];
#pragma unroll
        for (int ai = 0; ai < 2; ++ai)
#pragma unroll
            for (int m = 0; m < 4; ++m) {
                const int a = av[ai * 4 + m];
                if (a < 0) continue;
                const float w = wv[ai * 4 + m];
#pragma unroll
                for (int bj = 0; bj < 2; ++bj) {
                    const f32x4 v0 = acc[ai][bj][m][0] * w, v1 = acc[ai][bj][m][1] * w;
                    u32x4 o; o.x = cvt_pk_bf16(v0.x, v0.y); o.y = cvt_pk_bf16(v0.z, v0.w); o.z = cvt_pk_bf16(v1.x, v1.y); o.w = cvt_pk_bf16(v1.z, v1.w);
                    *(u32x4*)(slot + (size_t)a * DM + col0 + bj * 128) = o;
                }
            }
    }
};
struct EpiBf16 {
    static constexpr bool PERM = true; static constexpr bool PROBE_DUP = false;
    int dummy;
    __device__ __forceinline__ void operator()(const AccT& acc, const Unit& u, int wr, int wc, int fr, int fq) const {
        KParams Q = kparams(); bf16_t* O = (bf16_t*)(Q->ws + WS_ACT); constexpr int ldc = 1024;
        const int col0 = u.pn * 256 + wc * 32 + 8 * fq;
#pragma unroll
        for (int ai = 0; ai < 2; ++ai)
#pragma unroll
            for (int m = 0; m < 4; ++m) {
                const int row = u.pm * 256 + ai * 128 + wr * 64 + m * 16 + fr;
#pragma unroll
                for (int bj = 0; bj < 2; ++bj) {
                    const f32x4 v0 = acc[ai][bj][m][0], v1 = acc[ai][bj][m][1];
                    u32x4 o; o.x = cvt_pk_bf16(v0.x, v0.y); o.y = cvt_pk_bf16(v0.z, v0.w); o.z = cvt_pk_bf16(v1.x, v1.y); o.w = cvt_pk_bf16(v1.z, v1.w);
                    *(u32x4*)(O + (size_t)row * ldc + col0 + bj * 128) = o;
                }
            }
    }
};
struct EpiQkv {
    static constexpr bool PERM = true; static constexpr bool PROBE_DUP = (PROBE_EPI_SEL == 1);
    int tile0; int J;
    __device__ __forceinline__ void operator()(const AccT& acc, const Unit& u, int wr, int wc, int fr, int fq) const {
        KParams Q = kparams(); unsigned char* ws = Q->ws;
        const float* ssq = (const float*)(ws + WS_SSQ); const float* rope = (const float*)(ws + WS_ROPE); const float* bgate = Q->in[21] + J * 48;
        bf16_t* kvc = (bf16_t*)(ws + WS_KVC); bf16_t* ks = (bf16_t*)(ws + WS_KS); bf16_t* vs = (bf16_t*)(ws + WS_VS); bf16_t* kw = (bf16_t*)(ws + WS_KW); bf16_t* vw = (bf16_t*)(ws + WS_VW);
        bf16_t* q = (bf16_t*)(ws + WS_Q); float* gates = (float*)(ws + WS_GATES);
        const int ty = u.pn + tile0;
        const int cu0 = wc * 32 + 8 * fq;
        const bool roped = (ty == 2 || ty == 4 || ty >= 6) && ty != 10;
        const bool dorope = roped && ((wc & 1) == 0);
        bf16_t* dst; int ldc; int cbase;
        if (ty < 2)       { dst = kvc; ldc = 512;  cbase = ty * 256; }
        else if (ty == 2) { dst = ks;  ldc = 256;  cbase = 0; }
        else if (ty == 3) { dst = vs;  ldc = 256;  cbase = 0; }
        else if (ty == 4) { dst = kw;  ldc = 256;  cbase = 0; }
        else if (ty == 5) { dst = vw;  ldc = 256;  cbase = 0; }
        else              { dst = q;   ldc = 1024; cbase = (ty - 6) * 256; }
        const LAS float* rtab = (const LAS float*)((LAS unsigned char*)smem_ + LDS_RSTD);
#pragma unroll
        for (int ai = 0; ai < 2; ++ai)
#pragma unroll
            for (int m = 0; m < 4; ++m) {
                const int row = u.pm * 256 + ai * 128 + wr * 64 + m * 16 + fr;
                const float rs = rtab[u.ord * 256 + ai * 128 + wr * 64 + m * 16 + fr];
                if (ty == 10) {
                    if (wc < 2) {
#pragma unroll
                        for (int n = 0; n < 2; ++n) {
                            const int c = cu0 + 4 * n;
                            if (c < 48) { f32x4 z = acc[ai][0][m][n] * rs + *(const f32x4*)(bgate + c);
                                f32x4 o = {sigmoidf_(z.x), sigmoidf_(z.y), sigmoidf_(z.z), sigmoidf_(z.w)};
                                *(f32x4*)(gates + (size_t)row * 48 + c) = o; }
                        }
                    }
                    continue;
                }
                f32x4 cs[2], sn[2];
                if (dorope) {
                    const float pf = (float)(row & (SEQ - 1));
                    constexpr float RV[8] = {0.15915494309189535f, 0.03086376340470123f, 0.005985185712713705f, 0.001160663641240061f, 0.00022507907903927653f, 4.364795279280289e-05f, 8.464330808241401e-06f, 1.6414262627950345e-06f};
#pragma unroll
                    for (int n2 = 0; n2 < 2; ++n2)
#pragma unroll
                        for (int i = 0; i < 4; ++i) { const float rv = __builtin_amdgcn_fractf(pf * RV[4 * n2 + i]); cs[n2][i] = __builtin_amdgcn_cosf(rv); sn[n2][i] = __builtin_amdgcn_sinf(rv); }
                }
#pragma unroll
                for (int bj = 0; bj < 2; ++bj) {
                    f32x4 v[2];
#pragma unroll
                    for (int n = 0; n < 2; ++n) {
                        v[n] = acc[ai][bj][m][n] * rs;
                        if (dorope) {
                            f32x4 ot;
#pragma unroll
                            for (int i = 0; i < 4; ++i) ot[i] = __shfl_xor(v[n][i], 16);
                            if (fq == 0) v[n] = v[n] * cs[n] - ot * sn[n];
                            else if (fq == 1) v[n] = v[n] * cs[n] + ot * sn[n];
                        }
                        if (ty >= 6) v[n] = v[n] * QSCALE;
                    }
                    u32x4 o; o.x = cvt_pk_bf16(v[0].x, v[0].y); o.y = cvt_pk_bf16(v[0].z, v[0].w); o.z = cvt_pk_bf16(v[1].x, v[1].y); o.w = cvt_pk_bf16(v[1].z, v[1].w);
                    if (ty == 2 || ty == 4) *(u32x4*)(dst + (((size_t)((row >> 13) * 4 + 2 * bj + (wc >> 1))) * SEQ + (row & (SEQ - 1))) * 64 + (wc & 1) * 32 + 8 * fq) = o;
                    else *(u32x4*)(dst + (size_t)row * ldc + cbase + cu0 + bj * 128) = o;
                }
            }
    }
};
__device__ __forceinline__ float gelu_tanh(float x) {
    const float u = 0.7978845608028654f * (x + 0.044715f * x * x * x);
    const float t = 1.f - 2.f * __builtin_amdgcn_rcpf(1.f + __builtin_amdgcn_exp2f(2.8853900817779268f * u));
    return 0.5f * x * (1.f + t);
}
struct EpiCmp1 {
    static constexpr bool PERM = true; static constexpr bool PROBE_DUP = false;
    int dummy;
    __device__ __forceinline__ void operator()(const AccT& acc, const Unit& u, int wr, int wc, int fr, int fq) const {
        KParams Q = kparams(); unsigned char* ws = Q->ws; const float* cb1 = (const float*)(ws + WS_CB1); bf16_t* chid = (bf16_t*)(ws + WS_CHID);
        const int col0 = wc * 32 + 8 * fq;
        bf16_t* O = chid + (size_t)u.pn * 8192 * 256;
#pragma unroll
        for (int ai = 0; ai < 2; ++ai)
#pragma unroll
            for (int m = 0; m < 4; ++m) {
                const int row = u.pm * 256 + ai * 128 + wr * 64 + m * 16 + fr;
#pragma unroll
                for (int bj = 0; bj < 2; ++bj) {
                    const int c = col0 + bj * 128;
                    const f32x4 b0 = *(const f32x4*)(cb1 + u.pn * 256 + c), b1 = *(const f32x4*)(cb1 + u.pn * 256 + c + 4);
                    const f32x4 v0 = acc[ai][bj][m][0] + b0, v1 = acc[ai][bj][m][1] + b1;
                    u32x4 o; o.x = cvt_pk_bf16(gelu_tanh(v0.x), gelu_tanh(v0.y)); o.y = cvt_pk_bf16(gelu_tanh(v0.z), gelu_tanh(v0.w));
                    o.z = cvt_pk_bf16(gelu_tanh(v1.x), gelu_tanh(v1.y)); o.w = cvt_pk_bf16(gelu_tanh(v1.z), gelu_tanh(v1.w));
                    *(u32x4*)(O + (size_t)row * 256 + c) = o;
                }
            }
    }
};
struct EpiCmp2 {
    static constexpr bool PERM = true; static constexpr bool PROBE_DUP = false;
    int dummy;
    __device__ __forceinline__ void operator()(const AccT& acc, const Unit& u, int wr, int wc, int fr, int fq) const {
        if (wc >= 2) return;
        KParams Q = kparams(); unsigned char* ws = Q->ws; const float* b2k = Q->in[14]; const float* b2v = Q->in[19]; const float* rope = (const float*)(ws + WS_ROPE);
        bf16_t* kc = (bf16_t*)(ws + WS_KC); bf16_t* vct = (bf16_t*)(ws + WS_VCT);
        const int c0 = wc * 32 + 8 * fq;
        const float* b2 = u.pn ? b2v : b2k;
        const f32x4 bb0 = *(const f32x4*)(b2 + c0), bb1 = *(const f32x4*)(b2 + c0 + 4);
#pragma unroll
        for (int ai = 0; ai < 2; ++ai)
#pragma unroll
            for (int m = 0; m < 4; ++m) {
                const int row = u.pm * 256 + ai * 128 + wr * 64 + m * 16 + fr;
                const int bg = row >> 9, n = row & 511;
                f32x4 v[2]; v[0] = acc[ai][0][m][0] + bb0; v[1] = acc[ai][0][m][1] + bb1;
                if (u.pn == 0) {
#ifdef DBG_NOROPE_KC
                    if (false) {
#else
                    if (wc == 0) {
#endif
                        const int pos = (16 * n + 31) & (SEQ - 1);
                        const float* rp = rope + (size_t)pos * 16;
#pragma unroll
                        for (int nn = 0; nn < 2; ++nn) {
                            const f32x4 cs = *(const f32x4*)(rp + 4 * nn), sn = *(const f32x4*)(rp + 8 + 4 * nn);
                            f32x4 ot;
#pragma unroll
                            for (int i = 0; i < 4; ++i) ot[i] = __shfl_xor(v[nn][i], 16);
                            if (fq == 0) v[nn] = v[nn] * cs - ot * sn; else if (fq == 1) v[nn] = v[nn] * cs + ot * sn;
                        }
                    }
                    if (n == 511) { v[0] = (f32x4){0.f, 0.f, 0.f, 0.f}; v[1] = v[0]; }
                    u32x4 o; o.x = cvt_pk_bf16(v[0].x, v[0].y); o.y = cvt_pk_bf16(v[0].z, v[0].w); o.z = cvt_pk_bf16(v[1].x, v[1].y); o.w = cvt_pk_bf16(v[1].z, v[1].w);
                    *(u32x4*)(kc + ((size_t)bg * 512 + n) * 64 + c0) = o;
                } else {
                    const int np = swap23(n & 63), ntile = n >> 6;
#pragma unroll
                    for (int nn = 0; nn < 2; ++nn)
#pragma unroll
                        for (int i = 0; i < 4; ++i) vct[(((size_t)bg * 8 + ntile) * 64 + c0 + 4 * nn + i) * 64 + np] = (n == 511) ? (bf16_t)0 : f2bf(v[nn][i]);
                }
            }
    }
};
#ifndef CVT_DEPTH
#define CVT_DEPTH 4
#endif
template <class F>
__device__ __forceinline__ void cvt_family(LAS float* scr, bf16_t* dst, int nbatch, int Nd, int K, const F& f) {
    const int tilesN = Nd / 64, tilesK = K / 64, per = tilesN * tilesK, items = nbatch * per;
    int tid_ = my_tid(); asm volatile("" : "+v"(tid_));
    const int tid = tid_;
    const int kk0 = tid >> 4, n4 = (tid & 15) * 4;
    const int G = gridDim.x;
    f32x4 q[CVT_DEPTH][2]; float qs[CVT_DEPTH][2];
#define CVT_LOAD(j_, it_) do { int i__ = (it_); i__ = i__ < items ? i__ : items - 1; const int b_ = i__ / per, r_ = i__ % per, n0_ = (r_ / tilesK) * 64, k0_ = (r_ % tilesK) * 64; \
        q[j_][0] = f(b_, k0_ + kk0, n0_ + n4, qs[j_][0]); q[j_][1] = f(b_, k0_ + kk0 + 32, n0_ + n4, qs[j_][1]); } while (0)
    int it = blockIdx.x;
    if (it < items) {
#pragma unroll
        for (int j = 0; j < CVT_DEPTH; ++j) CVT_LOAD(j, it + j * G);
        while (it < items) {
#pragma unroll
            for (int j = 0; j < CVT_DEPTH; ++j) {
                const f32x4 c0 = q[j][0] * qs[j][0], c1 = q[j][1] * qs[j][1];
                CVT_LOAD(j, it + CVT_DEPTH * G);
                if (it < items) {
                    const int b = it / per, r = it % per, n0 = (r / tilesK) * 64, k0 = (r % tilesK) * 64;
                    LAS float* sb = scr + (j & 1) * (64 * 68);
                    *(LAS f32x4*)(sb + kk0 * 68 + n4) = c0; *(LAS f32x4*)(sb + (kk0 + 32) * 68 + n4) = c1;
                    __syncthreads();
                    { const int nn = tid >> 3, kc = tid & 7; const LAS float* s = sb + (8 * kc) * 68 + nn;
                      u32x4 o; o.x = cvt_pk_bf16(s[0], s[68]); o.y = cvt_pk_bf16(s[2 * 68], s[3 * 68]); o.z = cvt_pk_bf16(s[4 * 68], s[5 * 68]); o.w = cvt_pk_bf16(s[6 * 68], s[7 * 68]);
                      *(u32x4*)(dst + ((size_t)b * Nd + n0 + nn) * K + k0 + 8 * kc) = o; }
                }
                it += G;
            }
        }
    }
    __syncthreads();
#undef CVT_LOAD
}
#define LD4(p_) (*(const f32x4*)(p_))
#define Z4 ((f32x4){0.f, 0.f, 0.f, 0.f})

__device__ __forceinline__ void prologue_phase(LAS unsigned char* lds, const Params& p) {
    LAS float* scr = (LAS float*)lds;
    unsigned char* ws = p.ws;
    const int tid = my_tid();
    const size_t gtid = (size_t)blockIdx.x * 512 + tid, gsz = (size_t)gridDim.x * 512;
    { float* rope = (float*)(ws + WS_ROPE);
      for (size_t i = gtid; i < (size_t)SEQ * 8; i += gsz) { const int pos = (int)(i >> 3), f = (int)(i & 7);
          const float inv = (float)pow(500000.0, -(double)f / 8.0); const float ang = (float)pos * inv;
          rope[pos * 16 + f] = (float)cos((double)ang); rope[pos * 16 + 8 + f] = (float)sin((double)ang); } }
    { unsigned* tab = (unsigned*)(ws + WS_CMPTAB);
      for (size_t i = gtid; i < 8192; i += gsz) { const int bg = (int)(i >> 9), n = (int)(i & 511), b = bg >> 2, g = bg & 3, nc = n > 510 ? 510 : n;
          tab[i] = (unsigned)((((size_t)b * SEQ + 16 * nc) * 512 + g * 64) * 2); } }
    if (blockIdx.x == 0) { float* cb1 = (float*)(ws + WS_CB1); const int which = tid >> 8, hh = tid & 255;
        const float* pos = which ? p.in[15] : p.in[10]; const float* w1 = which ? p.in[16] : p.in[11]; const float* b1 = which ? p.in[17] : p.in[12];
        float s = b1[hh]; for (int k = 0; k < 2048; ++k) s += pos[k] * w1[(size_t)k * 256 + hh];
        cb1[which * 256 + hh] = s; }
    { const f32x4* src = (const f32x4*)p.in[0]; u32x2* dst = (u32x2*)(ws + WS_HBA);
      static_assert(((size_t)T_TOK * 1024 / 4) % ((size_t)256 * 512 * 4) == 0, "x conversion is unrolled by 4");
      for (size_t i = gtid; i < (size_t)T_TOK * 1024 / 4; i += 4 * gsz) { f32x4 v[4];
#pragma unroll
          for (int u = 0; u < 4; ++u) v[u] = src[i + u * gsz];
#pragma unroll
          for (int u = 0; u < 4; ++u) { u32x2 o; o.x = cvt_pk_bf16(v[u].x, v[u].y); o.y = cvt_pk_bf16(v[u].z, v[u].w); dst[i + u * gsz] = o; } } }
    { const f32x4* src = (const f32x4*)p.in[1]; u32x2* dst = (u32x2*)(ws + WS_PB);
      for (size_t i = gtid; i < (size_t)4 * T_TOK * 256 / 4; i += 4 * gsz) { f32x4 v[4];
#pragma unroll
          for (int u = 0; u < 4; ++u) v[u] = src[i + u * gsz];
#pragma unroll
          for (int u = 0; u < 4; ++u) { u32x2 o; o.x = cvt_pk_bf16(v[u].x, v[u].y); o.y = cvt_pk_bf16(v[u].z, v[u].w); dst[i + u * gsz] = o; } } }
    { const float* pw = p.in[5];
      cvt_family(scr, (bf16_t*)(ws + WS_WPOOL), 2, 1024, 256, [=](int b, int k, int nd, float& sc) { sc = 1.f; return LD4(pw + (((size_t)b * 4 + (nd >> 8)) * 256 + k) * 256 + (nd & 255)); }); }
    { const float* wkv = p.in[9]; const float* kvn = p.in[8]; const float* wqg = p.in[20]; const float* nm = p.in[2] + 2 * 1024;
      cvt_family(scr, (bf16_t*)(ws + WS_WKVQ), 1, 2816, 1024, [=](int b, int k, int nd, float& sc) {
          if (nd < 1536) { sc = kvn[k]; return LD4(wkv + (size_t)k * 1536 + nd); }
          if (nd < 1536 + 1072) { sc = nm[k]; return LD4(wqg + (size_t)k * 1072 + (nd - 1536)); }
          sc = 1.f; return Z4; }); }
    { const float* wqg = p.in[20] + (size_t)1024 * 1072; const float* nm = p.in[2] + 3 * 1024;
      cvt_family(scr, (bf16_t*)(ws + WS_WQG1), 1, 1280, 1024, [=](int b, int k, int nd, float& sc) { sc = nm[k]; return nd < 1072 ? LD4(wqg + (size_t)k * 1072 + nd) : Z4; }); }
    { const float* wk = p.in[11]; const float* wv = p.in[16];
      cvt_family(scr, (bf16_t*)(ws + WS_WC1), 2, 256, 2048, [=](int b, int k, int nd, float& sc) { sc = 1.f; return LD4((b ? wv : wk) + (size_t)k * 256 + nd); }); }
    { const float* wk = p.in[13]; const float* wv = p.in[18];
      cvt_family(scr, (bf16_t*)(ws + WS_WC2), 2, 256, 256, [=](int b, int k, int nd, float& sc) { sc = 1.f; return nd < 64 ? LD4((b ? wv : wk) + (size_t)k * 64 + nd) : Z4; }); }
    { const float* wo = p.in[22];
      cvt_family(scr, (bf16_t*)(ws + WS_WO), 2, 1024, 1024, [=](int b, int k, int nd, float& sc) { sc = 1.f; return LD4(wo + ((size_t)b * 1024 + k) * 1024 + nd); }); }
    { const float* rg = p.in[23]; const float* re = p.in[25]; const float* nf = p.in[3];
      cvt_family(scr, (bf16_t*)(ws + WS_WR), 4, 256, 1024, [=](int b, int k, int nd, float& sc) {
          sc = nf[b * 1024 + k];
          if (nd < 32) return LD4(re + ((size_t)b * 1024 + k) * 32 + nd);
          if (nd == 128) return LD4(rg + ((size_t)b * 1024 + k) * 4);
          return Z4; }); }
    { const float* pp = p.in[30];
      cvt_family(scr, (bf16_t*)(ws + WS_WPP), 4, 1024, 256, [=](int b, int k, int nd, float& sc) { sc = 1.f; return LD4(pp + ((size_t)b * 256 + k) * 1024 + nd); }); }
    { const float* pg = p.in[31]; const float* np = p.in[4];
      cvt_family(scr, (bf16_t*)(ws + WS_WPG), 4, 1024, 1024, [=](int b, int k, int nd, float& sc) { sc = np[b * 1024 + k]; return LD4(pg + ((size_t)b * 1024 + k) * 1024 + nd); }); }
    { const float* w1 = p.in[27]; const float* w3 = p.in[28]; const float* nf = p.in[3];
      cvt_family(scr, (bf16_t*)(ws + WS_W13), 128, 1024, 1024, [=](int b, int k, int nd, float& sc) {
          const int c8 = nd >> 3, i = nd & 7; const long dlt = (const char*)w3 - (const char*)w1; const float* w = (const float*)((const char*)w1 + ((i < 4) ? 0l : dlt));
          sc = nf[(b >> 5) * 1024 + k]; return LD4(w + ((size_t)b * 1024 + k) * 512 + 4 * c8); }); }
    { const float* w2 = p.in[29];
      cvt_family(scr, (bf16_t*)(ws + WS_W2), 128, 1024, 512, [=](int b, int k, int nd, float& sc) { sc = 1.f; return LD4(w2 + ((size_t)b * 512 + k) * 1024 + nd); }); }
}

template <int W>
__device__ __forceinline__ void stencil_rows(const bf16_t* h, const LAS float* rs, const float gx, const float gy, bf16_t* pooled, int r0, int s0, int c0) {
    f32x2 buf[16];
#pragma unroll
    for (int j = 0; j < 16; ++j) buf[j] = (f32x2){0.f, 0.f};
    for (int ch = 0; ch < 9; ++ch) {
        f32x2 ld[16];
#pragma unroll
        for (int j = 0; j < 16; ++j) { const int rr = ch * 16 + j; const bool ok = (ch > 0) || (s0 > 0);
            const unsigned hw = ok ? *(const unsigned*)(h + (size_t)(r0 - 16 + rr) * DM + c0) : 0u; ld[j] = (f32x2){bf2f(hw & 0xffffu), bf2f(hw >> 16)}; }
#pragma unroll
        for (int j = 0; j < 16; ++j) { const int rr = ch * 16 + j; const float r = rs[rr];
            f32x2 xn; xn.x = ld[j].x * r * gx; xn.y = ld[j].y * r * gy;
            buf[j] = xn;
            if (ch > 0) {
                f32x2 s = xn;
#pragma unroll
                for (int i = 1; i < W; ++i) s = s + buf[(j - i) & 15];
                const int sp = s0 + rr - 16;
                const int cnt = (sp + 1 < W) ? (sp + 1) : W;
                const float ic = 1.f / (float)cnt;
                const float ox = s.x * ic - xn.x, oy = s.y * ic - xn.y;
                *(unsigned*)(pooled + (size_t)(r0 - 16 + rr) * DM + c0) = cvt_pk_bf16(ox, oy);
            }
        }
    }
}
__device__ __forceinline__ void stencil_phase(LAS unsigned char* lds, const bf16_t* h, const float* gain, bf16_t* pooled) {
    LAS float* rs = (LAS float*)lds;
    int tid_ = my_tid(); asm volatile("" : "+v"(tid_));
    const int tid = tid_, w = tid >> 6, lane = tid & 63;
    for (int it = blockIdx.x; it < T_TOK / 128; it += gridDim.x) {
        const int r0 = it * 128, s0 = r0 & (SEQ - 1);
        for (int rb = w; rb < 144; rb += 24) {
            u32x4 xw[3][2];
#pragma unroll
            for (int q3 = 0; q3 < 3; ++q3) { const int rr = rb + 8 * q3; const bool ok = (rr >= 16 || s0 > 0);
                const u32x4* xr = (const u32x4*)(h + (size_t)(ok ? r0 - 16 + rr : r0) * DM) + lane; xw[q3][0] = xr[0]; xw[q3][1] = xr[64]; }
#pragma unroll
            for (int q3 = 0; q3 < 3; ++q3) { const int rr = rb + 8 * q3; const bool ok = (rr >= 16 || s0 > 0); float s = 0.f;
#pragma unroll
                for (int j = 0; j < 2; ++j) { const unsigned ww[4] = {xw[q3][j].x, xw[q3][j].y, xw[q3][j].z, xw[q3][j].w};
#pragma unroll
                    for (int q = 0; q < 4; ++q) { const float a = bf2f(ww[q] & 0xffffu), b = bf2f(ww[q] >> 16); s += a * a + b * b; } }
                s = wave_sum(s); const float v = ok ? 1.f / sqrtf(s * (1.f / DM) + RMS_EPS) : 0.f;
                if (lane == 0) rs[rr] = v; }
        }
        __syncthreads();
        const int c0 = 2 * tid, gi = tid >> 7; const float gx = gain[c0], gy = gain[c0 + 1];
        if (gi == 0) stencil_rows<2>(h, rs, gx, gy, pooled, r0, s0, c0);
        else if (gi == 1) stencil_rows<4>(h, rs, gx, gy, pooled, r0, s0, c0);
        else if (gi == 2) stencil_rows<8>(h, rs, gx, gy, pooled, r0, s0, c0);
        else stencil_rows<16>(h, rs, gx, gy, pooled, r0, s0, c0);
        __syncthreads();
    }
}

__device__ __forceinline__ int moe_tables(LAS unsigned char* lds, const unsigned* counts) {
    LAS unsigned* pstart = (LAS unsigned*)(lds + LDS_MISC);
    LAS unsigned char* tile_e = lds + LDS_MISC + 256;
    __syncthreads();
    if (my_tid() == 0) { unsigned acc = 0;
        for (int e = 0; e < NEXP; ++e) { pstart[e] = acc; const unsigned nt = (counts[e] + 255u) >> 8; for (unsigned t = 0; t < nt; ++t) tile_e[(acc >> 8) + t] = (unsigned char)e; acc += nt << 8; }
        pstart[NEXP] = acc; }
    __syncthreads();
    return (int)(pstart[NEXP] >> 8);
}
__device__ __forceinline__ void scatter_phase(LAS unsigned char* lds, const unsigned* counts, unsigned* cursor, const int* toke, int* rowtab, unsigned* rowoff) {
    moe_tables(lds, counts);
    LAS unsigned* pstart = (LAS unsigned*)(lds + LDS_MISC);
    LAS unsigned* cl = (LAS unsigned*)(lds + LDS_MISC + 1024);
    const int tid = my_tid();
    for (int it = blockIdx.x; it < 2 * T_TOK / 256; it += gridDim.x) {
        if (tid < 64) cl[tid] = 0;
        __syncthreads();
        int a = -1, e = 0; unsigned rank = 0;
        if (tid < 256) { a = it * 256 + tid; e = toke[a]; rank = __hip_atomic_fetch_add(&cl[e], 1u, __ATOMIC_RELAXED, __HIP_MEMORY_SCOPE_WORKGROUP); }
        __syncthreads();
        if (tid < 32) { const unsigned n = cl[tid]; cl[32 + tid] = n ? __hip_atomic_fetch_add(cursor + tid, n, __ATOMIC_RELAXED, __HIP_MEMORY_SCOPE_AGENT) : 0u; }
        __syncthreads();
        if (tid < 256) { const unsigned pos = pstart[e] + cl[32 + e] + rank; rowtab[pos] = a; rowoff[pos] = (unsigned)(a >> 1) * 2048u; }
        __syncthreads();
    }
    if (blockIdx.x < NEXP) { const int e = blockIdx.x; const unsigned lo = pstart[e] + counts[e], hi = pstart[e + 1];
        for (unsigned pos = lo + tid; pos < hi; pos += 512) { rowtab[pos] = -1; rowoff[pos] = 0u; } }
}

__device__ __forceinline__ void e1_phase(const bf16_t* hin, const bf16_t* slot, bf16_t* hb, float* rsp) {
    int tid_ = my_tid(); asm volatile("" : "+v"(tid_));
    const int w = tid_ >> 6, lane = tid_ & 63;
    for (int row0 = (blockIdx.x * 8 + w) * 4; row0 < T_TOK; row0 += gridDim.x * 32) {
        u32x4 a[4][2], b[4][2], c[4][2];
#pragma unroll
        for (int q = 0; q < 4; ++q) { const int row = row0 + q;
            const u32x4* hr = (const u32x4*)(hin + (size_t)row * DM) + lane;
            const u32x4* s0 = (const u32x4*)(slot + (size_t)(2 * row) * DM) + lane; const u32x4* s1 = (const u32x4*)(slot + (size_t)(2 * row + 1) * DM) + lane;
#pragma unroll
            for (int j = 0; j < 2; ++j) { a[q][j] = hr[64 * j]; b[q][j] = s0[64 * j]; c[q][j] = s1[64 * j]; } }
#pragma unroll
        for (int q = 0; q < 4; ++q) { const int row = row0 + q;
            u32x4* ob = (u32x4*)(hb + (size_t)row * DM) + lane;
            float ss = 0.f;
#pragma unroll
            for (int j = 0; j < 2; ++j) {
                const unsigned aw[4] = {a[q][j].x, a[q][j].y, a[q][j].z, a[q][j].w}, bw[4] = {b[q][j].x, b[q][j].y, b[q][j].z, b[q][j].w}, cw[4] = {c[q][j].x, c[q][j].y, c[q][j].z, c[q][j].w}; unsigned ow[4];
#pragma unroll
                for (int k = 0; k < 4; ++k) { const float lo = bf2f(aw[k] & 0xffffu) + bf2f(bw[k] & 0xffffu) + bf2f(cw[k] & 0xffffu), hi = bf2f(aw[k] >> 16) + bf2f(bw[k] >> 16) + bf2f(cw[k] >> 16);
                    ow[k] = cvt_pk_bf16(lo, hi); const float rl = bf2f(ow[k] & 0xffffu), rh = bf2f(ow[k] >> 16); ss += rl * rl + rh * rh; }
                u32x4 o; o.x = ow[0]; o.y = ow[1]; o.z = ow[2]; o.w = ow[3]; ob[64 * j] = o; }
            ss = wave_sum(ss);
            if (lane == 0) rsp[row] = 1.f / sqrtf(ss * (1.f / DM) + RMS_EPS); }
    }
}
__device__ __forceinline__ void final_phase(const bf16_t* hin, float* out, const float* gain) {
    int tid_ = my_tid(); asm volatile("" : "+v"(tid_));
    const int w = tid_ >> 6, lane = tid_ & 63;
    const f32x4* gr = (const f32x4*)gain + lane;
    f32x4 gv[4];
#pragma unroll
    for (int j = 0; j < 4; ++j) gv[j] = gr[64 * j];
    for (int row0 = (blockIdx.x * 8 + w) * 4; row0 < T_TOK; row0 += gridDim.x * 32) {
        u32x2 x[4][4];
#pragma unroll
        for (int q = 0; q < 4; ++q) { const u32x2* hr = (const u32x2*)(hin + (size_t)(row0 + q) * DM) + lane;
#pragma unroll
            for (int j = 0; j < 4; ++j) x[q][j] = hr[64 * j]; }
#pragma unroll
        for (int q = 0; q < 4; ++q) { f32x4* orow = (f32x4*)(out + (size_t)(row0 + q) * DM) + lane;
            f32x4 v[4]; float ss = 0.f;
#pragma unroll
            for (int j = 0; j < 4; ++j) { v[j] = (f32x4){bf2f(x[q][j].x & 0xffffu), bf2f(x[q][j].x >> 16), bf2f(x[q][j].y & 0xffffu), bf2f(x[q][j].y >> 16)};
                ss += v[j].x * v[j].x + v[j].y * v[j].y + v[j].z * v[j].z + v[j].w * v[j].w; }
            ss = wave_sum(ss); const float r = 1.f / sqrtf(ss * (1.f / DM) + RMS_EPS);
#pragma unroll
            for (int j = 0; j < 4; ++j) orow[64 * j] = v[j] * r * gv[j]; }
    }
}
__device__ __forceinline__ void vtrans_phase(LAS unsigned char* lds, const bf16_t* vs, const bf16_t* vw, bf16_t* vst, bf16_t* vwt) {
    LAS bf16_t* tl = (LAS bf16_t*)lds;
    int tid_ = my_tid(); asm volatile("" : "+v"(tid_));
    const int tid = tid_;
    for (int it = blockIdx.x; it < 2 * 16 * 128; it += gridDim.x) {
        const int which = it >> 11, r = it & 2047, bg = r >> 7, kt = r & 127, b = bg >> 2, g = bg & 3;
        const bf16_t* src = which ? vw : vs; bf16_t* dst = which ? vwt : vst;
        { const int key = tid >> 3, ch = tid & 7;
          const u32x4 v = *(const u32x4*)(src + ((size_t)b * SEQ + kt * 64 + key) * 256 + g * 64 + ch * 8);
          const int kp = swap23(key);
          const unsigned wv[4] = {v.x, v.y, v.z, v.w};
#pragma unroll
          for (int i = 0; i < 4; ++i) { tl[(ch * 8 + 2 * i) * 72 + kp] = (bf16_t)(wv[i] & 0xffffu); tl[(ch * 8 + 2 * i + 1) * 72 + kp] = (bf16_t)(wv[i] >> 16); } }
        __syncthreads();
        { const int d = tid >> 3, ch = tid & 7;
          const u32x4 v = *(const LAS u32x4*)(tl + d * 72 + ch * 8);
          *(u32x4*)(dst + (((size_t)bg * 128 + kt) * 64 + d) * 64 + ch * 8) = v; }
        __syncthreads();
    }
}

struct AttnArgs { const bf16_t* q; const float* gates; const bf16_t* kc; const bf16_t* vct; const bf16_t* ks; const bf16_t* vst; const bf16_t* kw; const bf16_t* vwt; bf16_t* out; };
#define ATT_MFMA(a, b, c) __builtin_amdgcn_mfma_f32_32x32x16_bf16(a, b, c, 0, 0, 0)
#ifndef ATT_RING_N
#define ATT_RING_N 7
#endif
#ifndef ATT_AHEAD
#define ATT_AHEAD 2
#endif
constexpr int ATT_SLOT = 16384, ATT_RING = ATT_RING_N, ATT_IMP = ATT_RING * ATT_SLOT;
constexpr int ATT_DIST = ATT_RING - 2;
constexpr float ATT_THR = 8.f;
#ifndef ATT_DECOUPLED_RING
#define ATT_BARRIER_RING 1
#endif
#ifndef ATT_SLC_GROUP
#define ATT_SLC_GROUP 3
#endif
#ifndef ATT_SPARSE_QB
#define ATT_SPARSE_QB 1000
#endif
typedef float f32x8 __attribute__((ext_vector_type(8)));
__device__ __forceinline__ float hsum16(const f32x16 a) { const f32x8 b = a.lo + a.hi; const f32x4 c = b.lo + b.hi; const f32x2 d = c.lo + c.hi; return d.x + d.y; }
__device__ __forceinline__ float hmax16(const f32x16 a) {
    float m0 = fmaxf(fmaxf(a[0], a[1]), a[2]), m1 = fmaxf(fmaxf(a[3], a[4]), a[5]), m2 = fmaxf(fmaxf(a[6], a[7]), a[8]), m3 = fmaxf(fmaxf(a[9], a[10]), a[11]), m4 = fmaxf(fmaxf(a[12], a[13]), a[14]);
    return fmaxf(fmaxf(fmaxf(m0, m1), fmaxf(m2, m3)), fmaxf(m4, a[15]));
}
template <bool MASKED, bool ONLINE, bool DO_PV, bool DO_IMP>
__device__ __forceinline__ void attn_step(const LAS unsigned char* Kb, const LAS unsigned char* Vb, const bf16x8 (&Qf)[4], const int (&ro)[4],
                                          const int lo4, const int hi4, const bool rowsel, f32x16& O0, f32x16& O1, float& mref, float& lsum,
                                          LAS float* impw, const int jbase, const int lane, LAS unsigned* qkc = nullptr, const unsigned qkv = 0u) {
    f32x16 S0, S1;
    bool pre; float mr0;
    if (ONLINE) { pre = (__ballot(mref < -1e29f) == 0ull); mr0 = (MASKED || rowsel) ? mref : 1e30f; }
    else { pre = true; mr0 = mref; }
    const float sinit = pre ? -mr0 : 0.f;
#pragma unroll
    for (int r = 0; r < 16; ++r) { S0[r] = sinit; S1[r] = sinit; }
    { bf16x8 KA[4], KB[4];
#pragma unroll
      for (int ks = 0; ks < 4; ++ks) { KA[ks] = *(const LAS bf16x8*)(Kb + ro[ks]); KB[ks] = *(const LAS bf16x8*)(Kb + 4096 + ro[ks]); }
      __builtin_amdgcn_sched_barrier(0);
#pragma unroll
      for (int ks = 0; ks < 4; ++ks) { S0 = ATT_MFMA(KA[ks], Qf[ks], S0); S1 = ATT_MFMA(KB[ks], Qf[ks], S1); } }
    bf16x8 VA[4], VB[4];
    if (DO_PV) {
        __builtin_amdgcn_sched_barrier(0);
#pragma unroll
        for (int k4 = 0; k4 < 4; ++k4) { VA[k4] = *(const LAS bf16x8*)(Vb + ro[k4]); VB[k4] = *(const LAS bf16x8*)(Vb + 4096 + ro[k4]); }
    }
    if (qkc != nullptr) { __builtin_amdgcn_sched_barrier(0); if (lane == 0) __hip_atomic_store(qkc, qkv, __ATOMIC_RELAXED, __HIP_MEMORY_SCOPE_WORKGROUP); }
    __builtin_amdgcn_sched_barrier(0);
    if (MASKED) {
        int lo_o = lo4, hi_o = hi4; asm volatile("" : "+v"(lo_o), "+v"(hi_o));
        const int lo_c = lo_o < 0 ? 0 : lo_o, hi_c = hi_o > 63 ? 63 : hi_o;
        unsigned long long vm = (hi_c >= 63) ? ~0ull : ((1ull << (hi_c + 1)) - 1ull);
        vm &= ~((1ull << lo_c) - 1ull);
        if (hi_c < lo_c) vm = 0ull;
        const unsigned vlo = (unsigned)vm, vhi = (unsigned)(vm >> 32);
        const unsigned negbits = __float_as_uint(-1e30f);
#pragma unroll
        for (int r = 0; r < 16; ++r) { const int cr = (r & 3) + 8 * (r >> 2);
            const unsigned m0 = (unsigned)__builtin_amdgcn_sbfe((int)vlo, cr, 1), m1 = (unsigned)__builtin_amdgcn_sbfe((int)vhi, cr, 1);
            S0[r] = __uint_as_float((__float_as_uint(S0[r]) & m0) | (negbits & ~m0));
            S1[r] = __uint_as_float((__float_as_uint(S1[r]) & m1) | (negbits & ~m1)); }
    }
    if (ONLINE) {
        if (!pre) {
            float mx = fmaxf(hmax16(S0), hmax16(S1));
            mx = fmaxf(mx, __shfl_xor(mx, 32));
            if (!MASKED && !rowsel) mx = -1e30f;
            const bool grow = (mref < -1e29f) && (mx > -1e29f);
            if (__ballot(grow) != 0ull) mref = grow ? mx : mref;
            const float mr = ((MASKED || rowsel) && mref > -1e29f) ? mref : 1e30f;
            S0 = S0 - mr; S1 = S1 - mr;
        }
    }
#pragma unroll
    for (int r = 0; r < 16; ++r) { S0[r] = __builtin_amdgcn_exp2f(S0[r]); S1[r] = __builtin_amdgcn_exp2f(S1[r]); }
    if (ONLINE) lsum += hsum16(S0 + S1);
    if (DO_IMP) {
#pragma unroll
        for (int kh = 0; kh < 2; ++kh)
#pragma unroll
            for (int q4 = 0; q4 < 4; ++q4) {
                float G, E;
                if (kh == 0) { G = (S0[4 * q4] + S0[4 * q4 + 1]) + (S0[4 * q4 + 2] + S0[4 * q4 + 3]); E = S0[4 * q4 + 3]; }
                else         { G = (S1[4 * q4] + S1[4 * q4 + 1]) + (S1[4 * q4 + 2] + S1[4 * q4 + 3]); E = S1[4 * q4 + 3]; }
                G += __builtin_bit_cast(float, __builtin_amdgcn_mov_dpp(__builtin_bit_cast(int, G), 0xB1, 0xF, 0xF, true)); G += __builtin_bit_cast(float, __builtin_amdgcn_mov_dpp(__builtin_bit_cast(int, G), 0x4E, 0xF, 0xF, true));
                E += __builtin_bit_cast(float, __builtin_amdgcn_mov_dpp(__builtin_bit_cast(int, E), 0xB1, 0xF, 0xF, true)); E += __builtin_bit_cast(float, __builtin_amdgcn_mov_dpp(__builtin_bit_cast(int, E), 0x4E, 0xF, 0xF, true));
                const int jj = jbase + 8 * kh + 2 * q4 + (lane >> 5);
                if ((lane & 3) == 0) { impw[jj] += G; if (jj + 1 < 128) impw[jj + 1] += E; }
            }
    }
    __builtin_amdgcn_sched_barrier(0);
    if (DO_PV) {
        bf16x8 Pf[4];
        { u32x4 pk; pk.x = cvt_pk_bf16(S0[0], S0[1]); pk.y = cvt_pk_bf16(S0[2], S0[3]); pk.z = cvt_pk_bf16(S0[4], S0[5]); pk.w = cvt_pk_bf16(S0[6], S0[7]); Pf[0] = __builtin_bit_cast(bf16x8, pk); }
        { u32x4 pk; pk.x = cvt_pk_bf16(S0[8], S0[9]); pk.y = cvt_pk_bf16(S0[10], S0[11]); pk.z = cvt_pk_bf16(S0[12], S0[13]); pk.w = cvt_pk_bf16(S0[14], S0[15]); Pf[1] = __builtin_bit_cast(bf16x8, pk); }
        { u32x4 pk; pk.x = cvt_pk_bf16(S1[0], S1[1]); pk.y = cvt_pk_bf16(S1[2], S1[3]); pk.z = cvt_pk_bf16(S1[4], S1[5]); pk.w = cvt_pk_bf16(S1[6], S1[7]); Pf[2] = __builtin_bit_cast(bf16x8, pk); }
        { u32x4 pk; pk.x = cvt_pk_bf16(S1[8], S1[9]); pk.y = cvt_pk_bf16(S1[10], S1[11]); pk.z = cvt_pk_bf16(S1[12], S1[13]); pk.w = cvt_pk_bf16(S1[14], S1[15]); Pf[3] = __builtin_bit_cast(bf16x8, pk); }
        __builtin_amdgcn_sched_barrier(0);
#pragma unroll
        for (int k4 = 0; k4 < 4; ++k4) { O0 = ATT_MFMA(VA[k4], Pf[k4], O0); O1 = ATT_MFMA(VB[k4], Pf[k4], O1); }
    }
}

template <bool FIRST>
__device__ __forceinline__ void attn_out_acc(bf16_t* orow, const f32x16& O0, const f32x16& O1, const float sc, const int h) {
#pragma unroll
    for (int rq = 0; rq < 4; ++rq) {
        u32x2* p0 = (u32x2*)(orow + 8 * rq + 4 * h); u32x2* p1 = (u32x2*)(orow + 32 + 8 * rq + 4 * h);
        float a0 = 0.f, a1 = 0.f, a2 = 0.f, a3 = 0.f, b0 = 0.f, b1 = 0.f, b2 = 0.f, b3 = 0.f;
        if (!FIRST) { const u32x2 x = *p0, y = *p1; a0 = bf2f(x.x & 0xffffu); a1 = bf2f(x.x >> 16); a2 = bf2f(x.y & 0xffffu); a3 = bf2f(x.y >> 16);
            b0 = bf2f(y.x & 0xffffu); b1 = bf2f(y.x >> 16); b2 = bf2f(y.y & 0xffffu); b3 = bf2f(y.y >> 16); }
        u32x2 o; o.x = cvt_pk_bf16(a0 + sc * O0[4 * rq], a1 + sc * O0[4 * rq + 1]); o.y = cvt_pk_bf16(a2 + sc * O0[4 * rq + 2], a3 + sc * O0[4 * rq + 3]); *p0 = o;
        u32x2 o2; o2.x = cvt_pk_bf16(b0 + sc * O1[4 * rq], b1 + sc * O1[4 * rq + 1]); o2.y = cvt_pk_bf16(b2 + sc * O1[4 * rq + 2], b3 + sc * O1[4 * rq + 3]); *p1 = o2;
    }
}
__device__ __forceinline__ void attn_out_load(const bf16_t* orow, u32x2 (&X)[4], u32x2 (&Y)[4], const int h) {
#pragma unroll
    for (int rq = 0; rq < 4; ++rq) { X[rq] = *(const u32x2*)(orow + 8 * rq + 4 * h); Y[rq] = *(const u32x2*)(orow + 32 + 8 * rq + 4 * h); }
}
__device__ __forceinline__ void attn_out_fin(bf16_t* orow, const u32x2 (&X)[4], const u32x2 (&Y)[4], const f32x16& O0, const f32x16& O1, const float sc, const int h) {
#pragma unroll
    for (int rq = 0; rq < 4; ++rq) {
        u32x2* p0 = (u32x2*)(orow + 8 * rq + 4 * h); u32x2* p1 = (u32x2*)(orow + 32 + 8 * rq + 4 * h);
        const u32x2 x = X[rq], y = Y[rq];
        const float a0 = bf2f(x.x & 0xffffu), a1 = bf2f(x.x >> 16), a2 = bf2f(x.y & 0xffffu), a3 = bf2f(x.y >> 16);
        const float b0 = bf2f(y.x & 0xffffu), b1 = bf2f(y.x >> 16), b2 = bf2f(y.y & 0xffffu), b3 = bf2f(y.y >> 16);
        u32x2 o; o.x = cvt_pk_bf16(a0 + sc * O0[4 * rq], a1 + sc * O0[4 * rq + 1]); o.y = cvt_pk_bf16(a2 + sc * O0[4 * rq + 2], a3 + sc * O0[4 * rq + 3]); *p0 = o;
        u32x2 o2; o2.x = cvt_pk_bf16(b0 + sc * O1[4 * rq], b1 + sc * O1[4 * rq + 1]); o2.y = cvt_pk_bf16(b2 + sc * O1[4 * rq + 2], b3 + sc * O1[4 * rq + 3]); *p1 = o2;
    }
}
__device__ __forceinline__ unsigned lds_ld_u32(LAS unsigned* p) { unsigned v; asm volatile("ds_read_b32 %0, %1\n\ts_waitcnt lgkmcnt(0)" : "=v"(v) : "v"((unsigned)(uintptr_t)p) : "memory"); return v; }
__device__ __forceinline__ void lds_add_u32(LAS unsigned* p, unsigned v) { asm volatile("ds_add_u32 %0, %1" :: "v"((unsigned)(uintptr_t)p), "v"(v) : "memory"); }
__device__ __forceinline__ void lds_add_f32(LAS float* p, float v) { asm volatile("ds_add_f32 %0, %1" :: "v"((unsigned)(uintptr_t)p), "v"(v) : "memory"); }
constexpr bool ATT_HAS_SPARSE = ATT_SPARSE_QB <= 127;
constexpr int ATT_OACC = ATT_IMP;
constexpr int ATT_LIST = ATT_OACC + (ATT_HAS_SPARSE ? 65536 : 32768);
constexpr int ATT_CNT  = ATT_LIST + (ATT_HAS_SPARSE ? 8192 : 0);
constexpr int ATT_SELM2 = ATT_CNT + 128;
constexpr int ATT_LACC = ATT_SELM2 + 1024;
constexpr int ATT_RREF = ATT_LACC + 1024;
constexpr int ATT_CTR  = ATT_RREF + 1024;
static_assert(ATT_CTR + 128 <= LDS_BYTES - 16, "attention LDS map");
__device__ __forceinline__ int oacc_idx(int R, int d) { return R * 64 + ((((d >> 2) ^ R) & 15) << 2) + (d & 3); }

__device__ __forceinline__ void attn_sparse_task(const LAS unsigned char* Kb, const LAS unsigned char* Vb, const bf16x8 (&Qf)[4], const int (&ro)[4],
                                                 const float rr, const bool valid, const int R, LAS float* oacc, LAS float* lacc, const int h) {
    f32x16 S0, S1;
#pragma unroll
    for (int r = 0; r < 16; ++r) { S0[r] = 0.f; S1[r] = 0.f; }
    { bf16x8 KA[4], KB[4];
#pragma unroll
      for (int ks = 0; ks < 4; ++ks) { KA[ks] = *(const LAS bf16x8*)(Kb + ro[ks]); KB[ks] = *(const LAS bf16x8*)(Kb + 4096 + ro[ks]); }
#pragma unroll
      for (int ks = 0; ks < 4; ++ks) { S0 = ATT_MFMA(KA[ks], Qf[ks], S0); S1 = ATT_MFMA(KB[ks], Qf[ks], S1); } }
    S0 = S0 - rr; S1 = S1 - rr;
#pragma unroll
    for (int r = 0; r < 16; ++r) { S0[r] = __builtin_amdgcn_exp2f(S0[r]); S1[r] = __builtin_amdgcn_exp2f(S1[r]); }
    float rs = hsum16(S0 + S1); rs += __shfl_xor(rs, 32);
    bf16x8 Pf[4];
    { u32x4 pk; pk.x = cvt_pk_bf16(S0[0], S0[1]); pk.y = cvt_pk_bf16(S0[2], S0[3]); pk.z = cvt_pk_bf16(S0[4], S0[5]); pk.w = cvt_pk_bf16(S0[6], S0[7]); Pf[0] = __builtin_bit_cast(bf16x8, pk); }
    { u32x4 pk; pk.x = cvt_pk_bf16(S0[8], S0[9]); pk.y = cvt_pk_bf16(S0[10], S0[11]); pk.z = cvt_pk_bf16(S0[12], S0[13]); pk.w = cvt_pk_bf16(S0[14], S0[15]); Pf[1] = __builtin_bit_cast(bf16x8, pk); }
    { u32x4 pk; pk.x = cvt_pk_bf16(S1[0], S1[1]); pk.y = cvt_pk_bf16(S1[2], S1[3]); pk.z = cvt_pk_bf16(S1[4], S1[5]); pk.w = cvt_pk_bf16(S1[6], S1[7]); Pf[2] = __builtin_bit_cast(bf16x8, pk); }
    { u32x4 pk; pk.x = cvt_pk_bf16(S1[8], S1[9]); pk.y = cvt_pk_bf16(S1[10], S1[11]); pk.z = cvt_pk_bf16(S1[12], S1[13]); pk.w = cvt_pk_bf16(S1[14], S1[15]); Pf[3] = __builtin_bit_cast(bf16x8, pk); }
    f32x16 T0, T1;
#pragma unroll
    for (int r = 0; r < 16; ++r) { T0[r] = 0.f; T1[r] = 0.f; }
    { bf16x8 VA[4], VB[4];
#pragma unroll
      for (int k4 = 0; k4 < 4; ++k4) { VA[k4] = *(const LAS bf16x8*)(Vb + ro[k4]); VB[k4] = *(const LAS bf16x8*)(Vb + 4096 + ro[k4]); }
#pragma unroll
      for (int k4 = 0; k4 < 4; ++k4) { T0 = ATT_MFMA(VA[k4], Pf[k4], T0); T1 = ATT_MFMA(VB[k4], Pf[k4], T1); } }
    if (valid) {
        if (h == 0) lacc[R] += rs;
#pragma unroll
        for (int q = 0; q < 4; ++q) {
            LAS f32x4* p0 = (LAS f32x4*)(oacc + oacc_idx(R, 8 * q + 4 * h)); LAS f32x4* p1 = (LAS f32x4*)(oacc + oacc_idx(R, 32 + 8 * q + 4 * h));
            const f32x4 a = *p0, b = *p1;
            *p0 = a + (f32x4){T0[4 * q], T0[4 * q + 1], T0[4 * q + 2], T0[4 * q + 3]}; *p1 = b + (f32x4){T1[4 * q], T1[4 * q + 1], T1[4 * q + 2], T1[4 * q + 3]}; }
    }
}

__device__ __forceinline__ void attn_phase(LAS unsigned char* lds, unsigned* qctr) {
    int tid_ = my_tid(); asm volatile("" : "+v"(tid_));
    const int tid = tid_, w = __builtin_amdgcn_readfirstlane(tid >> 6), lane = tid & 63, n = lane & 31, h = lane >> 5;
    LAS float* imp = (LAS float*)(lds + ATT_IMP); LAS unsigned* selm = (LAS unsigned*)(lds + ATT_SELM2);
    LAS float* oacc = (LAS float*)(lds + ATT_OACC); LAS float* lacc = (LAS float*)(lds + ATT_LACC); LAS float* rref = (LAS float*)(lds + ATT_RREF);
    LAS unsigned char* lists = lds + ATT_LIST; LAS unsigned char* cnts = lds + ATT_CNT;
    LAS unsigned* cready = (LAS unsigned*)(lds + ATT_CTR); LAS unsigned* cdone = cready + 8;
    int ro[4];
#pragma unroll
    for (int ks = 0; ks < 4; ++ks) ro[ks] = n * 128 + (((2 * ks + h) ^ ((n >> 1) & 7)) << 4);
    const int drow = 8 * w + (lane >> 3);
    const unsigned dsrc = (unsigned)(drow * 128 + (((lane & 7) ^ ((drow >> 1) & 7)) << 4));
    LAS int* itbox = (LAS int*)(lds + ATT_CTR + 96);
    for (;;) {
        if (tid == 0) *itbox = (int)__hip_atomic_fetch_add(qctr, 1u, __ATOMIC_RELAXED, __HIP_MEMORY_SCOPE_AGENT);
        asm volatile("s_waitcnt vmcnt(0) lgkmcnt(0)\n\ts_barrier" ::: "memory");
        const int it = __builtin_amdgcn_readfirstlane(*itbox);
        if (it >= 2048) break;
        const int qb = 127 - (it >> 4), bg = it & 15, b = bg >> 2, g = bg & 3;
        const int tl = w * 8 + (n >> 2), t = qb * 64 + tl, hd = g * 4 + (n & 3);
        const size_t trow0 = (size_t)b * SEQ + qb * 64, trow = trow0 + tl;
        const bool sparse = ATT_HAS_SPARSE && qb >= ATT_SPARSE_QB;
        bf16x8 Qf[4]; float g0, g1, g2; const char* kcb; const char* ksb; const bf16_t* qp;
        { unsigned char* ws = kparams()->ws; qp = (const bf16_t*)(ws + WS_Q); const float* gp = (const float*)(ws + WS_GATES);
#pragma unroll
          for (int s = 0; s < 4; ++s) Qf[s] = *(const bf16x8*)(qp + trow * 1024 + hd * 64 + 16 * s + 8 * h);
          g0 = gp[trow * 48 + hd * 3 + 0]; g1 = gp[trow * 48 + hd * 3 + 1]; g2 = gp[trow * 48 + hd * 3 + 2];
          kcb = (const char*)(ws + WS_KC + (size_t)bg * 512 * 64 * 2); ksb = (const char*)(ws + WS_KS + (size_t)bg * SEQ * 64 * 2); }
        const int nct = (4 * qb + 3 + 63) >> 6, wlo = qb > 8 ? qb - 8 : 0, nwin = qb - wlo + 1;
        const int e0 = nct, e1 = 2 * nct, e2 = 2 * nct + qb + 1, total = e2 + nwin;
        const int limc = (t >= 31) ? ((t - 31) >> 4) : -1;
        static_assert(WS_VCT - WS_KC == (size_t)1 << 20 && WS_KW - WS_KS == (size_t)1 << 24 && WS_VST - WS_KS == (size_t)2 << 24 && WS_VWT - WS_KW == (size_t)2 << 24, "attention tile streams rely on this workspace order");
#define ATT_SLCJ(i_) (sparse ? ((i_) == 0 ? 0 : (i_) == 1 ? qb - 1 : (i_) == 2 ? qb : (i_) - 2) : (i_))
#define ATT_ISSUE(s_) do { const int s__ = (s_); const char* kp; const char* vp; \
            if (s__ < e1) { const int ct = s__ < e0 ? s__ : s__ - e0; kp = kcb + (size_t)ct * 8192; vp = kp + ((size_t)1 << 20); } \
            else if (s__ < e2) { const int i__ = s__ - e1; const int j = ATT_SLCJ(i__); kp = ksb + (size_t)j * 8192; vp = kp + ((size_t)2 << 24); } \
            else { const int kt = wlo + s__ - e2; kp = ksb + ((size_t)1 << 24) + (size_t)kt * 8192; vp = kp + ((size_t)2 << 24); } \
            LAS unsigned char* sl = lds + (s__ % ATT_RING) * ATT_SLOT + w * 1024; \
            __builtin_amdgcn_global_load_lds((const unsigned*)(kp + dsrc), (LAS unsigned*)sl, 16, 0, 0); \
            __builtin_amdgcn_global_load_lds((const unsigned*)(vp + dsrc), (LAS unsigned*)(sl + 8192), 16, 0, 0); } while (0)
#define ATT_WAITC(ptr_, tgt_) do { const unsigned tg__ = (tgt_); while ((unsigned)__builtin_amdgcn_readfirstlane((int)lds_ld_u32(ptr_)) < tg__) __builtin_amdgcn_s_sleep(1); } while (0)
#define ATT_SIG(ptr_) do { if (lane == 0) lds_add_u32((ptr_), 1u); } while (0)
#define ATT_VMW(n_) do { const int nv__ = (n_); if (nv__ >= 5) asm volatile("s_waitcnt vmcnt(10)" ::: "memory"); else if (nv__ == 4) asm volatile("s_waitcnt vmcnt(8)" ::: "memory"); \
            else if (nv__ == 3) asm volatile("s_waitcnt vmcnt(6)" ::: "memory"); else if (nv__ == 2) asm volatile("s_waitcnt vmcnt(4)" ::: "memory"); \
            else if (nv__ == 1) asm volatile("s_waitcnt vmcnt(2)" ::: "memory"); else asm volatile("s_waitcnt vmcnt(0)" ::: "memory"); } while (0)
#ifdef ATT_BARRIER_RING
#define ATT_HEAD(s_) do { const int sh = (s_); if (sh + ATT_RING - 1 < total) ATT_ISSUE(sh + ATT_RING - 1); } while (0)
#define ATT_TAILN(nf_) do { const int nf__ = (nf_); \
            if (nf__ >= 5) asm volatile("s_waitcnt vmcnt(10) lgkmcnt(0)\n\ts_barrier" ::: "memory"); else if (nf__ == 4) asm volatile("s_waitcnt vmcnt(8) lgkmcnt(0)\n\ts_barrier" ::: "memory"); \
            else if (nf__ == 3) asm volatile("s_waitcnt vmcnt(6) lgkmcnt(0)\n\ts_barrier" ::: "memory"); else if (nf__ == 2) asm volatile("s_waitcnt vmcnt(4) lgkmcnt(0)\n\ts_barrier" ::: "memory"); \
            else if (nf__ == 1) asm volatile("s_waitcnt vmcnt(2) lgkmcnt(0)\n\ts_barrier" ::: "memory"); else asm volatile("s_waitcnt vmcnt(0) lgkmcnt(0)\n\ts_barrier" ::: "memory"); } while (0)
#define ATT_TAIL(s_) do { int nf = total - 2 - (s_); nf = nf < 0 ? 0 : (nf > ATT_RING - 2 ? ATT_RING - 2 : nf); ATT_TAILN(nf); } while (0)
#else
#define ATT_HEAD(s_) do { const int sh = (s_); \
            if (sh + ATT_DIST < total) { if (sh >= 2) ATT_WAITC(cdone + (sh - 2) % ATT_RING, 8u * (unsigned)((sh - 2) / ATT_RING + 1)); ATT_ISSUE(sh + ATT_DIST); } \
            { int nf = total - 1 - (sh + ATT_AHEAD); nf = nf < 0 ? 0 : (nf > ATT_DIST - ATT_AHEAD ? ATT_DIST - ATT_AHEAD : nf); ATT_VMW(nf); }     \
            if (sh + ATT_AHEAD < total) ATT_SIG(cready + (sh + ATT_AHEAD) % ATT_RING); \
            ATT_WAITC(cready + sh % ATT_RING, 8u * (unsigned)(sh / ATT_RING + 1)); } while (0)
#define ATT_TAIL(s_) do { asm volatile("s_waitcnt lgkmcnt(0)" ::: "memory"); ATT_SIG(cdone + (s_) % ATT_RING); } while (0)
#endif
#define ATT_BAR() asm volatile("s_waitcnt lgkmcnt(0)\n\ts_barrier" ::: "memory")
        asm volatile("s_waitcnt vmcnt(0) lgkmcnt(0)\n\ts_barrier" ::: "memory");
        for (int i = tid; i < 2048; i += 512) ((LAS f32x4*)imp)[i] = (f32x4){0.f, 0.f, 0.f, 0.f};
        if (tid < 16) cready[tid] = 0u;
        ATT_BAR();
        static_assert(ATT_DIST >= 2 && ATT_DIST <= 6 && ATT_AHEAD >= 1 && ATT_AHEAD < ATT_DIST && ATT_DIST - ATT_AHEAD <= 5, "ring geometry");
#ifdef ATT_BARRIER_RING
        static_assert(ATT_RING >= 3 && ATT_RING <= 7, "ring geometry");
#pragma unroll
        for (int i = 0; i < ATT_RING - 1; ++i) if (i < total) ATT_ISSUE(i);
        { const int issued = total < ATT_RING - 1 ? total : ATT_RING - 1; ATT_VMW(issued - 1); }
        asm volatile("s_barrier" ::: "memory");
#else
#pragma unroll
        for (int i = 0; i < ATT_DIST; ++i) if (i < total) ATT_ISSUE(i);
        { const int issued = total < ATT_DIST ? total : ATT_DIST; ATT_VMW(issued - ATT_AHEAD); }
#pragma unroll
        for (int i = 0; i < ATT_AHEAD; ++i) ATT_SIG(cready + i);
#endif
        f32x16 O0, O1; u32x2 OX[4], OY[4];
#pragma unroll
        for (int r = 0; r < 16; ++r) { O0[r] = 0.f; O1[r] = 0.f; }
        float mref = -1e30f, lsum = 0.f;
        int s = 0;
        for (; s < e0; ++s) {
            ATT_HEAD(s);
            const LAS unsigned char* Kb = lds + (s % ATT_RING) * ATT_SLOT; const int hi = limc - 64 * s;
            if (__ballot(hi < 63) == 0ull) attn_step<false, true, false, false>(Kb, Kb + 8192, Qf, ro, 0, 0, true, O0, O1, mref, lsum, nullptr, 0, lane);
            else if (__ballot(hi >= 0) != 0ull) attn_step<true, true, false, false>(Kb, Kb + 8192, Qf, ro, -4 * h, (hi > 63 ? 63 : hi) - 4 * h, true, O0, O1, mref, lsum, nullptr, 0, lane);
            ATT_TAIL(s);
        }
        lsum += __shfl_xor(lsum, 32);
        float mc2 = (lsum > 0.f) ? mref + __builtin_amdgcn_logf(lsum) : 1e30f;
        for (; s < e1; ++s) {
            ATT_HEAD(s);
            const LAS unsigned char* Kb = lds + (s % ATT_RING) * ATT_SLOT; const int ct = s - e0; const int hi = limc - 64 * ct;
            float dummy = 0.f;
            if (__ballot(hi < 63) == 0ull) attn_step<false, false, true, true>(Kb, Kb + 8192, Qf, ro, 0, 0, true, O0, O1, mc2, dummy, imp + tl * 128, 16 * ct, lane);
            else if (__ballot(hi >= 0) != 0ull) attn_step<true, false, true, true>(Kb, Kb + 8192, Qf, ro, -4 * h, (hi > 63 ? 63 : hi) - 4 * h, true, O0, O1, mc2, dummy, imp + tl * 128, 16 * ct, lane);
            ATT_TAIL(s);
        }
        attn_out_acc<true>((bf16_t*)(kparams()->ws + WS_ACT) + trow * 1024 + hd * 64, O0, O1, g0, h);
#pragma unroll
        for (int r = 0; r < 16; ++r) { O0[r] = 0.f; O1[r] = 0.f; }
        mref = -1e30f; lsum = 0.f;
        {
            for (int tk = 0; tk < 8; ++tk) {
                const int tok = w * 8 + tk; unsigned long long mlo, mhi;
                if (qb < 16) { mlo = (2ull << qb) - 1ull; mhi = 0ull; }
                else {
                    const float c0 = imp[tok * 128 + lane], c1 = imp[tok * 128 + 64 + lane];
                    const unsigned k0 = ((lane >= 1) && (lane <= qb - 2)) ? __float_as_uint(c0) + 1u : 0u;
                    const unsigned k1 = ((64 + lane) <= qb - 2) ? __float_as_uint(c1) + 1u : 0u;
                    unsigned T = 0u;
                    for (int bit = 30; bit >= 0; --bit) { const unsigned cand = T | (1u << bit);
                        const int cnt = __popcll(__ballot(k0 >= cand)) + __popcll(__ballot(k1 >= cand));
                        if (cnt >= 13) T = cand; }
                    unsigned long long gt0 = __ballot(k0 > T), gt1 = __ballot(k1 > T), eq0 = __ballot(k0 == T), eq1 = __ballot(k1 == T);
                    int need = 13 - __popcll(gt0) - __popcll(gt1);
                    while (need > 0 && eq0) { const unsigned long long low = eq0 & (0ull - eq0); gt0 |= low; eq0 ^= low; --need; }
                    while (need > 0 && eq1) { const unsigned long long low = eq1 & (0ull - eq1); gt1 |= low; eq1 ^= low; --need; }
                    mlo = gt0 | 1ull; mhi = gt1;
                    const int f1 = qb, f2 = qb - 1;
                    if (f1 < 64) mlo |= 1ull << f1; else mhi |= 1ull << (f1 - 64);
                    if (f2 < 64) mlo |= 1ull << f2; else mhi |= 1ull << (f2 - 64);
                }
                if (lane == 0) { selm[tok * 4 + 0] = (unsigned)mlo; selm[tok * 4 + 1] = (unsigned)(mlo >> 32); selm[tok * 4 + 2] = (unsigned)mhi; selm[tok * 4 + 3] = (unsigned)(mhi >> 32); }
            }
        }
        if (!sparse) {
            const unsigned mw0 = selm[tl * 4 + 0], mw1 = selm[tl * 4 + 1], mw2 = selm[tl * 4 + 2], mw3 = selm[tl * 4 + 3];
#if defined(ATT_BARRIER_RING) && ATT_SLC_GROUP > 1
            if (s + ATT_SLC_GROUP - 1 < e2 - 1) {
                int nis = s + ATT_RING - 1;
                { int last = s + ATT_RING - 2; last = last < total - 1 ? last : total - 1; const int nf = last - (s + ATT_SLC_GROUP - 1); ATT_TAILN(nf < 0 ? 0 : nf); }
                while (s + ATT_SLC_GROUP - 1 < e2 - 1) {
                    while (nis < total && nis <= s + ATT_RING - 1) { ATT_ISSUE(nis); ++nis; }
#pragma unroll 1
                    for (int u = 0; u < ATT_SLC_GROUP; ++u) {
                        const int su = s + u; const LAS unsigned char* Kb = lds + (su % ATT_RING) * ATT_SLOT; const int j = su - e1;
                        const unsigned wsel = (j < 32) ? mw0 : (j < 64) ? mw1 : (j < 96) ? mw2 : mw3;
                        const bool sel = (wsel >> (j & 31)) & 1u;
                        if (__ballot(sel) != 0ull) attn_step<false, true, true, false>(Kb, Kb + 8192, Qf, ro, 0, 0, sel, O0, O1, mref, lsum, nullptr, 0, lane);
                    }
                    { const int nf = nis - 1 - (s + 2 * ATT_SLC_GROUP - 1); ATT_TAILN(nf < 0 ? 0 : nf); }
                    s += ATT_SLC_GROUP;
                }
                while (nis < total && nis <= s + ATT_RING - 2) { ATT_ISSUE(nis); ++nis; }
            }
#endif
            for (; s < e2 - 1; ++s) {
                ATT_HEAD(s);
                const LAS unsigned char* Kb = lds + (s % ATT_RING) * ATT_SLOT; const int j = s - e1;
                const unsigned wsel = (j < 32) ? mw0 : (j < 64) ? mw1 : (j < 96) ? mw2 : mw3;
                const bool sel = (wsel >> (j & 31)) & 1u;
                if (__ballot(sel) != 0ull) attn_step<false, true, true, false>(Kb, Kb + 8192, Qf, ro, 0, 0, sel, O0, O1, mref, lsum, nullptr, 0, lane);
                ATT_TAIL(s);
            }
            attn_out_load((const bf16_t*)(kparams()->ws + WS_ACT) + trow * 1024 + hd * 64, OX, OY, h);
            { ATT_HEAD(s);
              const LAS unsigned char* Kb = lds + (s % ATT_RING) * ATT_SLOT;
              attn_step<true, true, true, false>(Kb, Kb + 8192, Qf, ro, -4 * h, tl - 4 * h, true, O0, O1, mref, lsum, nullptr, 0, lane);
              ATT_TAIL(s); ++s; }
        } else {
            ATT_BAR();
            for (int jj = w; jj < qb - 2; jj += 8) { const int j = jj + 1;
                const unsigned wsel = selm[lane * 4 + (j >> 5)]; const bool bit = (wsel >> (j & 31)) & 1u;
                const unsigned long long bm = __ballot(bit);
                if (bit) lists[jj * 64 + __popcll(bm & ((1ull << lane) - 1ull))] = (unsigned char)lane;
                if (lane == 0) cnts[jj] = (unsigned char)__popcll(bm); }
            for (int i3 = 0; i3 < 2; ++i3, ++s) {
                ATT_HEAD(s);
                const LAS unsigned char* Kb = lds + (s % ATT_RING) * ATT_SLOT;
                attn_step<false, true, true, false>(Kb, Kb + 8192, Qf, ro, 0, 0, true, O0, O1, mref, lsum, nullptr, 0, lane);
                ATT_TAIL(s);
            }
            { ATT_HEAD(s);
              const LAS unsigned char* Kb = lds + (s % ATT_RING) * ATT_SLOT;
              attn_step<true, true, true, false>(Kb, Kb + 8192, Qf, ro, -4 * h, tl - 4 * h, true, O0, O1, mref, lsum, nullptr, 0, lane);
              ATT_TAIL(s); ++s; }
            { const int R = w * 32 + n;
#pragma unroll
              for (int r = 0; r < 16; ++r) { const int d = (r & 3) + 8 * (r >> 2) + 4 * h; oacc[oacc_idx(R, d)] = O0[r]; oacc[oacc_idx(R, d + 32)] = O1[r]; }
              lsum += __shfl_xor(lsum, 32);
              if (h == 0) { rref[R] = mref; lacc[R] = lsum; } }
            ATT_BAR();
#define ATT_GMETA(jj_, tsk_, valid_, rr_, R_, tok_) do { const int jc__ = (jj_) < qb - 2 ? (jj_) : qb - 3; const int cnt__ = cnts[jc__]; const int ti__ = (tsk_), tslot__ = n >> 2; \
                valid_ = ((tsk_) < ((cnt__ + 7) >> 3)) && ((8 * ti__ + tslot__) < cnt__); tok_ = (int)lists[jc__ * 64 + (valid_ ? 8 * ti__ + tslot__ : 0)] & 63; \
                R_ = tok_ * 4 + (n & 3); rr_ = valid_ ? rref[R_] : 1e30f; } while (0)
#define ATT_GASM(Q_, tok_) do { const bf16_t* gp__ = qp + (trow0 + (tok_)) * 1024 + hd * 64 + 8 * h; \
                asm volatile("global_load_dwordx4 %0, %4, off\n\tglobal_load_dwordx4 %1, %4, off offset:32\n\tglobal_load_dwordx4 %2, %4, off offset:64\n\tglobal_load_dwordx4 %3, %4, off offset:96" \
                             : "=&v"(Q_[0]), "=&v"(Q_[1]), "=&v"(Q_[2]), "=&v"(Q_[3]) : "v"(gp__) : "memory"); } while (0)
#define ATT_HEAD_SP(s_) do { const int sh = (s_); \
            ATT_WAITC(cdone + (sh - 2) % ATT_RING, 8u * (unsigned)((sh - 2) / ATT_RING + 1)); ATT_ISSUE(sh + 3); \
            asm volatile("s_waitcnt vmcnt(8)" ::: "memory");       \
            ATT_SIG(cready + (sh + 1) % ATT_RING); \
            ATT_WAITC(cready + sh % ATT_RING, 8u * (unsigned)(sh / ATT_RING + 1)); } while (0)
#define ATT_SP_STEP(QC, vC, rC, RC, QN, vN, rN, RN) do { \
                const int jj = s - e1 - 3; const int ntask = ((int)cnts[jj] + 7) >> 3; int tsk = (w - jj) & 7; \
                { int tokn; ATT_GMETA(jj + 1, ((w - jj - 1) & 7), vN, rN, RN, tokn); ATT_GASM(QN, tokn); } \
                ATT_HEAD_SP(s); \
                const LAS unsigned char* Kb = lds + (s % ATT_RING) * ATT_SLOT; \
                if (tsk < ntask) attn_sparse_task(Kb, Kb + 8192, QC, ro, rC, vC, RC, oacc, lacc, h); \
                for (tsk += 8; tsk < ntask; tsk += 8) { bool v2; float r2; int R2, tok2; bf16x8 Q2[4]; ATT_GMETA(jj, tsk, v2, r2, R2, tok2); \
                    _Pragma("unroll") for (int ks = 0; ks < 4; ++ks) Q2[ks] = *(const bf16x8*)(qp + (trow0 + tok2) * 1024 + hd * 64 + 16 * ks + 8 * h); \
                    attn_sparse_task(Kb, Kb + 8192, Q2, ro, r2, v2, R2, oacc, lacc, h); } \
                ATT_TAIL(s); ATT_BAR(); ++s; } while (0)
            bf16x8 QA[4], QB[4]; bool vA = false, vB = false; float rA = 1e30f, rB = 1e30f; int RA = 0, RB = 0;
            { int tok0; ATT_GMETA(0, (w & 7), vA, rA, RA, tok0); ATT_GASM(QA, tok0); asm volatile("s_waitcnt vmcnt(0)" ::: "memory"); }
            while (s < e2) {
                ATT_SP_STEP(QA, vA, rA, RA, QB, vB, rB, RB);
                if (s >= e2) break;
                ATT_SP_STEP(QB, vB, rB, RB, QA, vA, rA, RA);
            }
            asm volatile("s_waitcnt vmcnt(0)" : "+v"(QA[0]), "+v"(QA[1]), "+v"(QA[2]), "+v"(QA[3]), "+v"(QB[0]), "+v"(QB[1]), "+v"(QB[2]), "+v"(QB[3]) :: "memory");
#undef ATT_GMETA
#undef ATT_GASM
#undef ATT_HEAD_SP
#undef ATT_SP_STEP
            ATT_BAR();
            { const int R = w * 32 + n;
#pragma unroll
              for (int r = 0; r < 16; ++r) { const int d = (r & 3) + 8 * (r >> 2) + 4 * h; O0[r] = oacc[oacc_idx(R, d)]; O1[r] = oacc[oacc_idx(R, d + 32)]; }
              lsum = lacc[R]; }
        }
        if (!sparse) lsum += __shfl_xor(lsum, 32);
        if (!sparse) attn_out_fin((bf16_t*)(kparams()->ws + WS_ACT) + trow * 1024 + hd * 64, OX, OY, O0, O1, g1 / fmaxf(lsum, 1e-30f), h);
        else attn_out_acc<false>((bf16_t*)(kparams()->ws + WS_ACT) + trow * 1024 + hd * 64, O0, O1, g1 / fmaxf(lsum, 1e-30f), h);
#pragma unroll
        for (int r = 0; r < 16; ++r) { O0[r] = 0.f; O1[r] = 0.f; }
        mref = -1e30f; lsum = 0.f;
        for (; s < total - 1; ++s) {
            ATT_HEAD(s);
            const LAS unsigned char* Kb = lds + (s % ATT_RING) * ATT_SLOT; const int kt = wlo + s - e2;
            if (kt == qb - 8) attn_step<true, true, true, false>(Kb, Kb + 8192, Qf, ro, tl + 1 - 4 * h, 63 - 4 * h, true, O0, O1, mref, lsum, nullptr, 0, lane);
            else attn_step<false, true, true, false>(Kb, Kb + 8192, Qf, ro, 0, 0, true, O0, O1, mref, lsum, nullptr, 0, lane);
            ATT_TAIL(s);
        }
        attn_out_load((const bf16_t*)(kparams()->ws + WS_ACT) + trow * 1024 + hd * 64, OX, OY, h);
        { ATT_HEAD(s);
          const LAS unsigned char* Kb = lds + (s % ATT_RING) * ATT_SLOT;
          attn_step<true, true, true, false>(Kb, Kb + 8192, Qf, ro, -4 * h, tl - 4 * h, true, O0, O1, mref, lsum, nullptr, 0, lane);
          ATT_TAIL(s); ++s; }
        lsum += __shfl_xor(lsum, 32);
        attn_out_fin((bf16_t*)(kparams()->ws + WS_ACT) + trow * 1024 + hd * 64, OX, OY, O0, O1, g2 / fmaxf(lsum, 1e-30f), h);
#undef ATT_ISSUE
#undef ATT_SLCJ
#undef ATT_HEAD
#undef ATT_VMW
#undef ATT_TAIL
#undef ATT_TAILN
#undef ATT_WAITC
#undef ATT_SIG
#undef ATT_BAR
    }
    asm volatile("s_waitcnt vmcnt(0) lgkmcnt(0)\n\ts_barrier" ::: "memory");
}
#ifndef PROBE_PRO
#define PROBE_PRO 1
#endif
#ifndef PROBE_ATT
#define PROBE_ATT 1
#endif
#ifndef PROBE_MOE
#define PROBE_MOE 1
#endif
#ifndef PROBE_QKV
#define PROBE_QKV 1
#endif
#ifndef PROBE_STEN
#define PROBE_STEN 1
#endif
#ifndef PROBE_PLE
#define PROBE_PLE 1
#endif
#ifndef PROBE_AMP
#define PROBE_AMP 4
#endif
#ifdef DBG_CHECK
constexpr int NPHASES = 1 + 8 + 8 + 11 + 9 + 1 + 2;
#ifndef DBG_THR
#define DBG_THR 1e-3f
#endif
#else
constexpr int NPHASES = 1 + 8 + 8 + 11 + 9 + 1;
#endif


__global__ void __launch_bounds__(512, 2) yoco_fwd(Params p_unused) {
    LAS unsigned char* lds = (LAS unsigned char*)smem_;
    if ((threadIdx.x & 63) == 0) lds[LDS_WTAB + hw_wave_slot()] = (unsigned char)(threadIdx.x >> 6);
    __syncthreads();
    int p0, p1; { KParams Q = kparams(); p0 = Q->p0; p1 = Q->p1; }
    const bool multi = (p1 - p0) > 1;
    LAS unsigned* xbw = (LAS unsigned*)(lds + LDS_BYTES - 16);
    unsigned xcc = 0;
    if (multi) {
        if (my_tid() == 0) { xbw[0] = 0u; xbw[1] = 0u; xbw[2] = 0u; xbw[3] = 0u; }
        __syncthreads();
        KParams Q = kparams();
        XcdBarrier b0 = xcd_barrier_post((unsigned*)(Q->ws + WS_ZERO), (volatile LAS unsigned*)xbw); xcc = b0.x;
    }
    int pid = 0;
#ifdef PROBE_CLK
    const unsigned long long clk_r0 = wall_clock64(), clk_c0 = clock64();
#endif
#ifdef PROBE_TIME
    unsigned long long tacc = 0ull, tph0 = 0ull;
#define PH_T0 tph0 = wall_clock64();
#define PH_T1 if ((PROBE_TIME >> me_) & 1ull) tacc += wall_clock64() - tph0;
#else
#define PH_T0
#define PH_T1
#endif
#define PH_BEGIN { const int me_ = pid++; PH_T0 if (p0 <= me_ && me_ < p1) { KParams Q = kparams(); unsigned char* ws = Q->ws; (void)ws;
#define PH_END   } if (p0 <= me_ && me_ + 1 < p1) { KParams Q2 = kparams(); XcdBarrier bar; bar.bar = (unsigned*)(Q2->ws + WS_ZERO); bar.x = xcc; bar.st = (volatile LAS unsigned*)xbw; xcd_barrier(bar); } PH_T1 }
#define WSP(T, off) ((T*)(ws + (off)))

    PH_BEGIN Params pl; pl.ws = ws; pl.out = Q->out; for (int i = 0; i < 34; ++i) pl.in[i] = Q->in[i]; for (int rep_ = 0; rep_ < PROBE_PRO; ++rep_) { prologue_phase(lds, pl); __syncthreads(); } PH_END

    auto layer = [&](auto LC) __attribute__((always_inline)) {
        constexpr int L = decltype(LC)::value;
        if (L < 2) {
            PH_BEGIN for (int rep_ = 0; rep_ < PROBE_STEN; ++rep_) { stencil_phase(lds, WSP(bf16_t, WS_HBA), Q->in[2] + L * 1024, WSP(bf16_t, WS_ACT)); __syncthreads(); } PH_END
            PH_BEGIN
                g8::DenseSched S; S.init(T_TOK / 256, 4); S.A = (const char*)(ws + WS_ACT); S.a_tile_b = (size_t)256 * 2048; S.a_pn_b = 512;
                S.Bt = (const char*)(ws + WS_WPOOL + (size_t)L * 1024 * 256 * 2); S.b_tile_b = (size_t)256 * 256 * 2;
                EpiResid<1> E; E.L = L;
                g8::gemm_phase<EpiResid<1>, g8::DenseSched, false>(lds, 256, 2048, 128, S, E);
            PH_END
        } else {
            const int J = L - 2;
            PH_BEGIN
                g8::DenseSched S; S.init(T_TOK / 256, J == 0 ? 11 : 5); S.A = (const char*)(ws + WS_HBA); S.a_tile_b = (size_t)256 * 2048;
                S.Bt = (const char*)(ws + (J == 0 ? WS_WKVQ : WS_WQG1)); S.b_tile_b = (size_t)256 * 1024 * 2;
                EpiQkv E; E.tile0 = (J == 0) ? 0 : 6; E.J = J;
                rstd_table_fill(lds, S, WSP(float, WS_SSQ));
                for (int rep_ = 0; rep_ < PROBE_QKV; ++rep_) { g8::gemm_phase<EpiQkv, g8::DenseSched, false>(lds, 1024, 2048, 128, S, E); __syncthreads(); }
            PH_END
            if (J == 0) {
                PH_BEGIN
                    vtrans_phase(lds, WSP(bf16_t, WS_VS), WSP(bf16_t, WS_VW), WSP(bf16_t, WS_VST), WSP(bf16_t, WS_VWT));
                    __syncthreads();
                    g8::DenseSched S; S.init(32, 2); S.A = (const char*)(ws + WS_KVC); S.a_tile_b = 0; S.a_pn_b = 512; S.tab = WSP(unsigned, WS_CMPTAB);
                    S.Bt = (const char*)(ws + WS_WC1); S.b_tile_b = (size_t)256 * 2048 * 2;
                    EpiCmp1 E; E.dummy = 0;
                    g8::gemm_phase<EpiCmp1, g8::DenseSched, true>(lds, 2048, 0, 1024, S, E);
                PH_END
                PH_BEGIN
                    g8::DenseSched S; S.init(32, 2); S.A = (const char*)(ws + WS_CHID); S.a_tile_b = (size_t)256 * 512; S.a_pn_b = (size_t)8192 * 512;
                    S.Bt = (const char*)(ws + WS_WC2); S.b_tile_b = (size_t)256 * 256 * 2;
                    EpiCmp2 E; E.dummy = 0;
                    g8::gemm_phase<EpiCmp2, g8::DenseSched, false>(lds, 256, 512, 128, S, E);
                PH_END
            }
            PH_BEGIN
                attn_phase(lds, WSP(unsigned, WS_ZERO + ZO_ATTQ) + L * 64); __syncthreads();
            PH_END
#ifdef DBG_CHECK
            PH_BEGIN Params pl; pl.ws = ws; pl.out = Q->out; for (int i = 0; i < 34; ++i) pl.in[i] = Q->in[i]; __syncthreads(); nsa_check_phase(lds, pl, J); __syncthreads(); PH_END
#endif
            PH_BEGIN
                g8::DenseSched S; S.init(T_TOK / 256, 4); S.A = (const char*)(ws + WS_ACT); S.a_tile_b = (size_t)256 * 2048;
                S.Bt = (const char*)(ws + WS_WO + (size_t)J * 1024 * 1024 * 2); S.b_tile_b = (size_t)256 * 1024 * 2;
                EpiResid<0> E; E.L = L;
                g8::gemm_phase<EpiResid<0>, g8::DenseSched, false>(lds, 1024, 2048, 128, S, E);
            PH_END
        }
        PH_BEGIN
            unsigned* counts = WSP(unsigned, WS_ZERO + ZO_COUNTS) + L * 32;
            LAS unsigned* hist = (LAS unsigned*)(lds + LDS_MISC);
            if (my_tid() < 32) hist[my_tid()] = 0u;
            __syncthreads();
            g8::DenseSched S; S.init(T_TOK / 256, 1); S.A = (const char*)(ws + WS_HBA); S.a_tile_b = (size_t)256 * 2048;
            S.Bt = (const char*)(ws + WS_WR + (size_t)L * 256 * 1024 * 2); S.b_tile_b = 0;
            EpiRouter E; E.L = L; E.hist = hist;
            { LAS float* rb = (LAS float*)(lds + LDS_RBIAS); const int t_ = my_tid(); if (t_ < 4) rb[t_] = Q->in[24][L * 4 + t_]; else if (t_ < 36) rb[t_] = Q->in[26][L * 32 + t_ - 4]; }
            rstd_table_fill(lds, S, WSP(float, WS_SSQ));
            g8::gemm_phase<EpiRouter, g8::DenseSched, false>(lds, 1024, 2048, 128, S, E);
            __syncthreads();
            if (my_tid() < 32 && hist[my_tid()]) __hip_atomic_fetch_add(counts + my_tid(), hist[my_tid()], __ATOMIC_RELAXED, __HIP_MEMORY_SCOPE_AGENT);
            __syncthreads();
            { g8::DenseSched S2; S2.init(T_TOK / 256, 4); S2.c = (blockIdx.x + 128) & 255; S2.A = (const char*)(ws + WS_PB + (size_t)L * T_TOK * 256 * 2); S2.a_tile_b = (size_t)256 * 512;
              S2.Bt = (const char*)(ws + WS_WPP + (size_t)L * 1024 * 256 * 2); S2.b_tile_b = (size_t)256 * 256 * 2;
              EpiBf16 E2; E2.dummy = 0;
              for (int rep_ = 0; rep_ < PROBE_PLE; ++rep_) { g8::gemm_phase<EpiBf16, g8::DenseSched, false>(lds, 256, 512, 128, S2, E2); __syncthreads(); } }
        PH_END
        PH_BEGIN scatter_phase(lds, WSP(unsigned, WS_ZERO + ZO_COUNTS) + L * 32, WSP(unsigned, WS_ZERO + ZO_CURSOR) + L * 32, WSP(int, WS_TOKE), WSP(int, WS_ROWTAB), WSP(unsigned, WS_ROWOFF)); PH_END
        PH_BEGIN
            const int ntiles = moe_tables(lds, WSP(unsigned, WS_ZERO + ZO_COUNTS) + L * 32);
            g8::MoeSched S; S.nunits = ntiles * 4; S.NPN = 4; S.G = gridDim.x; S.c = blockIdx.x; S.A = (const char*)(ws + WS_HBA); S.a_tile_b = 0;
            S.W = (const char*)(ws + WS_W13 + (size_t)L * 32 * 1024 * 1024 * 2); S.w_e_b = (size_t)1024 * 1024 * 2; S.b_tile_b = (size_t)256 * 1024 * 2;
            S.tab = WSP(unsigned, WS_ROWOFF); S.tile_e = lds + LDS_MISC + 256;
            EpiMoe1 E; E.dummy = 0;
            for (int rep_ = 0; rep_ < PROBE_MOE; ++rep_) { g8::gemm_phase<EpiMoe1, g8::MoeSched, true>(lds, 1024, 0, 128, S, E); __syncthreads(); }
        PH_END
        PH_BEGIN
            const int ntiles = moe_tables(lds, WSP(unsigned, WS_ZERO + ZO_COUNTS) + L * 32);
            g8::MoeSched S; S.nunits = ntiles * 4; S.NPN = 4; S.G = gridDim.x; S.c = blockIdx.x; S.A = (const char*)(ws + WS_HBUF); S.a_tile_b = (size_t)256 * 1024;
            S.W = (const char*)(ws + WS_W2 + (size_t)L * 32 * 1024 * 512 * 2); S.w_e_b = (size_t)1024 * 512 * 2; S.b_tile_b = (size_t)256 * 512 * 2;
            S.tab = nullptr; S.tile_e = lds + LDS_MISC + 256;
            EpiMoe2 E; E.dummy = 0;
            for (int rep_ = 0; rep_ < PROBE_MOE; ++rep_) { g8::gemm_phase<EpiMoe2, g8::MoeSched, false>(lds, 512, 1024, 128, S, E); __syncthreads(); }
        PH_END
        PH_BEGIN
            e1_phase(WSP(bf16_t, WS_HBA), WSP(bf16_t, WS_SLOT), WSP(bf16_t, WS_HBB), WSP(float, WS_RSP));
        PH_END
        PH_BEGIN
            g8::DenseSched S; S.init(T_TOK / 256, 4); S.A = (const char*)(ws + WS_HBB); S.a_tile_b = (size_t)256 * 2048;
            S.Bt = (const char*)(ws + WS_WPG + (size_t)L * 1024 * 1024 * 2); S.b_tile_b = (size_t)256 * 1024 * 2;
            EpiResid<2> E; E.L = L;
            g8::gemm_phase<EpiResid<2>, g8::DenseSched, false>(lds, 1024, 2048, 128, S, E);
        PH_END
    };
    layer(IC<0>{}); layer(IC<1>{}); layer(IC<2>{}); layer(IC<3>{});
#ifdef DBG_CHECK
    PH_BEGIN
        { const float* dbg = (const float*)(ws + WS_ZERO + ZO_DBG); bool bad = false;
          for (int c = 0; c < 6; ++c) if ((DBG_CHECK >> c) & 1) { const float e = dbg[2 * c], r = dbg[2 * c + 1]; if (!(r > 0.f) || !(e <= DBG_THR * r)) bad = true; }
          if (bad) { float* o = Q->out; for (size_t i = (size_t)blockIdx.x * 512 + my_tid(); i < (size_t)T_TOK * DM; i += (size_t)gridDim.x * 512) o[i] = 3.f; }
          else final_phase(WSP(bf16_t, WS_HBA), Q->out, Q->in[33]); }
    PH_END
#else
    PH_BEGIN final_phase(WSP(bf16_t, WS_HBA), Q->out, Q->in[33]); PH_END
#endif
#ifdef PROBE_CLK
    if (blockIdx.x == 0) { const unsigned long long r1 = wall_clock64(), c1 = clock64(); const unsigned long long fmhz = (c1 - clk_c0) * 100ull / (r1 - clk_r0);
        const unsigned long long t0 = wall_clock64(); while (wall_clock64() - t0 < fmhz * 100ull) __builtin_amdgcn_s_sleep(8); }
#endif
#ifdef PROBE_TIME
    if (blockIdx.x == 0) { const unsigned long long t0 = wall_clock64(); while (wall_clock64() - t0 < (unsigned long long)PROBE_AMP * tacc) __builtin_amdgcn_s_sleep(8); }
#endif
#undef PH_BEGIN
#undef PH_END
}

#ifndef MK_LAUNCHES
#define MK_LAUNCHES 0
#endif

extern "C" void kernel_launch(void* const* d_in, const int* in_sizes, int n_in, void* d_out, int out_size, void* d_ws, size_t ws_size, hipStream_t stream) {
    static int ready = 0;
    if (!ready) {
        if (n_in != 34 || out_size != T_TOK * DM || ws_size < WS_END) { fprintf(stderr, "kernel_launch: unexpected sizes (n_in %d out %d ws %zu need %zu)\n", n_in, out_size, ws_size, (size_t)WS_END); ready = -1; return; }
        if (hipFuncSetAttribute((const void*)yoco_fwd, hipFuncAttributeMaxDynamicSharedMemorySize, LDS_BYTES) != hipSuccess) { fprintf(stderr, "kernel_launch: hipFuncSetAttribute failed\n"); ready = -1; return; }
        int per_cu = 0;
        if (hipOccupancyMaxActiveBlocksPerMultiprocessor(&per_cu, (const void*)yoco_fwd, 512, LDS_BYTES) != hipSuccess || per_cu < 1) fprintf(stderr, "kernel_launch: occupancy query reports %d\n", per_cu);
        (void)hipGetLastError();
        ready = 1;
    }
    if (ready < 0) return;
    (void)hipMemsetAsync((char*)d_ws + WS_ZERO, 0, ZERO_BYTES, stream);
    Params p{};
    for (int i = 0; i < 34; ++i) p.in[i] = (const float*)d_in[i];
    p.out = (float*)d_out; p.ws = (unsigned char*)d_ws;
#if MK_LAUNCHES == 1
    p.p0 = 0; p.p1 = NPHASES;
    hipLaunchKernelGGL(yoco_fwd, dim3(256), dim3(512), LDS_BYTES, stream, p);
#else
    for (int ph = 0; ph < NPHASES; ++ph) { p.p0 = ph; p.p1 = ph + 1; hipLaunchKernelGGL(yoco_fwd, dim3(256), dim3(512), LDS_BYTES, stream, p); }
#endif
}
```
